# Optimizing an MI355X kernel written in HIP

```python
import math
import jax, jax.numpy as jnp
from jax import lax
import numpy as np

D_MODEL = 2048
BATCH = 4
SEQ = 2048
DEPTH = 2
DEC_BATCH = 128
DEC_SEQ = 4
PAST_LEN = 8192
PAGE_SIZE = 128

N_A_LAYERS = DEPTH // 2
N_B_LAYERS = DEPTH - N_A_LAYERS
HGRN_EXPAND = 128
HGRN_HEADS = D_MODEL // HGRN_EXPAND
HGRN_DK = HGRN_EXPAND
HGRN_DV = D_MODEL // HGRN_HEADS
HGRN_WIDTH = HGRN_HEADS * HGRN_DK
HGRN_CHUNK = 16
ATTN_HEAD_DIM = 64
ATTN_Q_HEADS = D_MODEL // ATTN_HEAD_DIM
ATTN_KV_HEADS = max(1, ATTN_Q_HEADS // 8)
ATTN_GROUP = ATTN_Q_HEADS // ATTN_KV_HEADS
WINDOW = 128
ROT_DIM = ATTN_HEAD_DIM // 4
ROPE_THETA = 500000.0
D_FF = int(math.ceil(8 * D_MODEL / 3 / 256)) * 256
RMS_EPS = 1e-6

kernel_name = "yoco_hgrn2_swa_sink_decode_step"


def rmsnorm(x, g):
    xf = x.astype(jnp.float32)
    y = xf * lax.rsqrt(jnp.mean(xf * xf, axis=-1, keepdims=True) + RMS_EPS)
    return (y * g.astype(jnp.float32)).astype(x.dtype)


def swiglu(xn, w_gate_up, w_down):
    gate, up = jnp.split(xn @ w_gate_up, 2, axis=-1)
    return (jax.nn.silu(gate) * up) @ w_down


def rope(x, pos):
    inv = ROPE_THETA ** (-jnp.arange(0, ROT_DIM, 2, dtype=jnp.float32) / ROT_DIM)
    ang = pos.astype(jnp.float32)[:, None] * inv[None, :]
    cos = jnp.cos(ang)[None, :, None, :]
    sin = jnp.sin(ang)[None, :, None, :]
    xr = x[..., :ROT_DIM].astype(jnp.float32)
    x1, x2 = jnp.split(xr, 2, axis=-1)
    rot = jnp.concatenate([x1 * cos - x2 * sin, x2 * cos + x1 * sin], axis=-1)
    return jnp.concatenate([rot.astype(x.dtype), x[..., ROT_DIM:]], axis=-1)


def gla_chunked(q, k, v, log_f, S0):
    B, T, H, DK = q.shape
    DV = v.shape[-1]
    C = math.gcd(T, HGRN_CHUNK)
    n = T // C

    def to_chunks(a):
        return jnp.moveaxis(a.astype(jnp.float32).reshape(B, n, C, *a.shape[2:]), 1, 0)

    tril = jnp.tril(jnp.ones((C, C), dtype=bool))

    def step(S, inp):
        qc, kc, vc, gc = inp
        b = jnp.cumsum(gc, axis=1)
        o_inter = jnp.einsum('bthk,bhkv->bthv', qc * jnp.exp(b), S)
        diff = b[:, :, None] - b[:, None, :]
        decay = jnp.exp(jnp.where(tril[None, :, :, None, None], diff, -jnp.inf))
        scores = jnp.einsum('bthk,bshk,btshk->btsh', qc, kc, decay)
        o_intra = jnp.einsum('btsh,bshv->bthv', scores, vc)
        b_last = b[:, -1]
        S_new = jnp.exp(b_last)[..., None] * S + jnp.einsum(
            'bshk,bshv->bhkv', kc * jnp.exp(b_last[:, None] - b), vc)
        return S_new, o_inter + o_intra

    S, o = lax.scan(step, S0.astype(jnp.float32),
                    (to_chunks(q), to_chunks(k), to_chunks(v), to_chunks(log_f)))
    o = jnp.moveaxis(o, 0, 1).reshape(B, T, H, DV)
    return o.astype(q.dtype), S.astype(S0.dtype)


def hgrn2_mixer(xn, w_in, lb, g_norm, w_out, S0):
    B, T, _ = xn.shape
    q, f, i, g = jnp.split(xn @ w_in, 4, axis=-1)
    q = jax.nn.silu(q).reshape(B, T, HGRN_HEADS, HGRN_DK)
    fg = lb + (1.0 - lb) * jax.nn.sigmoid(f.astype(jnp.float32))
    log_f = jnp.log(fg).reshape(B, T, HGRN_HEADS, HGRN_DK)
    k = (1.0 - fg).astype(xn.dtype).reshape(B, T, HGRN_HEADS, HGRN_DK)
    v = i.reshape(B, T, HGRN_HEADS, HGRN_DV)
    o, S = gla_chunked(q, k, v, log_f, S0)
    o = rmsnorm(o, g_norm.reshape(HGRN_HEADS, HGRN_DV))
    o = o.reshape(B, T, HGRN_WIDTH) * jax.nn.silu(g)
    return o @ w_out, S


def shared_kv(h, kv_norm, w_kv, pos):
    B, T, _ = h.shape
    k, v = jnp.split(rmsnorm(h, kv_norm) @ w_kv, 2, axis=-1)
    k = rope(k.reshape(B, T, ATTN_KV_HEADS, ATTN_HEAD_DIM), pos)
    v = v.reshape(B, T, ATTN_KV_HEADS, ATTN_HEAD_DIM)
    return k, v


def sink_attention(q, k, v, q_pos, k_pos, sinks):
    s = jnp.einsum('bnqhgd,bnkhd->bnhgqk', q, k).astype(jnp.float32) * (ATTN_HEAD_DIM ** -0.5)
    qp = q_pos[:, :, None]
    kp = k_pos[:, None, :]
    mask = (kp >= 0) & (kp <= qp) & (qp - kp < WINDOW)
    s = jnp.where(mask[None, :, None, None], s, -jnp.inf)
    sink = sinks.astype(jnp.float32).reshape(ATTN_KV_HEADS, ATTN_GROUP)[None, None, :, :, None, None]
    m = jnp.maximum(jnp.max(s, axis=-1, keepdims=True), sink)
    p = jnp.exp(s - m)
    p = p / (jnp.sum(p, axis=-1, keepdims=True) + jnp.exp(sink - m))
    return jnp.einsum('bnhgqk,bnkhd->bnqhgd', p.astype(v.dtype), v)


def swa_prompt(xn, w_q, sinks, w_out, k, v, pos):
    B, T, _ = xn.shape
    BLK = WINDOW
    nb = T // BLK
    q = rope((xn @ w_q).reshape(B, T, ATTN_Q_HEADS, ATTN_HEAD_DIM), pos)
    q = q.reshape(B, nb, BLK, ATTN_KV_HEADS, ATTN_GROUP, ATTN_HEAD_DIM)
    pad = ((0, 0), (BLK, 0), (0, 0), (0, 0))
    k_pad, v_pad = jnp.pad(k, pad), jnp.pad(v, pad)

    def band(a):
        return jnp.concatenate([a[:, :T].reshape(B, nb, BLK, *a.shape[2:]),
                                a[:, BLK:].reshape(B, nb, BLK, *a.shape[2:])], axis=2)

    kp_pad = jnp.arange(-BLK, T, dtype=jnp.int32)
    kp = jnp.concatenate([kp_pad[:T].reshape(nb, BLK), kp_pad[BLK:].reshape(nb, BLK)], axis=1)
    o = sink_attention(q, band(k_pad), band(v_pad), pos.reshape(nb, BLK), kp, sinks)
    return o.reshape(B, T, ATTN_Q_HEADS * ATTN_HEAD_DIM) @ w_out


def swa_sample(xn, w_q, sinks, w_out, k_all, v_all, q_pos, k_pos):
    B, T, _ = xn.shape
    q = rope((xn @ w_q).reshape(B, T, ATTN_Q_HEADS, ATTN_HEAD_DIM), q_pos)
    q = q.reshape(B, 1, T, ATTN_KV_HEADS, ATTN_GROUP, ATTN_HEAD_DIM)
    o = sink_attention(q, k_all[:, None], v_all[:, None], q_pos[None], k_pos[None], sinks)
    return o.reshape(B, T, ATTN_Q_HEADS * ATTN_HEAD_DIM) @ w_out


def trunk(x, pos, S_init, past_k, past_v, past_pos,
          norm_mix_pre, norm_mix_post, norm_ffn_pre, norm_ffn_post,
          hgrn_w_in, hgrn_lower_bounds, hgrn_g_norm, hgrn_w_out,
          kv_norm, w_kv, attn_w_q, attn_sinks, attn_w_out,
          ffn_w_gate_up, ffn_w_down):
    lbs = jnp.cumsum(jax.nn.softmax(hgrn_lower_bounds.astype(jnp.float32), axis=0), axis=0)
    h = x
    new_states = []
    k_sh = v_sh = None
    for l in range(DEPTH):
        hn = rmsnorm(h, norm_mix_pre[l])
        if l < N_A_LAYERS:
            mix, S_l = hgrn2_mixer(hn, hgrn_w_in[l], lbs[l], hgrn_g_norm[l], hgrn_w_out[l], S_init[l])
            new_states.append(S_l)
        else:
            j = l - N_A_LAYERS
            if past_k is None:
                mix = swa_prompt(hn, attn_w_q[j], attn_sinks[j], attn_w_out[j], k_sh, v_sh, pos)
            else:
                mix = swa_sample(hn, attn_w_q[j], attn_sinks[j], attn_w_out[j],
                                 jnp.concatenate([past_k, k_sh], axis=1),
                                 jnp.concatenate([past_v, v_sh], axis=1),
                                 pos, jnp.concatenate([past_pos, pos]))
        h = h + rmsnorm(mix, norm_mix_post[l])
        h = h + rmsnorm(swiglu(rmsnorm(h, norm_ffn_pre[l]), ffn_w_gate_up[l], ffn_w_down[l]),
                        norm_ffn_post[l])
        if l == N_A_LAYERS - 1:
            k_sh, v_sh = shared_kv(h, kv_norm, w_kv, pos)
    return h, jnp.stack(new_states), k_sh, v_sh


def setup_inputs(seed: int = 0) -> dict:
    key = jax.random.key(seed)
    ks = jax.random.split(key, 24)
    f32 = jnp.float32

    def w(k, shape, fan_in):
        return jax.random.normal(k, shape, f32) * (fan_in ** -0.5)

    def gain(k, shape):
        return 1.0 + 0.02 * jax.random.normal(k, shape, f32)

    w_buf = min(WINDOW, PAST_LEN)
    return {
        "x_prompt": jax.random.normal(ks[0], (BATCH, SEQ, D_MODEL), f32),
        "x_sample": jax.random.normal(ks[1], (DEC_BATCH, DEC_SEQ, D_MODEL), f32),
        "state_hgrn": jax.random.normal(ks[2], (N_A_LAYERS, DEC_BATCH, HGRN_HEADS, HGRN_DK, HGRN_DV), f32),
        "cache_k_win": jax.random.normal(ks[3], (DEC_BATCH, w_buf, ATTN_KV_HEADS, ATTN_HEAD_DIM), f32),
        "cache_v_win": jax.random.normal(ks[4], (DEC_BATCH, w_buf, ATTN_KV_HEADS, ATTN_HEAD_DIM), f32),
        "norm_mix_pre": gain(ks[5], (DEPTH, D_MODEL)),
        "norm_mix_post": gain(ks[6], (DEPTH, D_MODEL)),
        "norm_ffn_pre": gain(ks[7], (DEPTH, D_MODEL)),
        "norm_ffn_post": gain(ks[8], (DEPTH, D_MODEL)),
        "hgrn_w_in": w(ks[9], (N_A_LAYERS, D_MODEL, 4 * HGRN_WIDTH), D_MODEL),
        "hgrn_lower_bounds": jax.random.normal(ks[10], (N_A_LAYERS + 1, HGRN_WIDTH), f32),
        "hgrn_g_norm": gain(ks[11], (N_A_LAYERS, HGRN_HEADS * HGRN_DV)),
        "hgrn_w_out": w(ks[12], (N_A_LAYERS, HGRN_WIDTH, D_MODEL), HGRN_WIDTH),
        "kv_norm": gain(ks[13], (D_MODEL,)),
        "w_kv": w(ks[14], (D_MODEL, 2 * ATTN_KV_HEADS * ATTN_HEAD_DIM), D_MODEL),
        "attn_w_q": w(ks[15], (N_B_LAYERS, D_MODEL, ATTN_Q_HEADS * ATTN_HEAD_DIM), D_MODEL),
        "attn_sinks": 0.5 * jax.random.normal(ks[16], (N_B_LAYERS, ATTN_Q_HEADS), f32),
        "attn_w_out": w(ks[17], (N_B_LAYERS, ATTN_Q_HEADS * ATTN_HEAD_DIM, D_MODEL), ATTN_Q_HEADS * ATTN_HEAD_DIM),
        "ffn_w_gate_up": w(ks[18], (DEPTH, D_MODEL, 2 * D_FF), D_MODEL),
        "ffn_w_down": w(ks[19], (DEPTH, D_FF, D_MODEL), D_FF),
    }


def reference(x_prompt, x_sample, state_hgrn, cache_k_win, cache_v_win,
              norm_mix_pre, norm_mix_post, norm_ffn_pre, norm_ffn_post,
              hgrn_w_in, hgrn_lower_bounds, hgrn_g_norm, hgrn_w_out,
              kv_norm, w_kv, attn_w_q, attn_sinks, attn_w_out,
              ffn_w_gate_up, ffn_w_down):
    weights = (norm_mix_pre, norm_mix_post, norm_ffn_pre, norm_ffn_post,
               hgrn_w_in, hgrn_lower_bounds, hgrn_g_norm, hgrn_w_out,
               kv_norm, w_kv, attn_w_q, attn_sinks, attn_w_out,
               ffn_w_gate_up, ffn_w_down)
    Bp, Tp, _ = x_prompt.shape
    Ts = x_sample.shape[1]
    pos_p = jnp.arange(Tp, dtype=jnp.int32)
    S0_p = jnp.zeros((N_A_LAYERS, Bp, HGRN_HEADS, HGRN_DK, HGRN_DV), x_prompt.dtype)
    y_prompt, S_p, k_p, v_p = trunk(x_prompt, pos_p, S0_p, None, None, None, *weights)
    w_buf = cache_k_win.shape[1]
    pos_s = PAST_LEN + jnp.arange(Ts, dtype=jnp.int32)
    past_pos = PAST_LEN - w_buf + jnp.arange(w_buf, dtype=jnp.int32)
    y_sample, S_s, k_s, v_s = trunk(x_sample, pos_s, state_hgrn, cache_k_win, cache_v_win, past_pos, *weights)
    w_p = min(WINDOW, Tp)
    return (y_prompt, y_sample, S_p, S_s, k_p[:, Tp - w_p:], v_p[:, Tp - w_p:], k_s, v_s)
```

```cpp
#include <hip/hip_runtime.h>
#include <hip/hip_cooperative_groups.h>
#include <cstdio>
#include <cstdint>
namespace cg = cooperative_groups;

#ifndef MK_ONE_LAUNCH
#define MK_ONE_LAUNCH 1
#endif

#define LAS __attribute__((address_space(3)))
typedef unsigned short bf16_t;
typedef short bf16x8 __attribute__((ext_vector_type(8)));
typedef float f32x4 __attribute__((ext_vector_type(4)));
typedef float f32x2 __attribute__((ext_vector_type(2)));
typedef unsigned u32x4 __attribute__((ext_vector_type(4)));
typedef unsigned u32x2 __attribute__((ext_vector_type(2)));
typedef __bf16 bf16x2_t __attribute__((ext_vector_type(2)));

constexpr int D = 2048, NPROMPT = 8192, NSAMPLE = 512, M = NPROMPT + NSAMPLE;
constexpr int TP = 2048, TS = 4, BS = 128;
constexpr int DFF = 5632;
constexpr float EPS = 1e-6f;

__device__ __forceinline__ unsigned pk2(float lo, float hi) { f32x2 v = {lo, hi}; bf16x2_t b = __builtin_convertvector(v, bf16x2_t); return __builtin_bit_cast(unsigned, b); }
__device__ __forceinline__ float bf2f(unsigned b) { return __uint_as_float(b << 16); }
__device__ __forceinline__ float silu_f(float x) { return x * __builtin_amdgcn_rcpf(1.0f + __expf(-x)); }
__device__ __forceinline__ float wave_sum(float v) {
#pragma unroll
    for (int o = 1; o < 64; o <<= 1) v += __shfl_xor(v, o);
    return v;
}

namespace pg8 {
constexpr int BM = 256, BK = 64, HALF = 128, HTB = HALF * BK * 2, STAGE_BYTES = 8 * HTB, NXCD = 8, WGM = 8;
__host__ __device__ __forceinline__ int lds_byte(int r, int c) { const int st = (r >> 4) * 2 + (c >> 5), rr = r & 15, cc = c & 31, ob = rr * 64 + cc * 2; return st * 1024 + (ob ^ (((ob >> 9) & 1) << 5)); }
__host__ __device__ __forceinline__ void stage_rc(int b, int& R, int& C) { const int st = b / 1024, sb = b % 1024, swz = sb ^ (((sb >> 9) & 1) << 5); R = (st >> 1) * 16 + swz / 64; C = (st & 1) * 32 + (swz % 64) / 2; }
__host__ __device__ __forceinline__ int perm32(int rho) { const int n = rho >> 4, i = rho & 15; return 8 * (i >> 2) + 4 * n + (i & 3); }

struct Unit { int pm, pn, kt0, nt, split, uid; };
struct Gemm { const bf16_t* A; const bf16_t* Bt; int M, N, K; };

struct StaticOrder {
    int nM, nN, nwg, G, c, ntk;
    __host__ __device__ void init(int M_, int N_, int G_, int c_, int K_) { nM = M_ / BM; nN = N_ / BM; nwg = nM * nN; G = G_; c = c_; ntk = K_ / BK; }
    __host__ __device__ bool next(int i, Unit& u) const {
        const long L = (long)i * G + c; if (L >= nwg) return false;
        u.kt0 = 0; u.nt = ntk; u.split = -1; u.uid = 0;
        int wgid = (int)L; { const int q = nwg / NXCD, r = nwg % NXCD, xcd = wgid % NXCD, off = wgid / NXCD; wgid = (xcd < r ? xcd * (q + 1) : r * (q + 1) + (xcd - r) * q) + off; }
        const int nig = WGM * nN, gid = wgid / nig, fm = gid * WGM, gsz = (nM - fm) < WGM ? (nM - fm) : WGM;
        u.pm = fm + ((wgid % nig) % gsz); u.pn = (wgid % nig) / gsz; return true;
    }
    __device__ __forceinline__ void a_ready(const Unit&) const {}
    __device__ __forceinline__ void done(const Unit&) const {}
};

struct SplitOrder {
    StaticOrder so; int c;
    __host__ __device__ void init(int N_, int G_, int c_, int K_) { so.init(8192, N_, G_, c_, K_); c = c_; }
    __host__ __device__ bool next(int i, Unit& u) const {
        if (i == 0) return so.next(0, u);
        if (i == 1 && c < 128) { const int j = c >> 3, sp = c & 7; u.pm = 32 + (j >> 3); u.pn = j & 7; u.split = sp; u.uid = j;
            if (so.ntk == 32) { u.kt0 = 4 * sp; u.nt = 4; } else { u.kt0 = sp < 4 ? 12 * sp : 48 + 10 * (sp - 4); u.nt = sp < 4 ? 12 : 10; }
            return true; }
        return false;
    }
    __device__ __forceinline__ void a_ready(const Unit&) const {}
    __device__ __forceinline__ void done(const Unit&) const {}
};


struct EpiIn {
    static constexpr bool PERM = true, AFTER_DRAIN = false;
    bf16_t* Qs; float* LOGF; bf16_t* Vb; bf16_t* SG; const float* lbraw;
    __device__ __forceinline__ void operator()(const f32x4 (&acc)[2][2][4][2], const Unit& u, int wr, int wc, int fr, int fq) const {
        const int seg = u.pn >> 3;
        const int row0 = u.pm * BM + wr * 64 + fr;
        const int col0 = (u.pn & 7) * BM + wc * 32 + 8 * fq;
        if (seg == 1) {
#pragma unroll
            for (int bj = 0; bj < 2; ++bj) {
                const int c = col0 + bj * HALF;
                float lb[8];
#pragma unroll
                for (int e = 0; e < 8; ++e) { const float a0 = lbraw[c + e], a1 = lbraw[D + c + e]; lb[e] = __builtin_amdgcn_rcpf(1.0f + __expf(a1 - a0)); }
#pragma unroll
                for (int ai = 0; ai < 2; ++ai)
#pragma unroll
                    for (int m = 0; m < 4; ++m) {
                        float* dst = LOGF + (size_t)(row0 + ai * HALF + m * 16) * D + c;
                        f32x4 o0, o1;
#pragma unroll
                        for (int j = 0; j < 4; ++j) {
                            const float s0 = __builtin_amdgcn_rcpf(1.0f + __expf(-acc[ai][bj][m][0][j])), s1 = __builtin_amdgcn_rcpf(1.0f + __expf(-acc[ai][bj][m][1][j]));
                            o0[j] = __logf(lb[j] + (1.0f - lb[j]) * s0); o1[j] = __logf(lb[4 + j] + (1.0f - lb[4 + j]) * s1);
                        }
                        *(f32x4*)dst = o0; *(f32x4*)(dst + 4) = o1;
                    }
            }
        } else {
            bf16_t* base = Qs + (size_t)seg * ((size_t)M * D);
#pragma unroll
            for (int ai = 0; ai < 2; ++ai)
#pragma unroll
                for (int m = 0; m < 4; ++m)
#pragma unroll
                    for (int bj = 0; bj < 2; ++bj) {
                        f32x4 v0 = acc[ai][bj][m][0], v1 = acc[ai][bj][m][1];
                        if (seg != 2) {
#pragma unroll
                            for (int j = 0; j < 4; ++j) { v0[j] = silu_f(v0[j]); v1[j] = silu_f(v1[j]); }
                        }
                        u32x4 w; w.x = pk2(v0[0], v0[1]); w.y = pk2(v0[2], v0[3]); w.z = pk2(v1[0], v1[1]); w.w = pk2(v1[2], v1[3]);
                        *(u32x4*)(base + (size_t)(row0 + ai * HALF + m * 16) * D + col0 + bj * HALF) = w;
                    }
        }
    }
};
struct EpiF32 {
    static constexpr bool PERM = true, AFTER_DRAIN = false;
    bf16_t* Y; int ldc; float* slab; unsigned* cnt;
    __device__ __forceinline__ void operator()(const f32x4 (&acc)[2][2][4][2], const Unit& u, int wr, int wc, int fr, int fq) const {
        const int row0 = u.pm * BM + wr * 64 + fr, col0 = u.pn * BM + wc * 32 + 8 * fq;
        if (u.split < 0) {
#pragma unroll
            for (int ai = 0; ai < 2; ++ai)
#pragma unroll
                for (int m = 0; m < 4; ++m)
#pragma unroll
                    for (int bj = 0; bj < 2; ++bj) {
                        const f32x4 v0 = acc[ai][bj][m][0], v1 = acc[ai][bj][m][1];
                        u32x4 w4; w4.x = pk2(v0[0], v0[1]); w4.y = pk2(v0[2], v0[3]); w4.z = pk2(v1[0], v1[1]); w4.w = pk2(v1[2], v1[3]);
                        *(u32x4*)(Y + (size_t)(row0 + ai * HALF + m * 16) * ldc + col0 + bj * HALF) = w4;
                    }
            return;
        }
        const int tid = threadIdx.x;
        f32x4* mine = (f32x4*)(slab + (size_t)(u.uid * 8 + u.split) * 65536) + tid;
#pragma unroll
        for (int ai = 0; ai < 2; ++ai)
#pragma unroll
            for (int m = 0; m < 4; ++m)
#pragma unroll
                for (int bj = 0; bj < 2; ++bj)
#pragma unroll
                    for (int n = 0; n < 2; ++n) mine[(((ai * 4 + m) * 2 + bj) * 2 + n) * 512] = acc[ai][bj][m][n];
        __threadfence();
        __syncthreads();
        if (tid == 0) {
            unsigned* cw = cnt + 64 * u.uid;
            __hip_atomic_fetch_add(cw, 1u, __ATOMIC_RELAXED, __HIP_MEMORY_SCOPE_AGENT);
            unsigned sp = 0;
            while (__hip_atomic_load(cw, __ATOMIC_RELAXED, __HIP_MEMORY_SCOPE_AGENT) < 8u) { __builtin_amdgcn_s_sleep(2); if (++sp > (1u << 22)) break; }
            __threadfence();
        }
        __syncthreads();
        const int ai = u.split >> 2, m = u.split & 3;
        f32x4 sum[2][2];
#pragma unroll
        for (int bj = 0; bj < 2; ++bj)
#pragma unroll
            for (int n = 0; n < 2; ++n) sum[bj][n] = (f32x4){0.f, 0.f, 0.f, 0.f};
        const f32x4* base = (const f32x4*)(slab + (size_t)(u.uid * 8) * 65536) + tid + (size_t)(u.split * 4) * 512;
#pragma unroll
        for (int sp = 0; sp < 8; ++sp)
#pragma unroll
            for (int bj = 0; bj < 2; ++bj)
#pragma unroll
                for (int n = 0; n < 2; ++n) sum[bj][n] += base[(size_t)sp * 16384 + (bj * 2 + n) * 512];
#pragma unroll
        for (int bj = 0; bj < 2; ++bj) {
            const f32x4 v0 = sum[bj][0], v1 = sum[bj][1];
            u32x4 w4; w4.x = pk2(v0[0], v0[1]); w4.y = pk2(v0[2], v0[3]); w4.z = pk2(v1[0], v1[1]); w4.w = pk2(v1[2], v1[3]);
            *(u32x4*)(Y + (size_t)(row0 + ai * HALF + m * 16) * ldc + col0 + bj * HALF) = w4;
        }
    }
};
struct EpiSwiGLU {
    static constexpr bool PERM = true, AFTER_DRAIN = false;
    bf16_t* Hact;
    __device__ __forceinline__ void operator()(const f32x4 (&acc)[2][2][4][2], const Unit& u, int wr, int wc, int fr, int fq) const {
        const int row0 = u.pm * BM + wr * 64 + fr, col0 = u.pn * HALF + wc * 32 + 8 * fq;
#pragma unroll
        for (int ai = 0; ai < 2; ++ai)
#pragma unroll
            for (int m = 0; m < 4; ++m) {
                f32x4 v0, v1;
#pragma unroll
                for (int j = 0; j < 4; ++j) { v0[j] = silu_f(acc[ai][0][m][0][j]) * acc[ai][1][m][0][j]; v1[j] = silu_f(acc[ai][0][m][1][j]) * acc[ai][1][m][1][j]; }
                u32x4 w; w.x = pk2(v0[0], v0[1]); w.y = pk2(v0[2], v0[3]); w.z = pk2(v1[0], v1[1]); w.w = pk2(v1[2], v1[3]);
                *(u32x4*)(Hact + (size_t)(row0 + ai * HALF + m * 16) * DFF + col0) = w;
            }
    }
};
template <int MODE> struct EpiRope {
    static constexpr bool PERM = true, AFTER_DRAIN = false;
    bf16_t* O0; bf16_t* O1; const f32x2* rope;
    float* kwin; float* vwin; float* knew; float* vnew;
    __device__ __forceinline__ void operator()(const f32x4 (&accin)[2][2][4][2], const Unit& u, int wr, int wc, int fr, int fq) const {
        const int row0 = u.pm * BM + wr * 64 + fr;
        const bool do_rope = (MODE == 0 || u.pn == 0) && ((wc & 1) == 0);
        const float scale = MODE == 0 ? 0.125f : 1.0f;
#pragma unroll
        for (int ai = 0; ai < 2; ++ai) {
            f32x4 csm[4][4];
            if (do_rope) {
#pragma unroll
                for (int m = 0; m < 4; ++m) { const int row = row0 + ai * HALF + m * 16; const int idx = row < NPROMPT ? (row & (TP - 1)) : (TP + (row & 3));
                    const f32x4* rp = (const f32x4*)(rope + (size_t)idx * 8);
#pragma unroll
                    for (int q = 0; q < 4; ++q) csm[m][q] = rp[q]; }
            }
#pragma unroll
            for (int m = 0; m < 4; ++m) {
                const int row = row0 + ai * HALF + m * 16;
                f32x4 v[2][2];
#pragma unroll
                for (int bj = 0; bj < 2; ++bj) { v[bj][0] = accin[ai][bj][m][0]; v[bj][1] = accin[ai][bj][m][1]; }
                if (do_rope) {
                    const f32x4 (&cs)[4] = csm[m];
#pragma unroll
                    for (int bj = 0; bj < 2; ++bj)
#pragma unroll
                        for (int n = 0; n < 2; ++n)
#pragma unroll
                            for (int j = 0; j < 4; ++j) {
                                const int f = 4 * n + j;
                                const float c = cs[f >> 1][(f & 1) * 2], s = cs[f >> 1][(f & 1) * 2 + 1];
                                const float x = v[bj][n][j];
                                const float px = __shfl_xor(x, 16);
                                const float r = fq == 0 ? x * c - px * s : x * c + px * s;
                                v[bj][n][j] = fq < 2 ? r : x;
                            }
                }
#pragma unroll
                for (int bj = 0; bj < 2; ++bj) {
                    const f32x4 a = v[bj][0] * scale, b = v[bj][1] * scale;
                    u32x4 w; w.x = pk2(a[0], a[1]); w.y = pk2(a[2], a[3]); w.z = pk2(b[0], b[1]); w.w = pk2(b[2], b[3]);
                    const int ct = bj * HALF + wc * 32 + 8 * fq;
                    if (MODE == 0) {
                        *(u32x4*)(O0 + (size_t)row * D + u.pn * BM + ct) = w;
                    } else {
                        bf16_t* ob = u.pn == 0 ? O0 : O1;
                        *(u32x4*)(ob + (size_t)row * 256 + ct) = w;
                        float* fo = nullptr;
                        if (u.pm >= NPROMPT / BM) fo = (u.pn == 0 ? knew : vnew) + (size_t)(row - NPROMPT) * 256 + ct;
                        else if ((u.pm & 7) == 7 && ai == 1) fo = (u.pn == 0 ? kwin : vwin) + (size_t)((u.pm >> 3) * 128 + (row & 127)) * 256 + ct;
                        if (fo) { *(f32x4*)fo = a; *(f32x4*)(fo + 4) = b; }
                    }
                }
            }
        }
    }
};

template <class Epi, class Sched, bool ALIGN_EPI = false, bool SP2 = false>
__device__ __forceinline__ void gemm_phase(LAS unsigned char* lds, const Gemm g, const Sched& S, const Epi& E) {
    const int tid = threadIdx.x, wid = __builtin_amdgcn_readfirstlane(tid >> 6), lane = tid & 63, wr = wid >> 2, wc = wid & 3, fr = lane & 15, fq = lane >> 4;
    const int K = g.K;
    unsigned voffA[2], voffB[2];
#pragma unroll
    for (int i = 0; i < 2; ++i) { int R, C; stage_rc(tid * 16 + i * 8192, R, C); const int Rb = Epi::PERM ? ((R & ~31) + perm32(R & 31)) : R;
        voffA[i] = (unsigned)(R * K + C) * 2u; voffB[i] = (unsigned)(Rb * K + C) * 2u; }
    const size_t kstep = (size_t)(BK * 2);
    const size_t hstep = (size_t)HALF * K * 2;
    const size_t tstep = 2 * hstep;
    const unsigned ldsw = (unsigned)wid * 1024u;
    const int aoff = lds_byte(wr * 64 + fr, fq * 8), boff = lds_byte(wc * 32 + fr, fq * 8);
#define PG8_SA(b, h) (((b) * 2 + (h)) * HTB)
#define PG8_SB(b, h) ((4 + (b) * 2 + (h)) * HTB)
#define PG8_STAGE(bufoff, gbase, voff) do { _Pragma("unroll") for (int _i = 0; _i < 2; ++_i) \
        __builtin_amdgcn_global_load_lds((const unsigned*)((const char*)(gbase) + (voff)[_i]), (LAS unsigned*)(lds + (bufoff) + ldsw + _i * 8192), 16, 0, 0); } while (0)
#define PG8_LDA(dst, b, h) do { _Pragma("unroll") for (int m = 0; m < 4; ++m) _Pragma("unroll") for (int k = 0; k < 2; ++k) dst[m][k] = *(const LAS bf16x8*)(lds + PG8_SA(b, h) + aoff + m * 2048 + k * 1024); } while (0)
#define PG8_LDB(dst, b, h) do { _Pragma("unroll") for (int n = 0; n < 2; ++n) _Pragma("unroll") for (int k = 0; k < 2; ++k) dst[n][k] = *(const LAS bf16x8*)(lds + PG8_SB(b, h) + boff + n * 2048 + k * 1024); } while (0)
#define PG8_MMA(ai, bj, At, Bt) do { __builtin_amdgcn_s_setprio(1); _Pragma("unroll") for (int m = 0; m < 4; ++m) _Pragma("unroll") for (int n = 0; n < 2; ++n) _Pragma("unroll") for (int k = 0; k < 2; ++k) \
        acc[ai][bj][m][n] = __builtin_amdgcn_mfma_f32_16x16x32_bf16(Bt[n][k], At[m][k], acc[ai][bj][m][n], 0, 0, 0); __builtin_amdgcn_s_setprio(0); } while (0)
#define PG8_WAIT_V(n) asm volatile("s_waitcnt vmcnt(" #n ")" ::: "memory")
#define PG8_WAIT_L(n) asm volatile("s_waitcnt lgkmcnt(" #n ")" ::: "memory")
#define PG8_BAR __builtin_amdgcn_s_barrier()
#define PG8_SCHED __builtin_amdgcn_sched_barrier(0)
    Unit cur, nxt; int ui = 0;
    if (!S.next(0, cur)) return;
    f32x4 acc[2][2][4][2];
#pragma unroll
    for (int a = 0; a < 2; ++a)
#pragma unroll
        for (int b = 0; b < 2; ++b)
#pragma unroll
            for (int m = 0; m < 4; ++m)
#pragma unroll
                for (int n = 0; n < 2; ++n) acc[a][b][m][n] = (f32x4){0.f, 0.f, 0.f, 0.f};
    bf16x8 At[4][2], B0[2][2], B1[2][2];
    const char* cA = (const char*)g.A + (size_t)cur.pm * tstep + (size_t)cur.kt0 * kstep; const char* cB = (const char*)g.Bt + (size_t)cur.pn * tstep + (size_t)cur.kt0 * kstep;
    S.a_ready(cur);
    if constexpr (SP2) {
        PG8_STAGE(PG8_SB(0, 0), cB, voffB); PG8_STAGE(PG8_SB(0, 1), cB + hstep, voffB); PG8_STAGE(PG8_SA(0, 0), cA, voffA); PG8_STAGE(PG8_SA(0, 1), cA + hstep, voffA);
        if (wr == 1) PG8_BAR;
        PG8_WAIT_V(2); PG8_BAR;
        PG8_STAGE(PG8_SB(1, 0), cB + kstep, voffB); PG8_STAGE(PG8_SA(1, 0), cA + kstep, voffA); PG8_STAGE(PG8_SB(1, 1), cB + hstep + kstep, voffB);
        PG8_WAIT_V(6); PG8_BAR;
    } else {
        PG8_STAGE(PG8_SB(0, 0), cB, voffB); PG8_STAGE(PG8_SA(0, 0), cA, voffA); PG8_STAGE(PG8_SB(0, 1), cB + hstep, voffB); PG8_STAGE(PG8_SA(0, 1), cA + hstep, voffA);
        if (wr == 1) PG8_BAR;
        PG8_WAIT_V(4); PG8_BAR;
        PG8_STAGE(PG8_SB(1, 0), cB + kstep, voffB); PG8_STAGE(PG8_SA(1, 0), cA + kstep, voffA); PG8_STAGE(PG8_SB(1, 1), cB + hstep + kstep, voffB);
        PG8_WAIT_V(6); PG8_BAR;
    }
    for (;;) {
        const bool has_next = S.next(ui + 1, nxt);
        const char* nA = has_next ? (const char*)g.A + (size_t)nxt.pm * tstep + (size_t)nxt.kt0 * kstep : cA; const char* nB = has_next ? (const char*)g.Bt + (size_t)nxt.pn * tstep + (size_t)nxt.kt0 * kstep : cB;
        const int nt = cur.nt;
        for (int t = 0; t < nt; t += 2) {
            const bool last = (t == nt - 2);
            const char* a1 = cA + (size_t)(t + 1) * kstep;
            const char* a2 = last ? nA : cA + (size_t)(t + 2) * kstep; const char* b2 = last ? nB : cB + (size_t)(t + 2) * kstep;
            const char* a3 = a2 + kstep; const char* b3 = b2 + kstep;
            if (last && has_next) S.a_ready(nxt);
            if constexpr (SP2) {
            PG8_LDB(B0, 0, 0); PG8_LDB(B1, 0, 1); PG8_SCHED; PG8_LDA(At, 0, 0); PG8_STAGE(PG8_SA(1, 1), a1 + hstep, voffA);
            PG8_WAIT_V(8); PG8_WAIT_L(0); PG8_BAR; PG8_MMA(0, 0, At, B0); PG8_MMA(0, 1, At, B1); PG8_BAR; PG8_SCHED;
            PG8_LDA(At, 0, 1); PG8_STAGE(PG8_SB(0, 0), b2, voffB); PG8_STAGE(PG8_SB(0, 1), b2 + hstep, voffB); PG8_STAGE(PG8_SA(0, 0), a2, voffA);
            PG8_WAIT_V(8); PG8_WAIT_L(0); PG8_BAR; PG8_MMA(1, 0, At, B0); PG8_MMA(1, 1, At, B1); PG8_BAR; PG8_SCHED;
            PG8_LDB(B0, 1, 0); PG8_LDB(B1, 1, 1); PG8_SCHED; PG8_LDA(At, 1, 0); PG8_STAGE(PG8_SA(0, 1), a2 + hstep, voffA);
            PG8_WAIT_V(8); PG8_WAIT_L(0); PG8_BAR; PG8_MMA(0, 0, At, B0); PG8_MMA(0, 1, At, B1); PG8_BAR; PG8_SCHED;
            PG8_LDA(At, 1, 1); PG8_STAGE(PG8_SB(1, 0), b3, voffB); PG8_STAGE(PG8_SB(1, 1), b3 + hstep, voffB); PG8_STAGE(PG8_SA(1, 0), a3, voffA);
            PG8_WAIT_V(8); PG8_WAIT_L(0); PG8_BAR; PG8_MMA(1, 0, At, B0); PG8_MMA(1, 1, At, B1); PG8_BAR; PG8_SCHED;
            } else {
            PG8_LDB(B0, 0, 0); PG8_SCHED; PG8_LDA(At, 0, 0); PG8_STAGE(PG8_SA(1, 1), a1 + hstep, voffA);
            PG8_WAIT_L(8); PG8_BAR; PG8_WAIT_L(0); PG8_MMA(0, 0, At, B0); PG8_BAR; PG8_SCHED;
            PG8_LDB(B1, 0, 1); PG8_STAGE(PG8_SB(0, 0), b2, voffB);
            PG8_BAR; PG8_WAIT_L(0); PG8_MMA(0, 1, At, B1); PG8_BAR;
            PG8_LDA(At, 0, 1); PG8_STAGE(PG8_SA(0, 0), a2, voffA);
            PG8_BAR; PG8_WAIT_L(0); PG8_MMA(1, 0, At, B0); PG8_BAR; PG8_SCHED;
            PG8_STAGE(PG8_SB(0, 1), b2 + hstep, voffB);
            PG8_WAIT_V(6); PG8_BAR; PG8_MMA(1, 1, At, B1); PG8_BAR;
            PG8_LDB(B0, 1, 0); PG8_SCHED; PG8_LDA(At, 1, 0); PG8_STAGE(PG8_SA(0, 1), a2 + hstep, voffA);
            PG8_WAIT_L(8); PG8_BAR; PG8_WAIT_L(0); PG8_MMA(0, 0, At, B0); PG8_BAR; PG8_SCHED;
            PG8_LDB(B1, 1, 1); PG8_STAGE(PG8_SB(1, 0), b3, voffB);
            PG8_BAR; PG8_WAIT_L(0); PG8_MMA(0, 1, At, B1); PG8_BAR;
            PG8_LDA(At, 1, 1); PG8_STAGE(PG8_SA(1, 0), a3, voffA);
            PG8_BAR; PG8_WAIT_L(0); PG8_MMA(1, 0, At, B0); PG8_BAR; PG8_SCHED;
            PG8_STAGE(PG8_SB(1, 1), b3 + hstep, voffB);
            PG8_WAIT_V(6); PG8_BAR; PG8_MMA(1, 1, At, B1); PG8_BAR;
            }
        }
        if constexpr (ALIGN_EPI) { if (wr == 0) PG8_BAR; }
        if constexpr (!Epi::AFTER_DRAIN) { E(acc, cur, wr, wc, fr, fq); S.done(cur); }
        if (!has_next) break;
#pragma unroll
        for (int a = 0; a < 2; ++a)
#pragma unroll
            for (int b = 0; b < 2; ++b)
#pragma unroll
                for (int m = 0; m < 4; ++m)
#pragma unroll
                    for (int n = 0; n < 2; ++n) acc[a][b][m][n] = (f32x4){0.f, 0.f, 0.f, 0.f};
        cur = nxt; cA = nA; cB = nB; ++ui;
        if constexpr (ALIGN_EPI) { if (wr == 1) PG8_BAR; }
    }
    PG8_WAIT_V(0);
    if constexpr (!ALIGN_EPI) { if (wr == 0) PG8_BAR; }
    PG8_BAR;
#undef PG8_SA
#undef PG8_SB
#undef PG8_STAGE
#undef PG8_LDA
#undef PG8_LDB
#undef PG8_MMA
#undef PG8_WAIT_V
#undef PG8_WAIT_L
#undef PG8_BAR
#undef PG8_SCHED
}
}

constexpr size_t MiB = 1u << 20;
constexpr size_t WS_WIN = 1 * MiB, WS_WOUT = 33 * MiB, WS_WKV = 41 * MiB, WS_WQ = 43 * MiB, WS_WAO = 51 * MiB, WS_WGU0 = 59 * MiB, WS_WGU1 = 103 * MiB,
                 WS_WD0 = 147 * MiB, WS_WD1 = 169 * MiB, WS_ROPE = 191 * MiB, WS_XN = 192 * MiB, WS_Y = 226 * MiB, WS_O2 = 294 * MiB, WS_R1 = 328 * MiB;
constexpr size_t WS_GQT = 192 * MiB, WS_GKH = 224 * MiB, WS_GVT = 256 * MiB;
constexpr size_t WS_GPS = WS_R1 + 34 * MiB, WS_GDEC = WS_R1 + 42 * MiB;
constexpr size_t WS_QS = WS_R1, WS_VB = WS_R1 + 68 * MiB, WS_SG = WS_R1 + 102 * MiB, WS_LOGF = WS_R1 + 136 * MiB;
constexpr size_t WS_HACT = WS_R1;
constexpr size_t WS_XKV = WS_R1, WS_QR = WS_R1 + 34 * MiB, WS_KB = WS_R1 + 68 * MiB, WS_VKV = WS_R1 + 73 * MiB;
constexpr size_t WS_SLAB = WS_R1 + 204 * MiB;
constexpr size_t WS_END = WS_SLAB + 32 * MiB;
constexpr size_t WS_HB = WS_LOGF;
constexpr size_t WS_CNT = 65536;
constexpr size_t OUT_Y = 0, OUT_SP = (size_t)M * D, OUT_SS = OUT_SP + 4 * 16 * 16384, OUT_KWIN = OUT_SS + (size_t)128 * 16 * 16384, OUT_VWIN = OUT_KWIN + 131072,
                 OUT_KNEW = OUT_VWIN + 131072, OUT_VNEW = OUT_KNEW + 131072, OUT_END = OUT_VNEW + 131072;

constexpr int LDS_BYTES = 147456;
constexpr int NWAVES = 8;

template <bool GU> __device__ __forceinline__ void p0_transpose_item(const float* W, int K, int N, bf16_t* WT, LAS float* scr, int item, int lane) {
    const int nblk = N / 32, kb = item / nblk, nb = item % nblk, k0 = 64 * kb, n0 = 32 * nb;
    f32x4 wv[8];
#pragma unroll
    for (int i = 0; i < 8; ++i) wv[i] = *(const f32x4*)(W + (size_t)(k0 + 8 * i + (lane >> 3)) * N + n0 + 4 * (lane & 7));
#pragma unroll
    for (int i = 0; i < 8; ++i) { LAS float* d = scr + (8 * i + (lane >> 3)) * 33 + 4 * (lane & 7); d[0] = wv[i][0]; d[1] = wv[i][1]; d[2] = wv[i][2]; d[3] = wv[i][3]; }
    asm volatile("s_waitcnt lgkmcnt(0)" ::: "memory");
    int r0 = n0;
    if (GU) { const int half = n0 >= DFF ? 1 : 0, rem = n0 - half * DFF; r0 = (rem >> 7) * 256 + half * 128 + (rem & 127); }
    const int c = lane & 7;
#pragma unroll
    for (int j = 0; j < 4; ++j) { const int n = (lane >> 3) + 8 * j; const LAS float* s = scr + (8 * c) * 33 + n;
        u32x4 o; o.x = pk2(s[0 * 33], s[1 * 33]); o.y = pk2(s[2 * 33], s[3 * 33]); o.z = pk2(s[4 * 33], s[5 * 33]); o.w = pk2(s[6 * 33], s[7 * 33]);
        *(u32x4*)(WT + (size_t)(r0 + n) * K + k0 + 8 * c) = o; }
    asm volatile("s_waitcnt lgkmcnt(0)" ::: "memory");
}

template <bool GU> __device__ __forceinline__ void cvt_stream(const float* W, int K, int N, bf16_t* WT, LAS float* scr, int first, int stride, int nitems, int lane) {
    if (first >= nitems) return;
    const int nblk = N / 32, lr = lane >> 3, lc = 4 * (lane & 7);
    f32x4 wv[8];
    { const int k0 = 64 * (first / nblk), n0 = 32 * (first % nblk);
#pragma unroll
      for (int i = 0; i < 8; ++i) wv[i] = *(const f32x4*)(W + (size_t)(k0 + 8 * i + lr) * N + n0 + lc); }
    for (int it = first; it < nitems; it += stride) {
        const int k0 = 64 * (it / nblk), n0 = 32 * (it % nblk);
#pragma unroll
        for (int i = 0; i < 8; ++i) { LAS float* d = scr + (8 * i + lr) * 33 + lc; d[0] = wv[i][0]; d[1] = wv[i][1]; d[2] = wv[i][2]; d[3] = wv[i][3]; }
        const int itn = it + stride;
        if (itn < nitems) { const int k1 = 64 * (itn / nblk), n1 = 32 * (itn % nblk);
#pragma unroll
            for (int i = 0; i < 8; ++i) wv[i] = *(const f32x4*)(W + (size_t)(k1 + 8 * i + lr) * N + n1 + lc); }
        asm volatile("s_waitcnt lgkmcnt(0)" ::: "memory");
        int r0 = n0;
        if (GU) { const int half = n0 >= DFF ? 1 : 0, rem = n0 - half * DFF; r0 = (rem >> 7) * 256 + half * 128 + (rem & 127); }
        const int c = lane & 7;
#pragma unroll
        for (int j = 0; j < 4; ++j) { const int n = (lane >> 3) + 8 * j; const LAS float* sp = scr + (8 * c) * 33 + n;
            u32x4 o; o.x = pk2(sp[0 * 33], sp[1 * 33]); o.y = pk2(sp[2 * 33], sp[3 * 33]); o.z = pk2(sp[4 * 33], sp[5 * 33]); o.w = pk2(sp[6 * 33], sp[7 * 33]);
            *(u32x4*)(WT + (size_t)(r0 + n) * K + k0 + 8 * c) = o; }
        asm volatile("s_waitcnt lgkmcnt(0)" ::: "memory");
    }
}

template <bool HASY, bool HASA, bool HASB, bool HIN16 = false, bool HOUT16 = false>
__device__ __forceinline__ void row_pass(const void* hin, const bf16_t* Yrow, const float* gpost, void* hout, const float* gA, bf16_t* outA, const float* gB, bf16_t* outB, int lane) {
    f32x4 h[8];
    if (HIN16) { const u32x2* hr = (const u32x2*)hin + lane;
#pragma unroll
        for (int j = 0; j < 8; ++j) { const u32x2 hw = hr[64 * j]; h[j] = (f32x4){bf2f(hw.x & 0xffffu), __uint_as_float(hw.x & 0xffff0000u), bf2f(hw.y & 0xffffu), __uint_as_float(hw.y & 0xffff0000u)}; }
    } else { const f32x4* hr = (const f32x4*)hin + lane;
#pragma unroll
        for (int j = 0; j < 8; ++j) h[j] = hr[64 * j];
    }
    if (HASY) {
        const u32x2* yr = (const u32x2*)Yrow + lane; f32x4 y[8]; float ss = 0.f;
#pragma unroll
        for (int j = 0; j < 8; ++j) { const u32x2 yw = yr[64 * j]; y[j] = (f32x4){bf2f(yw.x & 0xffffu), __uint_as_float(yw.x & 0xffff0000u), bf2f(yw.y & 0xffffu), __uint_as_float(yw.y & 0xffff0000u)}; ss += (y[j].x * y[j].x + y[j].y * y[j].y) + (y[j].z * y[j].z + y[j].w * y[j].w); }
        const float rstd = rsqrtf(wave_sum(ss) * (1.0f / D) + EPS);
        const f32x4* gp = (const f32x4*)gpost + lane;
#pragma unroll
        for (int j = 0; j < 8; ++j) { h[j] = h[j] + y[j] * rstd * gp[64 * j];
            if (HOUT16) { u32x2 w; w.x = pk2(h[j].x, h[j].y); w.y = pk2(h[j].z, h[j].w); ((u32x2*)hout + lane)[64 * j] = w; } else ((f32x4*)hout + lane)[64 * j] = h[j]; }
    }
    if (HASA || HASB) {
        float ss = 0.f;
#pragma unroll
        for (int j = 0; j < 8; ++j) ss += (h[j].x * h[j].x + h[j].y * h[j].y) + (h[j].z * h[j].z + h[j].w * h[j].w);
        const float rstd = rsqrtf(wave_sum(ss) * (1.0f / D) + EPS);
        if (HASA) { const f32x4* ga = (const f32x4*)gA + lane; u32x2* oa = (u32x2*)outA + lane;
#pragma unroll
            for (int j = 0; j < 8; ++j) { const f32x4 v = h[j] * rstd * ga[64 * j]; u32x2 w; w.x = pk2(v.x, v.y); w.y = pk2(v.z, v.w); oa[64 * j] = w; } }
        if (HASB) { const f32x4* gb = (const f32x4*)gB + lane; u32x2* ob = (u32x2*)outB + lane;
#pragma unroll
            for (int j = 0; j < 8; ++j) { const f32x4 v = h[j] * rstd * gb[64 * j]; u32x2 w; w.x = pk2(v.x, v.y); w.y = pk2(v.z, v.w); ob[64 * j] = w; } }
    }
}

#define LDS_BARRIER() do { asm volatile("s_waitcnt lgkmcnt(0)" ::: "memory"); __builtin_amdgcn_s_barrier(); asm volatile("" ::: "memory"); } while (0)
namespace gla {
constexpr int QT_OFF = 0, TOK_STRIDE = 272;
constexpr int KT_OFF = 64 * 272;
constexpr int KH_OFF = 2 * 64 * 272, CH_STRIDE = 144;
constexpr int VT_OFF = KH_OFF + 128 * 144;
constexpr int DEC_OFF = VT_OFF + 128 * 144;
constexpr int OS_OFF = DEC_OFF + 1024, OS_STRIDE = 528;
constexpr int END = OS_OFF + 64 * 528;
static_assert(END <= 131072, "gla lds");
struct P { const bf16_t* Qs; const float* LOGF; const bf16_t* Vb; const bf16_t* SG; const float* gnorm; bf16_t* O2;
           unsigned char* G_QT; unsigned char* G_KH; unsigned char* G_VT; unsigned char* G_PS; unsigned char* G_DEC; };

__device__ __forceinline__ bf16x8 mk8(u32x2 lo, u32x2 hi) { u32x4 t; t.x = lo.x; t.y = lo.y; t.z = hi.x; t.w = hi.y; return __builtin_bit_cast(bf16x8, t); }
__device__ __forceinline__ bf16x8 pk8(f32x4 a, f32x4 b) { u32x4 t; t.x = pk2(a[0], a[1]); t.y = pk2(a[2], a[3]); t.z = pk2(b[0], b[1]); t.w = pk2(b[2], b[3]); return __builtin_bit_cast(bf16x8, t); }

__device__ __forceinline__ void intra_items(LAS unsigned char* lds, const P& p, int first, int stride, int nitems) {
    const int tid = threadIdx.x, lane = tid & 63, w = __builtin_amdgcn_readfirstlane(tid >> 6), l16 = lane & 15, g = lane >> 4;
    const int pk = tid & 127, grp = tid >> 7, pc = grp >> 1, hf = grp & 1;
    float lfo[16]; unsigned qv[16], vv[16];
#define GLA_LOAD_RAW(id) do { const int bh_ = (id) >> 5; const size_t R_ = (size_t)(bh_ >> 4) * TP + (size_t)((id) & 31) * 64; const int hc_ = (bh_ & 15) * 128; \
        _Pragma("unroll") for (int i = 0; i < 16; ++i) { const int tok = 16 * grp + i; lfo[i] = p.LOGF[(R_ + tok) * D + hc_ + pk]; \
            qv[i] = (unsigned)p.Qs[(R_ + tok) * D + hc_ + pk]; vv[i] = (unsigned)p.Vb[(R_ + tok) * D + hc_ + pk]; } } while (0)
    if (first < nitems) GLA_LOAD_RAW(first);
    for (int id = first; id < nitems; id += stride) {
        {
            float so = 0.f;
#pragma unroll
            for (int i = 0; i < 16; ++i) so += lfo[i];
            *(LAS float*)(lds + OS_OFF + tid * 4) = so;
            LDS_BARRIER();
            const float sx = *(const LAS float*)(lds + OS_OFF + (tid ^ 128) * 4);
            const float tot = so + sx;
            float b = hf ? sx : 0.f;
            unsigned khp[8], vtp[8]; float khprev = 0.f;
#pragma unroll
            for (int i = 0; i < 16; ++i) {
                const float l = lfo[i];
                b += l;
                const float kk = 1.0f - __expf(l);
                const float bc = fmaxf(b, -80.f);
                const float qq = bf2f(qv[i]) * __expf(bc);
                const float kt = kk * __expf(-bc);
                const float kh = kk * __expf(tot - b);
                const int t = 16 * grp + i;
                *(LAS bf16_t*)(lds + QT_OFF + t * TOK_STRIDE + pk * 2) = (bf16_t)(pk2(qq, 0.f) & 0xffffu);
                *(LAS bf16_t*)(lds + KT_OFF + t * TOK_STRIDE + pk * 2) = (bf16_t)(pk2(kt, 0.f) & 0xffffu);
                if (i & 1) { khp[i >> 1] = pk2(khprev, kh); vtp[i >> 1] = vv[i - 1] | (vv[i] << 16); } else khprev = kh;
            }
            LAS u32x4* khd = (LAS u32x4*)(lds + KH_OFF + pk * CH_STRIDE + grp * 32); LAS u32x4* vtd = (LAS u32x4*)(lds + VT_OFF + pk * CH_STRIDE + grp * 32);
            khd[0] = (u32x4){khp[0], khp[1], khp[2], khp[3]}; khd[1] = (u32x4){khp[4], khp[5], khp[6], khp[7]};
            vtd[0] = (u32x4){vtp[0], vtp[1], vtp[2], vtp[3]}; vtd[1] = (u32x4){vtp[4], vtp[5], vtp[6], vtp[7]};
            if (hf == 0) *(LAS float*)(lds + DEC_OFF + pc * 512 + pk * 4) = __expf(tot);
        }
        LDS_BARRIER();
        if (id + stride < nitems) GLA_LOAD_RAW(id + stride);
        {
            const int c = w >> 2, st = (w >> 1) & 1, tt = w & 1, tb = 32 * c;
            f32x4 a4 = (f32x4){0.f, 0.f, 0.f, 0.f};
#pragma unroll
            for (int ks = 0; ks < 4; ++ks) {
                const bf16x8 a = *(const LAS bf16x8*)(lds + KT_OFF + (tb + 16 * st + l16) * TOK_STRIDE + (32 * ks + 8 * g) * 2);
                const bf16x8 bq = *(const LAS bf16x8*)(lds + QT_OFF + (tb + 16 * tt + l16) * TOK_STRIDE + (32 * ks + 8 * g) * 2);
                a4 = __builtin_amdgcn_mfma_f32_16x16x32_bf16(a, bq, a4, 0, 0, 0);
            }
#pragma unroll
            for (int j = 0; j < 4; ++j) { const int s_ = 16 * st + 4 * g + j, t_ = 16 * tt + l16; a4[j] = s_ <= t_ ? a4[j] : 0.f; }
            u32x2 pw; pw.x = pk2(a4[0], a4[1]); pw.y = pk2(a4[2], a4[3]);
            *(u32x2*)(p.G_PS + (size_t)id * 4096 + w * 512 + lane * 8) = pw;
        }
#pragma unroll
        for (int i = 0; i < 2; ++i) { const int pi = tid + 512 * i;
            *(u32x4*)(p.G_QT + (size_t)id * 16384 + pi * 16) = *(const LAS u32x4*)(lds + QT_OFF + (pi >> 4) * TOK_STRIDE + (pi & 15) * 16);
            *(u32x4*)(p.G_KH + (size_t)id * 16384 + pi * 16) = *(const LAS u32x4*)(lds + KH_OFF + (pi >> 3) * CH_STRIDE + (pi & 7) * 16);
            *(u32x4*)(p.G_VT + (size_t)id * 16384 + pi * 16) = *(const LAS u32x4*)(lds + VT_OFF + (pi >> 3) * CH_STRIDE + (pi & 7) * 16); }
        if (tid < 64) *(u32x4*)(p.G_DEC + (size_t)id * 1024 + tid * 16) = *(const LAS u32x4*)(lds + DEC_OFF + tid * 16);
        LDS_BARRIER();
    }
#undef GLA_LOAD_RAW
}

__device__ __forceinline__ void scan_seq(LAS unsigned char* lds, const P& p, int bh, float* Sout, int nsc) {
    const int tid = threadIdx.x, lane = tid & 63, w = __builtin_amdgcn_readfirstlane(tid >> 6), l16 = lane & 15, g = lane >> 4;
    const int pt = tid >> 3, pp = tid & 7;
    const int hc = (bh & 15) * 128; const size_t row0 = (size_t)(bh >> 4) * TP;
    if (tid < 128) *(LAS float*)(lds + END + tid * 4) = p.gnorm[hc + tid];
    f32x4 S[8];
#pragma unroll
    for (int i = 0; i < 8; ++i) S[i] = (f32x4){0.f, 0.f, 0.f, 0.f};
    u32x4 rq[2], rk[2], rv[2], rd, rp;
    u32x4 sg0, sg1, sg0n = (u32x4){0u, 0u, 0u, 0u}, sg1n = sg0n;
#define SCAN_LOAD(sc) do { const size_t id_ = (size_t)bh * 32 + ((sc) & 31); \
        _Pragma("unroll") for (int i = 0; i < 2; ++i) { const int pi = tid + 512 * i; rq[i] = *(const u32x4*)(p.G_QT + id_ * 16384 + pi * 16); rk[i] = *(const u32x4*)(p.G_KH + id_ * 16384 + pi * 16); rv[i] = *(const u32x4*)(p.G_VT + id_ * 16384 + pi * 16); } \
        rd = *(const u32x4*)(p.G_DEC + id_ * 1024 + (tid & 63) * 16); rp = *(const u32x4*)(p.G_PS + id_ * 4096 + (tid & 255) * 16); } while (0)
    { const u32x4* sgp = (const u32x4*)(p.SG + (row0 + pt) * D + hc + 16 * pp); sg0 = sgp[0]; sg1 = sgp[1]; }
    SCAN_LOAD(0);
    for (int scx = 0; scx < nsc; ++scx) {
        const int sc = scx & 31;
        const size_t R = row0 + (size_t)sc * 64;
#pragma unroll
        for (int i = 0; i < 2; ++i) { const int pi = tid + 512 * i;
            *(LAS u32x4*)(lds + QT_OFF + (pi >> 4) * TOK_STRIDE + (pi & 15) * 16) = rq[i];
            *(LAS u32x4*)(lds + KH_OFF + (pi >> 3) * CH_STRIDE + (pi & 7) * 16) = rk[i];
            *(LAS u32x4*)(lds + VT_OFF + (pi >> 3) * CH_STRIDE + (pi & 7) * 16) = rv[i]; }
        if (tid < 64) *(LAS u32x4*)(lds + DEC_OFF + tid * 16) = rd;
        if (tid < 256) *(LAS u32x4*)(lds + KT_OFF + tid * 16) = rp;
        LDS_BARRIER();
        if (scx + 1 < nsc) { const u32x4* sgp = (const u32x4*)(p.SG + (row0 + (size_t)((scx + 1) & 31) * 64 + pt) * D + hc + 16 * pp); sg0n = sgp[0]; sg1n = sgp[1]; SCAN_LOAD(scx + 1); }
#pragma unroll
        for (int c = 0; c < 2; ++c) {
            const int tb = 32 * c;
            const LAS unsigned char* vrow = lds + VT_OFF + (16 * w + l16) * CH_STRIDE + (tb + 4 * g) * 2;
            const bf16x8 vfrag = mk8(*(const LAS u32x2*)vrow, *(const LAS u32x2*)(vrow + 32));
            bf16x8 pf[2], bq[2][4], ka[8]; f32x4 d4[8];
#pragma unroll
            for (int tt = 0; tt < 2; ++tt) {
                pf[tt] = mk8(*(const LAS u32x2*)(lds + KT_OFF + ((c * 4 + tt) * 64 + lane) * 8), *(const LAS u32x2*)(lds + KT_OFF + ((c * 4 + 2 + tt) * 64 + lane) * 8));
#pragma unroll
                for (int j2 = 0; j2 < 4; ++j2) { const LAS unsigned char* qrow = lds + QT_OFF + (tb + 16 * tt + l16) * TOK_STRIDE + (32 * j2 + 4 * g) * 2;
                    bq[tt][j2] = mk8(*(const LAS u32x2*)qrow, *(const LAS u32x2*)(qrow + 32)); }
            }
#pragma unroll
            for (int i = 0; i < 8; ++i) { d4[i] = *(const LAS f32x4*)(lds + DEC_OFF + c * 512 + (16 * i + 4 * g) * 4);
                const LAS unsigned char* krow = lds + KH_OFF + (16 * i + l16) * CH_STRIDE + (tb + 4 * g) * 2; ka[i] = mk8(*(const LAS u32x2*)krow, *(const LAS u32x2*)(krow + 32)); }
            bf16x8 sa[4];
#pragma unroll
            for (int j2 = 0; j2 < 4; ++j2) sa[j2] = pk8(S[2 * j2], S[2 * j2 + 1]);
            const f32x4 z4 = (f32x4){0.f, 0.f, 0.f, 0.f};
            f32x4 oa0 = __builtin_amdgcn_mfma_f32_16x16x32_bf16(vfrag, pf[0], z4, 0, 0, 0);
            f32x4 oa1 = __builtin_amdgcn_mfma_f32_16x16x32_bf16(vfrag, pf[1], z4, 0, 0, 0);
            f32x4 ob0 = __builtin_amdgcn_mfma_f32_16x16x32_bf16(sa[1], bq[0][1], z4, 0, 0, 0);
            f32x4 ob1 = __builtin_amdgcn_mfma_f32_16x16x32_bf16(sa[1], bq[1][1], z4, 0, 0, 0);
            oa0 = __builtin_amdgcn_mfma_f32_16x16x32_bf16(sa[0], bq[0][0], oa0, 0, 0, 0);
            oa1 = __builtin_amdgcn_mfma_f32_16x16x32_bf16(sa[0], bq[1][0], oa1, 0, 0, 0);
            ob0 = __builtin_amdgcn_mfma_f32_16x16x32_bf16(sa[3], bq[0][3], ob0, 0, 0, 0);
            ob1 = __builtin_amdgcn_mfma_f32_16x16x32_bf16(sa[3], bq[1][3], ob1, 0, 0, 0);
            oa0 = __builtin_amdgcn_mfma_f32_16x16x32_bf16(sa[2], bq[0][2], oa0, 0, 0, 0);
            oa1 = __builtin_amdgcn_mfma_f32_16x16x32_bf16(sa[2], bq[1][2], oa1, 0, 0, 0);
#pragma unroll
            for (int i = 0; i < 8; ++i) S[i] = __builtin_amdgcn_mfma_f32_16x16x32_bf16(ka[i], vfrag, S[i] * d4[i], 0, 0, 0);
            *(LAS f32x4*)(lds + OS_OFF + (tb + l16) * OS_STRIDE + (16 * w + 4 * g) * 4) = oa0 + ob0;
            *(LAS f32x4*)(lds + OS_OFF + (tb + 16 + l16) * OS_STRIDE + (16 * w + 4 * g) * 4) = oa1 + ob1;
        }
        LDS_BARRIER();
        {
            const LAS f32x4* op = (const LAS f32x4*)(lds + OS_OFF + pt * OS_STRIDE + pp * 64);
            f32x4 o[4]; float ss = 0.f;
#pragma unroll
            for (int q = 0; q < 4; ++q) { o[q] = op[q]; ss += (o[q].x * o[q].x + o[q].y * o[q].y) + (o[q].z * o[q].z + o[q].w * o[q].w); }
            ss += __shfl_xor(ss, 1); ss += __shfl_xor(ss, 2); ss += __shfl_xor(ss, 4);
            const float rstd = rsqrtf(ss * (1.0f / 128.0f) + EPS);
            const unsigned sgw[8] = {sg0.x, sg0.y, sg0.z, sg0.w, sg1.x, sg1.y, sg1.z, sg1.w};
            unsigned ow[8];
#pragma unroll
            for (int q = 0; q < 4; ++q) {
                const f32x4 v = o[q] * rstd * *(const LAS f32x4*)(lds + END + (16 * pp + 4 * q) * 4);
                ow[2 * q] = pk2(v.x * bf2f(sgw[2 * q] & 0xffffu), v.y * bf2f(sgw[2 * q] >> 16));
                ow[2 * q + 1] = pk2(v.z * bf2f(sgw[2 * q + 1] & 0xffffu), v.w * bf2f(sgw[2 * q + 1] >> 16));
            }
            u32x4* od = (u32x4*)(p.O2 + (R + pt) * D + hc + 16 * pp);
            od[0] = (u32x4){ow[0], ow[1], ow[2], ow[3]}; od[1] = (u32x4){ow[4], ow[5], ow[6], ow[7]};
        }
        sg0 = sg0n; sg1 = sg1n;
    }
#undef SCAN_LOAD
#pragma unroll
    for (int i = 0; i < 8; ++i)
#pragma unroll
        for (int j = 0; j < 4; ++j) Sout[(size_t)(16 * i + 4 * g + j) * 128 + 16 * w + l16] = S[i][j];
}

constexpr int DF_OFF = 0, DK_OFF = 2048, DQ_OFF = 4096, DV_OFF = 6144, DR_OFF = 8192, DW_OFF = 16384;
__device__ __forceinline__ void decode_items(LAS unsigned char* lds, const P& p, const float* state_in, float* state_out, int first, int stride, int nitems) {
    const int tid = threadIdx.x, lane = tid & 63, w = __builtin_amdgcn_readfirstlane(tid >> 6);
    const int v = tid & 127, kg = tid >> 7;
    float sA[32], sB[32];
    float lA = 0.f, gA = 0.f, lB = 0.f, gB = 0.f; unsigned qA = 0u, vA = 0u, sgA = 0u, qB = 0u, vB = 0u, sgB = 0u;
#define DEC_PREFETCH(itn_, s, c_l, c_q, c_v, c_sg, c_gn) do { const int itn = (itn_) & (BS * 16 - 1); \
        _Pragma("unroll") for (int q = 0; q < 4; ++q) { const float* sp = state_in + (size_t)itn * 16384 + (size_t)(32 * kg + 8 * q) * 128 + v; \
            _Pragma("unroll") for (int i = 0; i < 8; ++i) s[8 * q + i] = sp[i * 128]; } \
        const int hc_ = (itn & 15) * 128; const size_t off_ = ((size_t)NPROMPT + 4 * (itn >> 4) + kg) * D + hc_ + v; \
        c_l = p.LOGF[off_]; c_q = (unsigned)p.Qs[off_]; c_v = (unsigned)p.Vb[off_]; c_sg = (unsigned)p.SG[off_]; c_gn = p.gnorm[hc_ + v]; } while (0)
#define DEC_BODY(itx_, s, c_l, c_q, c_v, c_sg, c_gn) do { const int it = (itx_) & (BS * 16 - 1); \
        const size_t off = ((size_t)NPROMPT + 4 * (it >> 4) + kg) * D + (it & 15) * 128 + v; \
        const float gate = c_gn * bf2f(c_sg); \
        { const float f = __expf(c_l); \
          *(LAS float*)(lds + DF_OFF + tid * 4) = f; *(LAS float*)(lds + DK_OFF + tid * 4) = 1.0f - f; \
          *(LAS float*)(lds + DQ_OFF + tid * 4) = bf2f(c_q); *(LAS float*)(lds + DV_OFF + tid * 4) = bf2f(c_v); } \
        LDS_BARRIER(); \
        _Pragma("unroll 1") for (int t = 0; t < 4; ++t) { \
            const float vt = *(const LAS float*)(lds + DV_OFF + (t * 128 + v) * 4); \
            float a = 0.f; \
            _Pragma("unroll") for (int i4 = 0; i4 < 8; ++i4) { \
                const f32x4 f4 = *(const LAS f32x4*)(lds + DF_OFF + (t * 128 + 32 * kg + 4 * i4) * 4), k4 = *(const LAS f32x4*)(lds + DK_OFF + (t * 128 + 32 * kg + 4 * i4) * 4), \
                            q4 = *(const LAS f32x4*)(lds + DQ_OFF + (t * 128 + 32 * kg + 4 * i4) * 4); \
                _Pragma("unroll") for (int j = 0; j < 4; ++j) { const float sn = f4[j] * s[4 * i4 + j] + k4[j] * vt; s[4 * i4 + j] = sn; a += q4[j] * sn; } \
            } \
            *(LAS float*)(lds + DR_OFF + ((t * 4 + kg) * 128 + v) * 4) = a; \
        } \
        _Pragma("unroll") for (int q = 0; q < 4; ++q) { \
            float* so = state_out + (size_t)it * 16384 + (size_t)(32 * kg + 8 * q) * 128 + v; \
            _Pragma("unroll") for (int i = 0; i < 8; ++i) so[i * 128] = s[8 * q + i]; \
        } \
        if ((itx_) + 2 * stride < nitems) DEC_PREFETCH((itx_) + 2 * stride, s, c_l, c_q, c_v, c_sg, c_gn); \
        LDS_BARRIER(); \
        const LAS float* rr = (const LAS float*)(lds + DR_OFF + (kg * 4 * 128 + v) * 4); \
        const float o = (rr[0] + rr[128]) + (rr[256] + rr[384]); \
        const float ws = wave_sum(o * o); \
        if (lane == 0) *(LAS float*)(lds + DW_OFF + w * 4) = ws; \
        LDS_BARRIER(); \
        const float ss = *(const LAS float*)(lds + DW_OFF + (2 * kg) * 4) + *(const LAS float*)(lds + DW_OFF + (2 * kg + 1) * 4); \
        const float rstd = rsqrtf(ss * (1.0f / 128.0f) + EPS); \
        p.O2[off] = (bf16_t)(pk2(o * rstd * gate, 0.f) & 0xffffu); } while (0)
    if (first < nitems) DEC_PREFETCH(first, sA, lA, qA, vA, sgA, gA);
    if (first + stride < nitems) DEC_PREFETCH(first + stride, sB, lB, qB, vB, sgB, gB);
    for (int itx = first; itx < nitems; itx += 2 * stride) {
        DEC_BODY(itx, sA, lA, qA, vA, sgA, gA);
        if (itx + stride < nitems) DEC_BODY(itx + stride, sB, lB, qB, vB, sgB, gB);
    }
#undef DEC_BODY
#undef DEC_PREFETCH
}
}

namespace att {
constexpr int KS_OFF = 0, KS_STRIDE = 144;
constexpr int VT_OFF = 256 * 144, VT_STRIDE = 528;
struct P { const bf16_t* Qr; const bf16_t* Kb; const bf16_t* Vkv; const float* ck; const float* cv; const float* sinks; bf16_t* O; };

__device__ __forceinline__ void unit(LAS unsigned char* lds, const P& p, bool prompt, int b, int kvh, int qb) {
    const int tid = threadIdx.x, lane = tid & 63, w = __builtin_amdgcn_readfirstlane(tid >> 6), l16 = lane & 15, g = lane >> 4;
    const int h = kvh * 8 + w;
    bf16x8 qn0, qn1;
    { const size_t qrow0 = prompt ? (size_t)(b * TP + 128 * qb + l16) : (size_t)(NPROMPT + 4 * b + min(l16, 3));
      const bf16_t* qp = p.Qr + qrow0 * D + h * 64 + 8 * g; qn0 = *(const bf16x8*)qp; qn1 = *(const bf16x8*)(qp + 32); }
    __syncthreads();
#pragma unroll
    for (int i = 0; i < 4; ++i) {
        const int e = tid + 512 * i;
        {
            const int key = e >> 3, c8 = e & 7; u32x4 kv = (u32x4){0u, 0u, 0u, 0u};
            if (prompt) { if (qb > 0 || key >= 128) kv = *(const u32x4*)(p.Kb + (size_t)(b * TP + 128 * (qb - 1) + key) * 256 + kvh * 64 + c8 * 8); }
            else if (key < 128) { const f32x4* s = (const f32x4*)(p.ck + ((size_t)(b * 128 + key) * 4 + kvh) * 64 + c8 * 8); const f32x4 a = s[0], c = s[1]; kv = (u32x4){pk2(a.x, a.y), pk2(a.z, a.w), pk2(c.x, c.y), pk2(c.z, c.w)}; }
            else if (key < 132) kv = *(const u32x4*)(p.Kb + (size_t)(NPROMPT + 4 * b + key - 128) * 256 + kvh * 64 + c8 * 8);
            if (prompt || key < 160) *(LAS u32x4*)(lds + KS_OFF + key * KS_STRIDE + c8 * 16) = kv;
        }
        {
            const int key = e & 255, c8 = e >> 8; u32x4 vv = (u32x4){0u, 0u, 0u, 0u};
            if (prompt) { if (qb > 0 || key >= 128) vv = *(const u32x4*)(p.Vkv + (size_t)(b * TP + 128 * (qb - 1) + key) * 256 + kvh * 64 + c8 * 8); }
            else if (key < 128) { const f32x4* s = (const f32x4*)(p.cv + ((size_t)(b * 128 + key) * 4 + kvh) * 64 + c8 * 8); const f32x4 a = s[0], c = s[1]; vv = (u32x4){pk2(a.x, a.y), pk2(a.z, a.w), pk2(c.x, c.y), pk2(c.z, c.w)}; }
            else if (key < 132) vv = *(const u32x4*)(p.Vkv + (size_t)(NPROMPT + 4 * b + key - 128) * 256 + kvh * 64 + c8 * 8);
            if (prompt || key < 160) {
                LAS bf16_t* d = (LAS bf16_t*)(lds + VT_OFF + (c8 * 8) * VT_STRIDE + key * 2);
                d[0 * (VT_STRIDE / 2)] = (bf16_t)(vv.x & 0xffffu); d[1 * (VT_STRIDE / 2)] = (bf16_t)(vv.x >> 16);
                d[2 * (VT_STRIDE / 2)] = (bf16_t)(vv.y & 0xffffu); d[3 * (VT_STRIDE / 2)] = (bf16_t)(vv.y >> 16);
                d[4 * (VT_STRIDE / 2)] = (bf16_t)(vv.z & 0xffffu); d[5 * (VT_STRIDE / 2)] = (bf16_t)(vv.z >> 16);
                d[6 * (VT_STRIDE / 2)] = (bf16_t)(vv.w & 0xffffu); d[7 * (VT_STRIDE / 2)] = (bf16_t)(vv.w >> 16);
            }
        }
    }
    __syncthreads();
    const float sink = p.sinks[h];
    const bool hasprev = !prompt || qb > 0;
    const int nqt = prompt ? 8 : 1;
    for (int qt = 0; qt < nqt; ++qt) {
        const int qi = 16 * qt + l16;
        const size_t qrow = prompt ? (size_t)(b * TP + 128 * qb + qi) : (size_t)(NPROMPT + 4 * b + min(l16, 3));
        const bf16x8 qf[2] = {qn0, qn1};
        if (qt + 1 < nqt) { const bf16_t* qp = p.Qr + (qrow + 16) * D + h * 64 + 8 * g; qn0 = *(const bf16x8*)qp; qn1 = *(const bf16x8*)(qp + 32); }
        const int kt0 = 2 * (qt >> 1);
        f32x4 sc[10];
        float mx = -INFINITY;
#pragma unroll
        for (int ti = 0; ti < 10; ++ti) {
            const LAS unsigned char* kr = lds + KS_OFF + (16 * (kt0 + ti) + l16) * KS_STRIDE + 16 * g;
            f32x4 a4 = (f32x4){0.f, 0.f, 0.f, 0.f};
            a4 = __builtin_amdgcn_mfma_f32_16x16x32_bf16(*(const LAS bf16x8*)kr, qf[0], a4, 0, 0, 0);
            a4 = __builtin_amdgcn_mfma_f32_16x16x32_bf16(*(const LAS bf16x8*)(kr + 64), qf[1], a4, 0, 0, 0);
#pragma unroll
            for (int j = 0; j < 4; ++j) {
                const int jk = 16 * (kt0 + ti) + 4 * g + j;
                const bool valid = jk > qi && jk <= qi + 128 && (hasprev || jk >= 128);
                a4[j] = valid ? a4[j] : -INFINITY; mx = fmaxf(mx, a4[j]);
            }
            sc[ti] = a4;
        }
        mx = fmaxf(mx, __shfl_xor(mx, 16)); mx = fmaxf(mx, __shfl_xor(mx, 32)); mx = fmaxf(mx, sink);
        float sum = 0.f;
#pragma unroll
        for (int ti = 0; ti < 10; ++ti)
#pragma unroll
            for (int j = 0; j < 4; ++j) { const float e = __expf(sc[ti][j] - mx); sc[ti][j] = e; sum += e; }
        sum += __shfl_xor(sum, 16); sum += __shfl_xor(sum, 32);
        const float inv = 1.0f / (sum + __expf(sink - mx));
        f32x4 o[4];
#pragma unroll
        for (int dt = 0; dt < 4; ++dt) o[dt] = (f32x4){0.f, 0.f, 0.f, 0.f};
#pragma unroll
        for (int pp = 0; pp < 5; ++pp) {
            const bf16x8 pb = gla::pk8(sc[2 * pp], sc[2 * pp + 1]);
#pragma unroll
            for (int dt = 0; dt < 4; ++dt) {
                const LAS unsigned char* vr = lds + VT_OFF + (16 * dt + l16) * VT_STRIDE + (16 * (kt0 + 2 * pp) + 4 * g) * 2;
                const bf16x8 va = gla::mk8(*(const LAS u32x2*)vr, *(const LAS u32x2*)(vr + 32));
                o[dt] = __builtin_amdgcn_mfma_f32_16x16x32_bf16(va, pb, o[dt], 0, 0, 0);
            }
        }
        if (prompt || l16 < 4) {
#pragma unroll
            for (int dt = 0; dt < 4; ++dt) {
                const f32x4 v = o[dt] * inv; u32x2 wv; wv.x = pk2(v.x, v.y); wv.y = pk2(v.z, v.w);
                *(u32x2*)(p.O + qrow * D + h * 64 + 16 * dt + 4 * g) = wv;
            }
        }
    }
}
}

#define XB_TMO      128
#define XB_XCNT(j)  (256  + 64 * (j))
#define XB_XSUB(j)  (1280 + 64 * (j))
#define XB_XGEN(j)  (2304 + 64 * (j))
#define XB_TOP      3328
#define XB_TOPGEN   3392
#define XCD_BAR_WORDS 3456
#define XB_SPIN_CAP (1u << 18)
__device__ __forceinline__ unsigned xb_ld(unsigned* p)              { return __hip_atomic_load(p, __ATOMIC_RELAXED, __HIP_MEMORY_SCOPE_AGENT); }
__device__ __forceinline__ unsigned xb_add(unsigned* p, unsigned v) { return __hip_atomic_fetch_add(p, v, __ATOMIC_RELAXED, __HIP_MEMORY_SCOPE_AGENT); }
__device__ __forceinline__ unsigned xb_xcc_id() { return (unsigned)__builtin_amdgcn_s_getreg((3 << 11) | 20) & 0xFu; }
#define XB_SPIN(cond, bar) do { unsigned _sp = 0; while (cond) { __builtin_amdgcn_s_sleep(1); \
    if ((++_sp & 255u) == 0u) { if (xb_ld(&(bar)[XB_TMO])) break; if (_sp > XB_SPIN_CAP) { atomicAdd(&(bar)[XB_TMO], 1u); break; } } } } while (0)
struct XcdBarrier { unsigned* bar; unsigned x; volatile LAS unsigned* st; };
__device__ __forceinline__ XcdBarrier xcd_barrier_post(unsigned* bar, volatile LAS unsigned* st) {
    XcdBarrier b; b.bar = bar; b.x = xb_xcc_id(); b.st = st;
    if (threadIdx.x == 0) (void)xb_add(&bar[XB_XCNT(b.x)], 1u);
    return b;
}
__device__ __forceinline__ void xcd_barrier_complete(unsigned* bar, unsigned x, unsigned& nloc, unsigned& nx) {
    const unsigned G = gridDim.x * gridDim.y * gridDim.z;
    unsigned sum, cnt, mine, sp = 0u;
    for (;;) {
        sum = 0u; cnt = 0u; mine = 0u;
#pragma unroll
        for (unsigned j = 0; j < 16; ++j) { const unsigned c = xb_ld(&bar[XB_XCNT(j)]); sum += c; cnt += (c > 0u) ? 1u : 0u; mine = (j == x) ? c : mine; }
        if (sum == G) break;
        __builtin_amdgcn_s_sleep(1);
        if ((++sp & 255u) == 0u) { if (xb_ld(&bar[XB_TMO])) break; if (sp > XB_SPIN_CAP) { atomicAdd(&bar[XB_TMO], 1u); break; } }
    }
    nloc = mine > 0u ? mine : 1u; nx = cnt > 0u ? cnt : 1u;
}
__device__ __forceinline__ void xcd_barrier(const XcdBarrier& b) {
    asm volatile("s_waitcnt vmcnt(0)" ::: "memory");
    __syncthreads();
    if (threadIdx.x == 0) {
        unsigned* bar = b.bar;
        __builtin_amdgcn_s_waitcnt(0);
        unsigned nloc = b.st[0], nx = b.st[1];
        if (nloc == 0u) { xcd_barrier_complete(bar, b.x, nloc, nx); b.st[0] = nloc; b.st[1] = nx; }
        const unsigned old = xb_add(&bar[XB_XSUB(b.x)], 1u);
        const unsigned gen = old / nloc;
        if (old + 1u == (gen + 1u) * nloc) {
            __builtin_amdgcn_fence(__ATOMIC_RELEASE, "agent");
            asm volatile("s_waitcnt vmcnt(0)" ::: "memory");
            const unsigned og = xb_add(&bar[XB_TOP], 1u);
            const unsigned tg = og / nx;
            if (og + 1u == (tg + 1u) * nx) xb_add(&bar[XB_TOPGEN], 1u);
            else XB_SPIN(xb_ld(&bar[XB_TOPGEN]) == tg, bar);
            __builtin_amdgcn_fence(__ATOMIC_ACQUIRE, "agent");
            xb_add(&bar[XB_XGEN(b.x)], 1u);
            asm volatile("s_waitcnt vmcnt(0)" ::: "memory");
        } else {
            XB_SPIN(xb_ld(&bar[XB_XGEN(b.x)]) == gen, bar);
            __builtin_amdgcn_fence(__ATOMIC_ACQUIRE, "agent");
            asm volatile("s_waitcnt vmcnt(0)" ::: "memory");
        }
    }
    __syncthreads();
}

struct Args { const float* in[20]; float* out; unsigned char* ws; int ph_lo, ph_hi; };
constexpr int N_PHASES = 16;

__global__ void __launch_bounds__(NWAVES * 64, 2) mk_fwd(Args args) {
    extern __shared__ __attribute__((aligned(16))) unsigned char lds_raw[];
    LAS unsigned char* lds = (LAS unsigned char*)lds_raw;
    cg::grid_group grid = cg::this_grid();
    const int tid = threadIdx.x, lane = tid & 63, wave = __builtin_amdgcn_readfirstlane(tid >> 6);
    const int G = gridDim.x, cb = blockIdx.x;
    const int gw = cb * NWAVES + wave, NGW = G * NWAVES;
    unsigned char* ws = args.ws;
    const float* x_prompt = args.in[0]; const float* x_sample = args.in[1]; const float* state_in = args.in[2]; const float* cache_k = args.in[3]; const float* cache_v = args.in[4];
    const float* g_mix_pre = args.in[5]; const float* g_mix_post = args.in[6]; const float* g_ffn_pre = args.in[7]; const float* g_ffn_post = args.in[8];
    const float* w_in = args.in[9]; const float* lbraw = args.in[10]; const float* g_hnorm = args.in[11]; const float* w_hout = args.in[12];
    const float* g_kv = args.in[13]; const float* w_kv = args.in[14]; const float* w_q = args.in[15]; const float* sinks = args.in[16]; const float* w_ao = args.in[17];
    const float* w_gu = args.in[18]; const float* w_dn = args.in[19];
    bf16_t* Win_t = (bf16_t*)(ws + WS_WIN); bf16_t* Wout_t = (bf16_t*)(ws + WS_WOUT); bf16_t* Wkv_t = (bf16_t*)(ws + WS_WKV); bf16_t* Wq_t = (bf16_t*)(ws + WS_WQ); bf16_t* Wao_t = (bf16_t*)(ws + WS_WAO);
    bf16_t* Wgu_t[2] = {(bf16_t*)(ws + WS_WGU0), (bf16_t*)(ws + WS_WGU1)}; bf16_t* Wd_t[2] = {(bf16_t*)(ws + WS_WD0), (bf16_t*)(ws + WS_WD1)};
    f32x2* rope = (f32x2*)(ws + WS_ROPE);
    bf16_t* XN = (bf16_t*)(ws + WS_XN); bf16_t* O2 = (bf16_t*)(ws + WS_O2); bf16_t* Y = (bf16_t*)(ws + WS_Y);
    bf16_t* Qs = (bf16_t*)(ws + WS_QS); float* LOGF = (float*)(ws + WS_LOGF); bf16_t* Vb = (bf16_t*)(ws + WS_VB); bf16_t* SG = (bf16_t*)(ws + WS_SG);
    bf16_t* Hact = (bf16_t*)(ws + WS_HACT);
    bf16_t* XKV = (bf16_t*)(ws + WS_XKV); bf16_t* Qr = (bf16_t*)(ws + WS_QR); bf16_t* Kb = (bf16_t*)(ws + WS_KB); bf16_t* Vkv = (bf16_t*)(ws + WS_VKV);
    float* out = args.out; float* H = out + OUT_Y; bf16_t* Hb = (bf16_t*)(ws + WS_HB);
    float* slab = (float*)(ws + WS_SLAB); unsigned* cntw = (unsigned*)(ws + WS_CNT);
    const int lo = args.ph_lo, hi = args.ph_hi;
    LAS float* scr = (LAS float*)(lds + wave * 16384);
    constexpr int I_IN = 32 * 256, I_SQ = 32 * 64, I_KV = 32 * 16, I_GU = 32 * 352, I_DN = 88 * 64;
#define IN(k) (lo <= (k) && (k) < hi)
#define SEAM(k) do { if (IN(k) && IN((k) + 1)) { if (lo < 0) grid.sync(); else xcd_barrier(bar); } } while (0)
    volatile LAS unsigned* MISC = (volatile LAS unsigned*)(lds + 131072 + 320);
    if (tid < 32) MISC[tid] = 0u;
    __syncthreads();
    XcdBarrier bar; bar.bar = (unsigned*)ws; bar.x = 0; bar.st = nullptr;
    if (hi - lo > 1) bar = xcd_barrier_post((unsigned*)ws, MISC + 8);

    if (IN(0)) {
        cvt_stream<false>(w_in, D, 4 * D, Win_t, scr, gw, NGW, I_IN, lane);
        for (int e = cb * 512 + tid; e < (TP + TS) * 8; e += G * 512) {
            const int idx = e >> 3, f = e & 7; const double pos = idx < TP ? (double)idx : (double)(8192 + idx - TP);
            const double invf[8] = {1.0, 0.19392274474868576, 0.03760603093086393, 0.007292664737217109, 0.001414213562373095, 0.0002742481756762073, 5.318295896944988e-05, 1.031338537721246e-05};
            double iv = invf[0];
#pragma unroll
            for (int q = 1; q < 8; ++q) iv = f == q ? invf[q] : iv;
            const double ang = pos * (double)(float)iv;
            const double TWO_PI = 6.283185307179586476925286766559;
            const double r = ang - TWO_PI * __builtin_rint(ang / TWO_PI);
            const double r2 = r * r;
            double sn = 0.0, cs = 0.0;
#pragma unroll
            for (int k = 14; k >= 1; --k) { sn = (1.0 - sn) * r2 / (double)((2 * k) * (2 * k + 1)); cs = (1.0 - cs) * r2 / (double)((2 * k - 1) * (2 * k)); }
            rope[e] = (f32x2){(float)(1.0 - cs), (float)(r * (1.0 - sn))};
        }
        for (int m = gw; m < M; m += NGW) {
            const float* xr = m < NPROMPT ? x_prompt + (size_t)m * D : x_sample + (size_t)(m - NPROMPT) * D;
            row_pass<false, true, false>(xr, nullptr, nullptr, nullptr, g_mix_pre, XN + (size_t)m * D, nullptr, nullptr, lane);
        }
    }
    SEAM(0);
    if (IN(1)) {
        pg8::Gemm g{XN, Win_t, M, 4 * D, D}; pg8::StaticOrder S; S.init(M, 4 * D, G, cb, D);
        pg8::EpiIn E{Qs, LOGF, Vb, SG, lbraw};
        pg8::gemm_phase<pg8::EpiIn, pg8::StaticOrder, true, true>(lds, g, S, E);
        if (cb >= 64) {
            const int wv_ = (cb - 64) * NWAVES + wave;
            if (wv_ < 256) cvt_stream<false>(w_hout, D, D, Wout_t, scr, wv_, 256, I_SQ, lane);
            else if (wv_ < 512) cvt_stream<false>(w_q, D, D, Wq_t, scr, wv_ - 256, 256, I_SQ, lane);
            else if (wv_ < 768) cvt_stream<false>(w_ao, D, D, Wao_t, scr, wv_ - 512, 256, I_SQ, lane);
            else if (wv_ < 832) cvt_stream<false>(w_kv, D, 512, Wkv_t, scr, wv_ - 768, 64, I_KV, lane);
            else cvt_stream<false>(w_dn, DFF, D, Wd_t[0], scr, wv_ - 832, 704, I_DN, lane);
        }
    }
    SEAM(1);
    gla::P gp{Qs, LOGF, Vb, SG, g_hnorm, O2, ws + WS_GQT, ws + WS_GKH, ws + WS_GVT, ws + WS_GPS, ws + WS_GDEC};
    if (IN(2)) {
        gla::intra_items(lds, gp, cb, G, 2048);
    }
    SEAM(2);
    if (IN(3)) {
        const int nA = 64;
        if (cb < nA) gla::scan_seq(lds, gp, cb, out + OUT_SP + (size_t)cb * 16384, 32);
        else {
            gla::decode_items(lds, gp, state_in, out + OUT_SS, cb - nA, G - nA, BS * 16);
            __syncthreads();
            cvt_stream<true>(w_gu, D, 2 * DFF, Wgu_t[0], scr, (cb - nA) * NWAVES + wave, (G - nA) * NWAVES, I_GU, lane);
        }
    }
    SEAM(3);
    if (IN(4)) {
        pg8::Gemm g{O2, Wout_t, M, D, D}; pg8::SplitOrder S; S.init(D, G, cb, D);
        pg8::EpiF32 E{Y, D, slab, cntw + 0 * 1024};
        pg8::gemm_phase<pg8::EpiF32, pg8::SplitOrder, true, true>(lds, g, S, E);
    }
    SEAM(4);
    if (IN(5)) {
        for (int m = gw; m < M; m += NGW) {
            const float* xr = m < NPROMPT ? x_prompt + (size_t)m * D : x_sample + (size_t)(m - NPROMPT) * D;
            row_pass<true, true, false, false, true>(xr, Y + (size_t)m * D, g_mix_post, Hb + (size_t)m * D, g_ffn_pre, XN + (size_t)m * D, nullptr, nullptr, lane);
        }
    }
    SEAM(5);
    if (IN(6)) {
        pg8::Gemm g{XN, Wgu_t[0], M, 2 * DFF, D}; pg8::StaticOrder S; S.init(M, 2 * DFF, G, cb, D);
        pg8::EpiSwiGLU E{Hact};
        pg8::gemm_phase<pg8::EpiSwiGLU, pg8::StaticOrder, true, true>(lds, g, S, E);
    }
    SEAM(6);
    if (IN(7)) {
        pg8::Gemm g{Hact, Wd_t[0], M, D, DFF}; pg8::SplitOrder S; S.init(D, G, cb, DFF);
        pg8::EpiF32 E{Y, D, slab, cntw + 1 * 1024};
        pg8::gemm_phase<pg8::EpiF32, pg8::SplitOrder, true, true>(lds, g, S, E);
    }
    SEAM(7);
    if (IN(8)) {
        for (int m = gw; m < M; m += NGW)
            row_pass<true, true, true, true, true>(Hb + (size_t)m * D, Y + (size_t)m * D, g_ffn_post, Hb + (size_t)m * D, g_mix_pre + D, XN + (size_t)m * D, g_kv, XKV + (size_t)m * D, lane);
    }
    SEAM(8);
    if (IN(9)) {
        { pg8::Gemm g{XKV, Wkv_t, M, 512, D}; pg8::StaticOrder S; S.init(M, 512, G, cb, D);
          pg8::EpiRope<1> E{Kb, Vkv, rope, out + OUT_KWIN, out + OUT_VWIN, out + OUT_KNEW, out + OUT_VNEW};
          pg8::gemm_phase<pg8::EpiRope<1>, pg8::StaticOrder, true, true>(lds, g, S, E); }
        { pg8::Gemm g{XN, Wq_t, M, D, D}; pg8::StaticOrder S; S.init(M, D, G, (cb + G - (68 % G)) % G, D);
          pg8::EpiRope<0> E{Qr, nullptr, rope, nullptr, nullptr, nullptr, nullptr};
          pg8::gemm_phase<pg8::EpiRope<0>, pg8::StaticOrder, true, true>(lds, g, S, E); }
        if (cb >= 84) {
            const int wv_ = (cb - 84) * NWAVES + wave;
            if (wv_ < 917) cvt_stream<true>(w_gu + (size_t)D * 2 * DFF, D, 2 * DFF, Wgu_t[1], scr, wv_, 917, I_GU, lane);
            else cvt_stream<false>(w_dn + (size_t)DFF * D, DFF, D, Wd_t[1], scr, wv_ - 917, 459, I_DN, lane);
        }
    }
    SEAM(9);
    if (IN(10)) {
        att::P ap{Qr, Kb, Vkv, cache_k, cache_v, sinks, O2};
        for (int u = cb; u < 256 + 512; u += G) {
            if (u < 256) att::unit(lds, ap, true, u >> 6, (u >> 4) & 3, u & 15);
            else { const int v = u - 256; att::unit(lds, ap, false, v >> 2, v & 3, 0); }
        }
    }
    SEAM(10);
    if (IN(11)) {
        pg8::Gemm g{O2, Wao_t, M, D, D}; pg8::SplitOrder S; S.init(D, G, cb, D);
        pg8::EpiF32 E{Y, D, slab, cntw + 2 * 1024};
        pg8::gemm_phase<pg8::EpiF32, pg8::SplitOrder, true, true>(lds, g, S, E);
    }
    SEAM(11);
    if (IN(12)) {
        for (int m = gw; m < M; m += NGW)
            row_pass<true, true, false, true, true>(Hb + (size_t)m * D, Y + (size_t)m * D, g_mix_post + D, Hb + (size_t)m * D, g_ffn_pre + D, XN + (size_t)m * D, nullptr, nullptr, lane);
    }
    SEAM(12);
    if (IN(13)) {
        pg8::Gemm g{XN, Wgu_t[1], M, 2 * DFF, D}; pg8::StaticOrder S; S.init(M, 2 * DFF, G, cb, D);
        pg8::EpiSwiGLU E{Hact};
        pg8::gemm_phase<pg8::EpiSwiGLU, pg8::StaticOrder, true, true>(lds, g, S, E);
    }
    SEAM(13);
    if (IN(14)) {
        pg8::Gemm g{Hact, Wd_t[1], M, D, DFF}; pg8::SplitOrder S; S.init(D, G, cb, DFF);
        pg8::EpiF32 E{Y, D, slab, cntw + 3 * 1024};
        pg8::gemm_phase<pg8::EpiF32, pg8::SplitOrder, true, true>(lds, g, S, E);
    }
    SEAM(14);
    if (IN(15)) {
        for (int m = gw; m < M; m += NGW)
            row_pass<true, false, false, true, false>(Hb + (size_t)m * D, Y + (size_t)m * D, g_ffn_post + D, H + (size_t)m * D, nullptr, nullptr, nullptr, nullptr, lane);
    }
#undef IN
#undef SEAM
}

extern "C" void kernel_launch(void* const* d_in, const int* in_sizes, int n_in, void* d_out, int out_size, void* d_ws, size_t ws_size, hipStream_t stream) {
    static int grid = 0;
    if (grid == 0) {
        if (n_in != 20 || (size_t)out_size != OUT_END || ws_size < WS_END) { fprintf(stderr, "kernel_launch: unexpected shapes: n_in %d out %d ws %zu (need %zu)\n", n_in, out_size, ws_size, (size_t)WS_END); grid = -1; return; }
        int dev = 0, cus = 0, per_cu = 0;
        hipGetDevice(&dev); hipDeviceGetAttribute(&cus, hipDeviceAttributeMultiprocessorCount, dev);
        if (hipFuncSetAttribute((const void*)mk_fwd, hipFuncAttributeMaxDynamicSharedMemorySize, LDS_BYTES) != hipSuccess) { fprintf(stderr, "kernel_launch: hipFuncSetAttribute failed\n"); grid = -1; return; }
        hipOccupancyMaxActiveBlocksPerMultiprocessor(&per_cu, (const void*)mk_fwd, NWAVES * 64, LDS_BYTES);
        (void)hipGetLastError();
        if (per_cu < 1) per_cu = 1;
        if (cus < 256) { fprintf(stderr, "kernel_launch: built for a 256-CU device (got %d)\n", cus); grid = -1; return; }
        grid = 256;
        fprintf(stderr, "kernel_launch: cus %d per_cu %d grid %d\n", cus, per_cu, grid);
    }
    if (grid < 0) return;
    if (hipMemsetAsync(d_ws, 0, 131072, stream) != hipSuccess) { fprintf(stderr, "kernel_launch: memset failed\n"); return; }
    Args a{};
    for (int i = 0; i < 20; ++i) a.in[i] = (const float*)d_in[i];
    a.out = (float*)d_out; a.ws = (unsigned char*)d_ws;
#if MK_ONE_LAUNCH
    void* kargs[] = {&a};
    a.ph_lo = 0; a.ph_hi = N_PHASES;
    hipError_t e = hipLaunchCooperativeKernel((const void*)mk_fwd, dim3(grid), dim3(NWAVES * 64), kargs, LDS_BYTES, stream);
    if (e != hipSuccess) fprintf(stderr, "kernel_launch: cooperative launch failed: %s\n", hipGetErrorString(e));
#else
    for (int ph = 0; ph < N_PHASES; ++ph) {
        a.ph_lo = ph; a.ph_hi = ph + 1;
        hipLaunchKernelGGL(mk_fwd, dim3(grid), dim3(NWAVES * 64), LDS_BYTES, stream, a);
    }
#endif
}
```

```cpp
#include <hip/hip_runtime.h>
#include <hip/hip_cooperative_groups.h>
#include <cstdio>
#include <cstdint>
namespace cg = cooperative_groups;

#ifndef MK_ONE_LAUNCH
#define MK_ONE_LAUNCH 1
#endif

#define LAS __attribute__((address_space(3)))
typedef unsigned short bf16_t;
typedef short bf16x8 __attribute__((ext_vector_type(8)));
typedef float f32x4 __attribute__((ext_vector_type(4)));
typedef float f32x2 __attribute__((ext_vector_type(2)));
typedef unsigned u32x4 __attribute__((ext_vector_type(4)));
typedef unsigned u32x2 __attribute__((ext_vector_type(2)));
typedef __bf16 bf16x2_t __attribute__((ext_vector_type(2)));

constexpr int D = 2048, NPROMPT = 8192, NSAMPLE = 512, M = NPROMPT + NSAMPLE;
constexpr int TP = 2048, TS = 4, BS = 128;
constexpr int DFF = 5632;
constexpr float EPS = 1e-6f;

__device__ __forceinline__ unsigned pk2(float lo, float hi) { f32x2 v = {lo, hi}; bf16x2_t b = __builtin_convertvector(v, bf16x2_t); return __builtin_bit_cast(unsigned, b); }
__device__ __forceinline__ float bf2f(unsigned b) { return __uint_as_float(b << 16); }
__device__ __forceinline__ float silu_f(float x) { return x * __builtin_amdgcn_rcpf(1.0f + __expf(-x)); }
__device__ __forceinline__ float wave_sum(float v) {
#pragma unroll
    for (int o = 1; o < 64; o <<= 1) v += __shfl_xor(v, o);
    return v;
}

namespace pg8 {
constexpr int BM = 256, BK = 64, HALF = 128, HTB = HALF * BK * 2, STAGE_BYTES = 8 * HTB, NXCD = 8, WGM = 8;
__host__ __device__ __forceinline__ int lds_byte(int r, int c) { const int st = (r >> 4) * 2 + (c >> 5), rr = r & 15, cc = c & 31, ob = rr * 64 + cc * 2; return st * 1024 + (ob ^ (((ob >> 9) & 1) << 5)); }
__host__ __device__ __forceinline__ void stage_rc(int b, int& R, int& C) { const int st = b / 1024, sb = b % 1024, swz = sb ^ (((sb >> 9) & 1) << 5); R = (st >> 1) * 16 + swz / 64; C = (st & 1) * 32 + (swz % 64) / 2; }
__host__ __device__ __forceinline__ int perm32(int rho) { const int n = rho >> 4, i = rho & 15; return 8 * (i >> 2) + 4 * n + (i & 3); }

struct Unit { int pm, pn, kt0, nt, split, uid; };
struct Gemm { const bf16_t* A; const bf16_t* Bt; int M, N, K; };

struct StaticOrder {
    int nM, nN, nwg, G, c, ntk;
    __host__ __device__ void init(int M_, int N_, int G_, int c_, int K_) { nM = M_ / BM; nN = N_ / BM; nwg = nM * nN; G = G_; c = c_; ntk = K_ / BK; }
    __host__ __device__ bool next(int i, Unit& u) const {
        const long L = (long)i * G + c; if (L >= nwg) return false;
        u.kt0 = 0; u.nt = ntk; u.split = -1; u.uid = 0;
        int wgid = (int)L; { const int q = nwg / NXCD, r = nwg % NXCD, xcd = wgid % NXCD, off = wgid / NXCD; wgid = (xcd < r ? xcd * (q + 1) : r * (q + 1) + (xcd - r) * q) + off; }
        const int nig = WGM * nN, gid = wgid / nig, fm = gid * WGM, gsz = (nM - fm) < WGM ? (nM - fm) : WGM;
        u.pm = fm + ((wgid % nig) % gsz); u.pn = (wgid % nig) / gsz; return true;
    }
    __device__ __forceinline__ void a_ready(const Unit&) const {}
    __device__ __forceinline__ void done(const Unit&) const {}
};

struct SplitOrder {
    StaticOrder so; int c;
    __host__ __device__ void init(int N_, int G_, int c_, int K_) { so.init(8192, N_, G_, c_, K_); c = c_; }
    __host__ __device__ bool next(int i, Unit& u) const {
        if (i == 0) return so.next(0, u);
        if (i == 1 && c < 128) { const int j = c >> 3, sp = c & 7; u.pm = 32 + (j >> 3); u.pn = j & 7; u.split = sp; u.uid = j;
            if (so.ntk == 32) { u.kt0 = 4 * sp; u.nt = 4; } else { u.kt0 = sp < 4 ? 12 * sp : 48 + 10 * (sp - 4); u.nt = sp < 4 ? 12 : 10; }
            return true; }
        return false;
    }
    __device__ __forceinline__ void a_ready(const Unit&) const {}
    __device__ __forceinline__ void done(const Unit&) const {}
};


struct EpiIn {
    static constexpr bool PERM = true, AFTER_DRAIN = false;
    bf16_t* Qs; float* LOGF; bf16_t* Vb; bf16_t* SG; const float* lbraw;
    __device__ __forceinline__ void operator()(const f32x4 (&acc)[2][2][4][2], const Unit& u, int wr, int wc, int fr, int fq) const {
        const int seg = u.pn >> 3;
        const int row0 = u.pm * BM + wr * 64 + fr;
        const int col0 = (u.pn & 7) * BM + wc * 32 + 8 * fq;
        if (seg == 1) {
#pragma unroll
            for (int bj = 0; bj < 2; ++bj) {
                const int c = col0 + bj * HALF;
                float lb[8];
#pragma unroll
                for (int e = 0; e < 8; ++e) { const float a0 = lbraw[c + e], a1 = lbraw[D + c + e]; lb[e] = __builtin_amdgcn_rcpf(1.0f + __expf(a1 - a0)); }
#pragma unroll
                for (int ai = 0; ai < 2; ++ai)
#pragma unroll
                    for (int m = 0; m < 4; ++m) {
                        float* dst = LOGF + (size_t)(row0 + ai * HALF + m * 16) * D + c;
                        f32x4 o0, o1;
#pragma unroll
                        for (int j = 0; j < 4; ++j) {
                            const float s0 = __builtin_amdgcn_rcpf(1.0f + __expf(-acc[ai][bj][m][0][j])), s1 = __builtin_amdgcn_rcpf(1.0f + __expf(-acc[ai][bj][m][1][j]));
                            o0[j] = __logf(lb[j] + (1.0f - lb[j]) * s0); o1[j] = __logf(lb[4 + j] + (1.0f - lb[4 + j]) * s1);
                        }
                        *(f32x4*)dst = o0; *(f32x4*)(dst + 4) = o1;
                    }
            }
        } else {
            bf16_t* base = Qs + (size_t)seg * ((size_t)M * D);
#pragma unroll
            for (int ai = 0; ai < 2; ++ai)
#pragma unroll
                for (int m = 0; m < 4; ++m)
#pragma unroll
                    for (int bj = 0; bj < 2; ++bj) {
                        f32x4 v0 = acc[ai][bj][m][0], v1 = acc[ai][bj][m][1];
                        if (seg != 2) {
#pragma unroll
                            for (int j = 0; j < 4; ++j) { v0[j] = silu_f(v0[j]); v1[j] = silu_f(v1[j]); }
                        }
                        u32x4 w; w.x = pk2(v0[0], v0[1]); w.y = pk2(v0[2], v0[3]); w.z = pk2(v1[0], v1[1]); w.w = pk2(v1[2], v1[3]);
                        *(u32x4*)(base + (size_t)(row0 + ai * HALF + m * 16) * D + col0 + bj * HALF) = w;
                    }
        }
    }
};
struct EpiF32 {
    static constexpr bool PERM = true, AFTER_DRAIN = false;
    bf16_t* Y; int ldc; float* slab; unsigned* cnt;
    __device__ __forceinline__ void operator()(const f32x4 (&acc)[2][2][4][2], const Unit& u, int wr, int wc, int fr, int fq) const {
        const int row0 = u.pm * BM + wr * 64 + fr, col0 = u.pn * BM + wc * 32 + 8 * fq;
        if (u.split < 0) {
#pragma unroll
            for (int ai = 0; ai < 2; ++ai)
#pragma unroll
                for (int m = 0; m < 4; ++m)
#pragma unroll
                    for (int bj = 0; bj < 2; ++bj) {
                        const f32x4 v0 = acc[ai][bj][m][0], v1 = acc[ai][bj][m][1];
                        u32x4 w4; w4.x = pk2(v0[0], v0[1]); w4.y = pk2(v0[2], v0[3]); w4.z = pk2(v1[0], v1[1]); w4.w = pk2(v1[2], v1[3]);
                        *(u32x4*)(Y + (size_t)(row0 + ai * HALF + m * 16) * ldc + col0 + bj * HALF) = w4;
                    }
            return;
        }
        const int tid = threadIdx.x;
        f32x4* mine = (f32x4*)(slab + (size_t)(u.uid * 8 + u.split) * 65536) + tid;
#pragma unroll
        for (int ai = 0; ai < 2; ++ai)
#pragma unroll
            for (int m = 0; m < 4; ++m)
#pragma unroll
                for (int bj = 0; bj < 2; ++bj)
#pragma unroll
                    for (int n = 0; n < 2; ++n) mine[(((ai * 4 + m) * 2 + bj) * 2 + n) * 512] = acc[ai][bj][m][n];
        __threadfence();
        __syncthreads();
        if (tid == 0) {
            unsigned* cw = cnt + 64 * u.uid;
            __hip_atomic_fetch_add(cw, 1u, __ATOMIC_RELAXED, __HIP_MEMORY_SCOPE_AGENT);
            unsigned sp = 0;
            while (__hip_atomic_load(cw, __ATOMIC_RELAXED, __HIP_MEMORY_SCOPE_AGENT) < 8u) { __builtin_amdgcn_s_sleep(2); if (++sp > (1u << 22)) break; }
            __threadfence();
        }
        __syncthreads();
        const int ai = u.split >> 2, m = u.split & 3;
        f32x4 sum[2][2];
#pragma unroll
        for (int bj = 0; bj < 2; ++bj)
#pragma unroll
            for (int n = 0; n < 2; ++n) sum[bj][n] = (f32x4){0.f, 0.f, 0.f, 0.f};
        const f32x4* base = (const f32x4*)(slab + (size_t)(u.uid * 8) * 65536) + tid + (size_t)(u.split * 4) * 512;
#pragma unroll
        for (int sp = 0; sp < 8; ++sp)
#pragma unroll
            for (int bj = 0; bj < 2; ++bj)
#pragma unroll
                for (int n = 0; n < 2; ++n) sum[bj][n] += base[(size_t)sp * 16384 + (bj * 2 + n) * 512];
#pragma unroll
        for (int bj = 0; bj < 2; ++bj) {
            const f32x4 v0 = sum[bj][0], v1 = sum[bj][1];
            u32x4 w4; w4.x = pk2(v0[0], v0[1]); w4.y = pk2(v0[2], v0[3]); w4.z = pk2(v1[0], v1[1]); w4.w = pk2(v1[2], v1[3]);
            *(u32x4*)(Y + (size_t)(row0 + ai * HALF + m * 16) * ldc + col0 + bj * HALF) = w4;
        }
    }
};
struct EpiSwiGLU {
    static constexpr bool PERM = true, AFTER_DRAIN = false;
    bf16_t* Hact;
    __device__ __forceinline__ void operator()(const f32x4 (&acc)[2][2][4][2], const Unit& u, int wr, int wc, int fr, int fq) const {
        const int row0 = u.pm * BM + wr * 64 + fr, col0 = u.pn * HALF + wc * 32 + 8 * fq;
#pragma unroll
        for (int ai = 0; ai < 2; ++ai)
#pragma unroll
            for (int m = 0; m < 4; ++m) {
                f32x4 v0, v1;
#pragma unroll
                for (int j = 0; j < 4; ++j) { v0[j] = silu_f(acc[ai][0][m][0][j]) * acc[ai][1][m][0][j]; v1[j] = silu_f(acc[ai][0][m][1][j]) * acc[ai][1][m][1][j]; }
                u32x4 w; w.x = pk2(v0[0], v0[1]); w.y = pk2(v0[2], v0[3]); w.z = pk2(v1[0], v1[1]); w.w = pk2(v1[2], v1[3]);
                *(u32x4*)(Hact + (size_t)(row0 + ai * HALF + m * 16) * DFF + col0) = w;
            }
    }
};
template <int MODE> struct EpiRope {
    static constexpr bool PERM = true, AFTER_DRAIN = false;
    bf16_t* O0; bf16_t* O1; const f32x2* rope;
    float* kwin; float* vwin; float* knew; float* vnew;
    __device__ __forceinline__ void operator()(const f32x4 (&accin)[2][2][4][2], const Unit& u, int wr, int wc, int fr, int fq) const {
        const int row0 = u.pm * BM + wr * 64 + fr;
        const bool do_rope = (MODE == 0 || u.pn == 0) && ((wc & 1) == 0);
        const float scale = MODE == 0 ? 0.125f : 1.0f;
#pragma unroll
        for (int ai = 0; ai < 2; ++ai)
#pragma unroll
            for (int m = 0; m < 4; ++m) {
                const int row = row0 + ai * HALF + m * 16;
                f32x4 v[2][2];
#pragma unroll
                for (int bj = 0; bj < 2; ++bj) { v[bj][0] = accin[ai][bj][m][0]; v[bj][1] = accin[ai][bj][m][1]; }
                if (do_rope) {
                    const int idx = row < NPROMPT ? (row & (TP - 1)) : (TP + (row & 3));
                    const f32x4* rp = (const f32x4*)(rope + (size_t)idx * 8);
                    f32x4 cs[4];
#pragma unroll
                    for (int q = 0; q < 4; ++q) cs[q] = rp[q];
#pragma unroll
                    for (int bj = 0; bj < 2; ++bj)
#pragma unroll
                        for (int n = 0; n < 2; ++n)
#pragma unroll
                            for (int j = 0; j < 4; ++j) {
                                const int f = 4 * n + j;
                                const float c = cs[f >> 1][(f & 1) * 2], s = cs[f >> 1][(f & 1) * 2 + 1];
                                const float x = v[bj][n][j];
                                const float px = __shfl_xor(x, 16);
                                const float r = fq == 0 ? x * c - px * s : x * c + px * s;
                                v[bj][n][j] = fq < 2 ? r : x;
                            }
                }
#pragma unroll
                for (int bj = 0; bj < 2; ++bj) {
                    const f32x4 a = v[bj][0] * scale, b = v[bj][1] * scale;
                    u32x4 w; w.x = pk2(a[0], a[1]); w.y = pk2(a[2], a[3]); w.z = pk2(b[0], b[1]); w.w = pk2(b[2], b[3]);
                    const int ct = bj * HALF + wc * 32 + 8 * fq;
                    if (MODE == 0) {
                        *(u32x4*)(O0 + (size_t)row * D + u.pn * BM + ct) = w;
                    } else {
                        bf16_t* ob = u.pn == 0 ? O0 : O1;
                        *(u32x4*)(ob + (size_t)row * 256 + ct) = w;
                        float* fo = nullptr;
                        if (u.pm >= NPROMPT / BM) fo = (u.pn == 0 ? knew : vnew) + (size_t)(row - NPROMPT) * 256 + ct;
                        else if ((u.pm & 7) == 7 && ai == 1) fo = (u.pn == 0 ? kwin : vwin) + (size_t)((u.pm >> 3) * 128 + (row & 127)) * 256 + ct;
                        if (fo) { *(f32x4*)fo = a; *(f32x4*)(fo + 4) = b; }
                    }
                }
            }
    }
};

template <class Epi, class Sched, bool ALIGN_EPI = false, bool SP2 = false>
__device__ __forceinline__ void gemm_phase(LAS unsigned char* lds, const Gemm g, const Sched& S, const Epi& E) {
    const int tid = threadIdx.x, wid = __builtin_amdgcn_readfirstlane(tid >> 6), lane = tid & 63, wr = wid >> 2, wc = wid & 3, fr = lane & 15, fq = lane >> 4;
    const int K = g.K;
    unsigned voffA[2], voffB[2];
#pragma unroll
    for (int i = 0; i < 2; ++i) { int R, C; stage_rc(tid * 16 + i * 8192, R, C); const int Rb = Epi::PERM ? ((R & ~31) + perm32(R & 31)) : R;
        voffA[i] = (unsigned)(R * K + C) * 2u; voffB[i] = (unsigned)(Rb * K + C) * 2u; }
    const size_t kstep = (size_t)(BK * 2);
    const size_t hstep = (size_t)HALF * K * 2;
    const size_t tstep = 2 * hstep;
    const unsigned ldsw = (unsigned)wid * 1024u;
    const int aoff = lds_byte(wr * 64 + fr, fq * 8), boff = lds_byte(wc * 32 + fr, fq * 8);
#define PG8_SA(b, h) (((b) * 2 + (h)) * HTB)
#define PG8_SB(b, h) ((4 + (b) * 2 + (h)) * HTB)
#define PG8_STAGE(bufoff, gbase, voff) do { _Pragma("unroll") for (int _i = 0; _i < 2; ++_i) \
        __builtin_amdgcn_global_load_lds((const unsigned*)((const char*)(gbase) + (voff)[_i]), (LAS unsigned*)(lds + (bufoff) + ldsw + _i * 8192), 16, 0, 0); } while (0)
#define PG8_LDA(dst, b, h) do { _Pragma("unroll") for (int m = 0; m < 4; ++m) _Pragma("unroll") for (int k = 0; k < 2; ++k) dst[m][k] = *(const LAS bf16x8*)(lds + PG8_SA(b, h) + aoff + m * 2048 + k * 1024); } while (0)
#define PG8_LDB(dst, b, h) do { _Pragma("unroll") for (int n = 0; n < 2; ++n) _Pragma("unroll") for (int k = 0; k < 2; ++k) dst[n][k] = *(const LAS bf16x8*)(lds + PG8_SB(b, h) + boff + n * 2048 + k * 1024); } while (0)
#define PG8_MMA(ai, bj, At, Bt) do { __builtin_amdgcn_s_setprio(1); _Pragma("unroll") for (int m = 0; m < 4; ++m) _Pragma("unroll") for (int n = 0; n < 2; ++n) _Pragma("unroll") for (int k = 0; k < 2; ++k) \
        acc[ai][bj][m][n] = __builtin_amdgcn_mfma_f32_16x16x32_bf16(Bt[n][k], At[m][k], acc[ai][bj][m][n], 0, 0, 0); __builtin_amdgcn_s_setprio(0); } while (0)
#define PG8_WAIT_V(n) asm volatile("s_waitcnt vmcnt(" #n ")" ::: "memory")
#define PG8_WAIT_L(n) asm volatile("s_waitcnt lgkmcnt(" #n ")" ::: "memory")
#define PG8_BAR __builtin_amdgcn_s_barrier()
#define PG8_SCHED __builtin_amdgcn_sched_barrier(0)
    Unit cur, nxt; int ui = 0;
    if (!S.next(0, cur)) return;
    f32x4 acc[2][2][4][2];
#pragma unroll
    for (int a = 0; a < 2; ++a)
#pragma unroll
        for (int b = 0; b < 2; ++b)
#pragma unroll
            for (int m = 0; m < 4; ++m)
#pragma unroll
                for (int n = 0; n < 2; ++n) acc[a][b][m][n] = (f32x4){0.f, 0.f, 0.f, 0.f};
    bf16x8 At[4][2], B0[2][2], B1[2][2];
    const char* cA = (const char*)g.A + (size_t)cur.pm * tstep + (size_t)cur.kt0 * kstep; const char* cB = (const char*)g.Bt + (size_t)cur.pn * tstep + (size_t)cur.kt0 * kstep;
    S.a_ready(cur);
    if constexpr (SP2) {
        PG8_STAGE(PG8_SB(0, 0), cB, voffB); PG8_STAGE(PG8_SB(0, 1), cB + hstep, voffB); PG8_STAGE(PG8_SA(0, 0), cA, voffA); PG8_STAGE(PG8_SA(0, 1), cA + hstep, voffA);
        if (wr == 1) PG8_BAR;
        PG8_WAIT_V(2); PG8_BAR;
        PG8_STAGE(PG8_SB(1, 0), cB + kstep, voffB); PG8_STAGE(PG8_SA(1, 0), cA + kstep, voffA); PG8_STAGE(PG8_SB(1, 1), cB + hstep + kstep, voffB);
        PG8_WAIT_V(6); PG8_BAR;
    } else {
        PG8_STAGE(PG8_SB(0, 0), cB, voffB); PG8_STAGE(PG8_SA(0, 0), cA, voffA); PG8_STAGE(PG8_SB(0, 1), cB + hstep, voffB); PG8_STAGE(PG8_SA(0, 1), cA + hstep, voffA);
        if (wr == 1) PG8_BAR;
        PG8_WAIT_V(4); PG8_BAR;
        PG8_STAGE(PG8_SB(1, 0), cB + kstep, voffB); PG8_STAGE(PG8_SA(1, 0), cA + kstep, voffA); PG8_STAGE(PG8_SB(1, 1), cB + hstep + kstep, voffB);
        PG8_WAIT_V(6); PG8_BAR;
    }
    for (;;) {
        const bool has_next = S.next(ui + 1, nxt);
        const char* nA = has_next ? (const char*)g.A + (size_t)nxt.pm * tstep + (size_t)nxt.kt0 * kstep : cA; const char* nB = has_next ? (const char*)g.Bt + (size_t)nxt.pn * tstep + (size_t)nxt.kt0 * kstep : cB;
        const int nt = cur.nt;
        for (int t = 0; t < nt; t += 2) {
            const bool last = (t == nt - 2);
            const char* a1 = cA + (size_t)(t + 1) * kstep;
            const char* a2 = last ? nA : cA + (size_t)(t + 2) * kstep; const char* b2 = last ? nB : cB + (size_t)(t + 2) * kstep;
            const char* a3 = a2 + kstep; const char* b3 = b2 + kstep;
            if (last && has_next) S.a_ready(nxt);
            if constexpr (SP2) {
            PG8_LDB(B0, 0, 0); PG8_LDB(B1, 0, 1); PG8_SCHED; PG8_LDA(At, 0, 0); PG8_STAGE(PG8_SA(1, 1), a1 + hstep, voffA);
            PG8_WAIT_V(8); PG8_WAIT_L(0); PG8_BAR; PG8_MMA(0, 0, At, B0); PG8_MMA(0, 1, At, B1); PG8_BAR; PG8_SCHED;
            PG8_LDA(At, 0, 1); PG8_STAGE(PG8_SB(0, 0), b2, voffB); PG8_STAGE(PG8_SB(0, 1), b2 + hstep, voffB); PG8_STAGE(PG8_SA(0, 0), a2, voffA);
            PG8_WAIT_V(8); PG8_WAIT_L(0); PG8_BAR; PG8_MMA(1, 0, At, B0); PG8_MMA(1, 1, At, B1); PG8_BAR; PG8_SCHED;
            PG8_LDB(B0, 1, 0); PG8_LDB(B1, 1, 1); PG8_SCHED; PG8_LDA(At, 1, 0); PG8_STAGE(PG8_SA(0, 1), a2 + hstep, voffA);
            PG8_WAIT_V(8); PG8_WAIT_L(0); PG8_BAR; PG8_MMA(0, 0, At, B0); PG8_MMA(0, 1, At, B1); PG8_BAR; PG8_SCHED;
            PG8_LDA(At, 1, 1); PG8_STAGE(PG8_SB(1, 0), b3, voffB); PG8_STAGE(PG8_SB(1, 1), b3 + hstep, voffB); PG8_STAGE(PG8_SA(1, 0), a3, voffA);
            PG8_WAIT_V(8); PG8_WAIT_L(0); PG8_BAR; PG8_MMA(1, 0, At, B0); PG8_MMA(1, 1, At, B1); PG8_BAR; PG8_SCHED;
            } else {
            PG8_LDB(B0, 0, 0); PG8_SCHED; PG8_LDA(At, 0, 0); PG8_STAGE(PG8_SA(1, 1), a1 + hstep, voffA);
            PG8_WAIT_L(8); PG8_BAR; PG8_WAIT_L(0); PG8_MMA(0, 0, At, B0); PG8_BAR; PG8_SCHED;
            PG8_LDB(B1, 0, 1); PG8_STAGE(PG8_SB(0, 0), b2, voffB);
            PG8_BAR; PG8_WAIT_L(0); PG8_MMA(0, 1, At, B1); PG8_BAR;
            PG8_LDA(At, 0, 1); PG8_STAGE(PG8_SA(0, 0), a2, voffA);
            PG8_BAR; PG8_WAIT_L(0); PG8_MMA(1, 0, At, B0); PG8_BAR; PG8_SCHED;
            PG8_STAGE(PG8_SB(0, 1), b2 + hstep, voffB);
            PG8_WAIT_V(6); PG8_BAR; PG8_MMA(1, 1, At, B1); PG8_BAR;
            PG8_LDB(B0, 1, 0); PG8_SCHED; PG8_LDA(At, 1, 0); PG8_STAGE(PG8_SA(0, 1), a2 + hstep, voffA);
            PG8_WAIT_L(8); PG8_BAR; PG8_WAIT_L(0); PG8_MMA(0, 0, At, B0); PG8_BAR; PG8_SCHED;
            PG8_LDB(B1, 1, 1); PG8_STAGE(PG8_SB(1, 0), b3, voffB);
            PG8_BAR; PG8_WAIT_L(0); PG8_MMA(0, 1, At, B1); PG8_BAR;
            PG8_LDA(At, 1, 1); PG8_STAGE(PG8_SA(1, 0), a3, voffA);
            PG8_BAR; PG8_WAIT_L(0); PG8_MMA(1, 0, At, B0); PG8_BAR; PG8_SCHED;
            PG8_STAGE(PG8_SB(1, 1), b3 + hstep, voffB);
            PG8_WAIT_V(6); PG8_BAR; PG8_MMA(1, 1, At, B1); PG8_BAR;
            }
        }
        if constexpr (ALIGN_EPI) { if (wr == 0) PG8_BAR; }
        if constexpr (!Epi::AFTER_DRAIN) { E(acc, cur, wr, wc, fr, fq); S.done(cur); }
        if (!has_next) break;
#pragma unroll
        for (int a = 0; a < 2; ++a)
#pragma unroll
            for (int b = 0; b < 2; ++b)
#pragma unroll
                for (int m = 0; m < 4; ++m)
#pragma unroll
                    for (int n = 0; n < 2; ++n) acc[a][b][m][n] = (f32x4){0.f, 0.f, 0.f, 0.f};
        cur = nxt; cA = nA; cB = nB; ++ui;
        if constexpr (ALIGN_EPI) { if (wr == 1) PG8_BAR; }
    }
    PG8_WAIT_V(0);
    if constexpr (!ALIGN_EPI) { if (wr == 0) PG8_BAR; }
    PG8_BAR;
#undef PG8_SA
#undef PG8_SB
#undef PG8_STAGE
#undef PG8_LDA
#undef PG8_LDB
#undef PG8_MMA
#undef PG8_WAIT_V
#undef PG8_WAIT_L
#undef PG8_BAR
#undef PG8_SCHED
}
}

constexpr size_t MiB = 1u << 20;
constexpr size_t WS_WIN = 1 * MiB, WS_WOUT = 33 * MiB, WS_WKV = 41 * MiB, WS_WQ = 43 * MiB, WS_WAO = 51 * MiB, WS_WGU0 = 59 * MiB, WS_WGU1 = 103 * MiB,
                 WS_WD0 = 147 * MiB, WS_WD1 = 169 * MiB, WS_ROPE = 191 * MiB, WS_XN = 192 * MiB, WS_Y = 226 * MiB, WS_O2 = 294 * MiB, WS_R1 = 328 * MiB;
constexpr size_t WS_GQT = 192 * MiB, WS_GKH = 224 * MiB, WS_GVT = 256 * MiB;
constexpr size_t WS_GPS = WS_R1 + 34 * MiB, WS_GDEC = WS_R1 + 42 * MiB;
constexpr size_t WS_QS = WS_R1, WS_VB = WS_R1 + 68 * MiB, WS_SG = WS_R1 + 102 * MiB, WS_LOGF = WS_R1 + 136 * MiB;
constexpr size_t WS_HACT = WS_R1;
constexpr size_t WS_XKV = WS_R1, WS_QR = WS_R1 + 34 * MiB, WS_KB = WS_R1 + 68 * MiB, WS_VKV = WS_R1 + 73 * MiB;
constexpr size_t WS_SLAB = WS_R1 + 204 * MiB;
constexpr size_t WS_END = WS_SLAB + 32 * MiB;
constexpr size_t WS_HB = WS_LOGF;
constexpr size_t WS_CNT = 65536;
constexpr size_t OUT_Y = 0, OUT_SP = (size_t)M * D, OUT_SS = OUT_SP + 4 * 16 * 16384, OUT_KWIN = OUT_SS + (size_t)128 * 16 * 16384, OUT_VWIN = OUT_KWIN + 131072,
                 OUT_KNEW = OUT_VWIN + 131072, OUT_VNEW = OUT_KNEW + 131072, OUT_END = OUT_VNEW + 131072;

constexpr int LDS_BYTES = 147456;
constexpr int NWAVES = 8;

template <bool GU> __device__ __forceinline__ void p0_transpose_item(const float* W, int K, int N, bf16_t* WT, LAS float* scr, int item, int lane) {
    const int nblk = N / 32, kb = item / nblk, nb = item % nblk, k0 = 64 * kb, n0 = 32 * nb;
    f32x4 wv[8];
#pragma unroll
    for (int i = 0; i < 8; ++i) wv[i] = *(const f32x4*)(W + (size_t)(k0 + 8 * i + (lane >> 3)) * N + n0 + 4 * (lane & 7));
#pragma unroll
    for (int i = 0; i < 8; ++i) { LAS float* d = scr + (8 * i + (lane >> 3)) * 33 + 4 * (lane & 7); d[0] = wv[i][0]; d[1] = wv[i][1]; d[2] = wv[i][2]; d[3] = wv[i][3]; }
    asm volatile("s_waitcnt lgkmcnt(0)" ::: "memory");
    int r0 = n0;
    if (GU) { const int half = n0 >= DFF ? 1 : 0, rem = n0 - half * DFF; r0 = (rem >> 7) * 256 + half * 128 + (rem & 127); }
    const int c = lane & 7;
#pragma unroll
    for (int j = 0; j < 4; ++j) { const int n = (lane >> 3) + 8 * j; const LAS float* s = scr + (8 * c) * 33 + n;
        u32x4 o; o.x = pk2(s[0 * 33], s[1 * 33]); o.y = pk2(s[2 * 33], s[3 * 33]); o.z = pk2(s[4 * 33], s[5 * 33]); o.w = pk2(s[6 * 33], s[7 * 33]);
        *(u32x4*)(WT + (size_t)(r0 + n) * K + k0 + 8 * c) = o; }
    asm volatile("s_waitcnt lgkmcnt(0)" ::: "memory");
}

template <bool GU> __device__ __forceinline__ void cvt_stream(const float* W, int K, int N, bf16_t* WT, LAS float* scr, int first, int stride, int nitems, int lane) {
    if (first >= nitems) return;
    const int nblk = N / 32, lr = lane >> 3, lc = 4 * (lane & 7);
    f32x4 wv[8];
    { const int k0 = 64 * (first / nblk), n0 = 32 * (first % nblk);
#pragma unroll
      for (int i = 0; i < 8; ++i) wv[i] = *(const f32x4*)(W + (size_t)(k0 + 8 * i + lr) * N + n0 + lc); }
    for (int it = first; it < nitems; it += stride) {
        const int k0 = 64 * (it / nblk), n0 = 32 * (it % nblk);
#pragma unroll
        for (int i = 0; i < 8; ++i) { LAS float* d = scr + (8 * i + lr) * 33 + lc; d[0] = wv[i][0]; d[1] = wv[i][1]; d[2] = wv[i][2]; d[3] = wv[i][3]; }
        const int itn = it + stride;
        if (itn < nitems) { const int k1 = 64 * (itn / nblk), n1 = 32 * (itn % nblk);
#pragma unroll
            for (int i = 0; i < 8; ++i) wv[i] = *(const f32x4*)(W + (size_t)(k1 + 8 * i + lr) * N + n1 + lc); }
        asm volatile("s_waitcnt lgkmcnt(0)" ::: "memory");
        int r0 = n0;
        if (GU) { const int half = n0 >= DFF ? 1 : 0, rem = n0 - half * DFF; r0 = (rem >> 7) * 256 + half * 128 + (rem & 127); }
        const int c = lane & 7;
#pragma unroll
        for (int j = 0; j < 4; ++j) { const int n = (lane >> 3) + 8 * j; const LAS float* sp = scr + (8 * c) * 33 + n;
            u32x4 o; o.x = pk2(sp[0 * 33], sp[1 * 33]); o.y = pk2(sp[2 * 33], sp[3 * 33]); o.z = pk2(sp[4 * 33], sp[5 * 33]); o.w = pk2(sp[6 * 33], sp[7 * 33]);
            *(u32x4*)(WT + (size_t)(r0 + n) * K + k0 + 8 * c) = o; }
        asm volatile("s_waitcnt lgkmcnt(0)" ::: "memory");
    }
}

template <bool HASY, bool HASA, bool HASB, bool HIN16 = false, bool HOUT16 = false>
__device__ __forceinline__ void row_pass(const void* hin, const bf16_t* Yrow, const float* gpost, void* hout, const float* gA, bf16_t* outA, const float* gB, bf16_t* outB, int lane) {
    f32x4 h[8], gp[8], ga[8], gb[8]; u32x2 yw[8];
    if (HIN16) { const u32x2* hr = (const u32x2*)hin + lane;
#pragma unroll
        for (int j = 0; j < 8; ++j) { const u32x2 hw = hr[64 * j]; h[j] = (f32x4){bf2f(hw.x & 0xffffu), __uint_as_float(hw.x & 0xffff0000u), bf2f(hw.y & 0xffffu), __uint_as_float(hw.y & 0xffff0000u)}; }
    } else { const f32x4* hr = (const f32x4*)hin + lane;
#pragma unroll
        for (int j = 0; j < 8; ++j) h[j] = hr[64 * j];
    }
    if (HASY) {
#pragma unroll
        for (int j = 0; j < 8; ++j) { yw[j] = ((const u32x2*)Yrow + lane)[64 * j]; gp[j] = ((const f32x4*)gpost + lane)[64 * j]; }
    }
    if (HASA) {
#pragma unroll
        for (int j = 0; j < 8; ++j) ga[j] = ((const f32x4*)gA + lane)[64 * j];
    }
    if (HASB) {
#pragma unroll
        for (int j = 0; j < 8; ++j) gb[j] = ((const f32x4*)gB + lane)[64 * j];
    }
    if (HASY) {
        f32x4 y[8]; float ss = 0.f;
#pragma unroll
        for (int j = 0; j < 8; ++j) { y[j] = (f32x4){bf2f(yw[j].x & 0xffffu), __uint_as_float(yw[j].x & 0xffff0000u), bf2f(yw[j].y & 0xffffu), __uint_as_float(yw[j].y & 0xffff0000u)}; ss += (y[j].x * y[j].x + y[j].y * y[j].y) + (y[j].z * y[j].z + y[j].w * y[j].w); }
        const float rstd = rsqrtf(wave_sum(ss) * (1.0f / D) + EPS);
#pragma unroll
        for (int j = 0; j < 8; ++j) { h[j] = h[j] + y[j] * rstd * gp[j];
            if (HOUT16) { u32x2 w; w.x = pk2(h[j].x, h[j].y); w.y = pk2(h[j].z, h[j].w); ((u32x2*)hout + lane)[64 * j] = w; } else ((f32x4*)hout + lane)[64 * j] = h[j]; }
    }
    if (HASA || HASB) {
        float ss = 0.f;
#pragma unroll
        for (int j = 0; j < 8; ++j) ss += (h[j].x * h[j].x + h[j].y * h[j].y) + (h[j].z * h[j].z + h[j].w * h[j].w);
        const float rstd = rsqrtf(wave_sum(ss) * (1.0f / D) + EPS);
        if (HASA) { u32x2* oa = (u32x2*)outA + lane;
#pragma unroll
            for (int j = 0; j < 8; ++j) { const f32x4 v = h[j] * rstd * ga[j]; u32x2 w; w.x = pk2(v.x, v.y); w.y = pk2(v.z, v.w); oa[64 * j] = w; } }
        if (HASB) { u32x2* ob = (u32x2*)outB + lane;
#pragma unroll
            for (int j = 0; j < 8; ++j) { const f32x4 v = h[j] * rstd * gb[j]; u32x2 w; w.x = pk2(v.x, v.y); w.y = pk2(v.z, v.w); ob[64 * j] = w; } }
    }
}

#define LDS_BARRIER() do { asm volatile("s_waitcnt lgkmcnt(0)" ::: "memory"); __builtin_amdgcn_s_barrier(); asm volatile("" ::: "memory"); } while (0)
namespace gla {
constexpr int QT_OFF = 0, TOK_STRIDE = 272;
constexpr int KT_OFF = 64 * 272;
constexpr int KH_OFF = 2 * 64 * 272, CH_STRIDE = 144;
constexpr int VT_OFF = KH_OFF + 128 * 144;
constexpr int DEC_OFF = VT_OFF + 128 * 144;
constexpr int OS_OFF = DEC_OFF + 1024, OS_STRIDE = 528;
constexpr int END = OS_OFF + 64 * 528;
static_assert(END <= 131072, "gla lds");
struct P { const bf16_t* Qs; const float* LOGF; const bf16_t* Vb; const bf16_t* SG; const float* gnorm; bf16_t* O2;
           unsigned char* G_QT; unsigned char* G_KH; unsigned char* G_VT; unsigned char* G_PS; unsigned char* G_DEC; };

__device__ __forceinline__ bf16x8 mk8(u32x2 lo, u32x2 hi) { u32x4 t; t.x = lo.x; t.y = lo.y; t.z = hi.x; t.w = hi.y; return __builtin_bit_cast(bf16x8, t); }
__device__ __forceinline__ bf16x8 pk8(f32x4 a, f32x4 b) { u32x4 t; t.x = pk2(a[0], a[1]); t.y = pk2(a[2], a[3]); t.z = pk2(b[0], b[1]); t.w = pk2(b[2], b[3]); return __builtin_bit_cast(bf16x8, t); }

__device__ __forceinline__ void intra_items(LAS unsigned char* lds, const P& p, int first, int stride, int nitems) {
    const int tid = threadIdx.x, lane = tid & 63, w = __builtin_amdgcn_readfirstlane(tid >> 6), l16 = lane & 15, g = lane >> 4;
    const int pk = tid & 127, grp = tid >> 7, pc = grp >> 1, hf = grp & 1;
    float lfo[16]; unsigned qv[16], vv[16];
#define GLA_LOAD_RAW(id) do { const int bh_ = (id) >> 5; const size_t R_ = (size_t)(bh_ >> 4) * TP + (size_t)((id) & 31) * 64; const int hc_ = (bh_ & 15) * 128; \
        _Pragma("unroll") for (int i = 0; i < 16; ++i) { const int tok = 16 * grp + i; lfo[i] = p.LOGF[(R_ + tok) * D + hc_ + pk]; \
            qv[i] = (unsigned)p.Qs[(R_ + tok) * D + hc_ + pk]; vv[i] = (unsigned)p.Vb[(R_ + tok) * D + hc_ + pk]; } } while (0)
    if (first < nitems) GLA_LOAD_RAW(first);
    for (int id = first; id < nitems; id += stride) {
        {
            float so = 0.f;
#pragma unroll
            for (int i = 0; i < 16; ++i) so += lfo[i];
            *(LAS float*)(lds + OS_OFF + tid * 4) = so;
            LDS_BARRIER();
            const float sx = *(const LAS float*)(lds + OS_OFF + (tid ^ 128) * 4);
            const float tot = so + sx;
            float b = hf ? sx : 0.f;
            unsigned khp[8], vtp[8]; float khprev = 0.f;
#pragma unroll
            for (int i = 0; i < 16; ++i) {
                const float l = lfo[i];
                b += l;
                const float kk = 1.0f - __expf(l);
                const float bc = fmaxf(b, -80.f);
                const float qq = bf2f(qv[i]) * __expf(bc);
                const float kt = kk * __expf(-bc);
                const float kh = kk * __expf(tot - b);
                const int t = 16 * grp + i;
                *(LAS bf16_t*)(lds + QT_OFF + t * TOK_STRIDE + pk * 2) = (bf16_t)(pk2(qq, 0.f) & 0xffffu);
                *(LAS bf16_t*)(lds + KT_OFF + t * TOK_STRIDE + pk * 2) = (bf16_t)(pk2(kt, 0.f) & 0xffffu);
                if (i & 1) { khp[i >> 1] = pk2(khprev, kh); vtp[i >> 1] = vv[i - 1] | (vv[i] << 16); } else khprev = kh;
            }
            LAS u32x4* khd = (LAS u32x4*)(lds + KH_OFF + pk * CH_STRIDE + grp * 32); LAS u32x4* vtd = (LAS u32x4*)(lds + VT_OFF + pk * CH_STRIDE + grp * 32);
            khd[0] = (u32x4){khp[0], khp[1], khp[2], khp[3]}; khd[1] = (u32x4){khp[4], khp[5], khp[6], khp[7]};
            vtd[0] = (u32x4){vtp[0], vtp[1], vtp[2], vtp[3]}; vtd[1] = (u32x4){vtp[4], vtp[5], vtp[6], vtp[7]};
            if (hf == 0) *(LAS float*)(lds + DEC_OFF + pc * 512 + pk * 4) = __expf(tot);
        }
        LDS_BARRIER();
        if (id + stride < nitems) GLA_LOAD_RAW(id + stride);
        {
            const int c = w >> 2, st = (w >> 1) & 1, tt = w & 1, tb = 32 * c;
            f32x4 a4 = (f32x4){0.f, 0.f, 0.f, 0.f};
#pragma unroll
            for (int ks = 0; ks < 4; ++ks) {
                const bf16x8 a = *(const LAS bf16x8*)(lds + KT_OFF + (tb + 16 * st + l16) * TOK_STRIDE + (32 * ks + 8 * g) * 2);
                const bf16x8 bq = *(const LAS bf16x8*)(lds + QT_OFF + (tb + 16 * tt + l16) * TOK_STRIDE + (32 * ks + 8 * g) * 2);
                a4 = __builtin_amdgcn_mfma_f32_16x16x32_bf16(a, bq, a4, 0, 0, 0);
            }
#pragma unroll
            for (int j = 0; j < 4; ++j) { const int s_ = 16 * st + 4 * g + j, t_ = 16 * tt + l16; a4[j] = s_ <= t_ ? a4[j] : 0.f; }
            u32x2 pw; pw.x = pk2(a4[0], a4[1]); pw.y = pk2(a4[2], a4[3]);
            *(u32x2*)(p.G_PS + (size_t)id * 4096 + w * 512 + lane * 8) = pw;
        }
#pragma unroll
        for (int i = 0; i < 2; ++i) { const int pi = tid + 512 * i;
            *(u32x4*)(p.G_QT + (size_t)id * 16384 + pi * 16) = *(const LAS u32x4*)(lds + QT_OFF + (pi >> 4) * TOK_STRIDE + (pi & 15) * 16);
            *(u32x4*)(p.G_KH + (size_t)id * 16384 + pi * 16) = *(const LAS u32x4*)(lds + KH_OFF + (pi >> 3) * CH_STRIDE + (pi & 7) * 16);
            *(u32x4*)(p.G_VT + (size_t)id * 16384 + pi * 16) = *(const LAS u32x4*)(lds + VT_OFF + (pi >> 3) * CH_STRIDE + (pi & 7) * 16); }
        if (tid < 64) *(u32x4*)(p.G_DEC + (size_t)id * 1024 + tid * 16) = *(const LAS u32x4*)(lds + DEC_OFF + tid * 16);
        LDS_BARRIER();
    }
#undef GLA_LOAD_RAW
}

__device__ __forceinline__ void scan_seq(LAS unsigned char* lds, const P& p, int bh, float* Sout, int nsc) {
    const int tid = threadIdx.x, lane = tid & 63, w = __builtin_amdgcn_readfirstlane(tid >> 6), l16 = lane & 15, g = lane >> 4;
    const int pt = tid >> 3, pp = tid & 7;
    const int hc = (bh & 15) * 128; const size_t row0 = (size_t)(bh >> 4) * TP;
    if (tid < 128) *(LAS float*)(lds + END + tid * 4) = p.gnorm[hc + tid];
    f32x4 S[8];
#pragma unroll
    for (int i = 0; i < 8; ++i) S[i] = (f32x4){0.f, 0.f, 0.f, 0.f};
    u32x4 rq[2], rk[2], rv[2], rd, rp;
    u32x4 sg0, sg1, sg0n = (u32x4){0u, 0u, 0u, 0u}, sg1n = sg0n;
#define SCAN_LOAD(sc) do { const size_t id_ = (size_t)bh * 32 + ((sc) & 31); \
        _Pragma("unroll") for (int i = 0; i < 2; ++i) { const int pi = tid + 512 * i; rq[i] = *(const u32x4*)(p.G_QT + id_ * 16384 + pi * 16); rk[i] = *(const u32x4*)(p.G_KH + id_ * 16384 + pi * 16); rv[i] = *(const u32x4*)(p.G_VT + id_ * 16384 + pi * 16); } \
        rd = *(const u32x4*)(p.G_DEC + id_ * 1024 + (tid & 63) * 16); rp = *(const u32x4*)(p.G_PS + id_ * 4096 + (tid & 255) * 16); } while (0)
    { const u32x4* sgp = (const u32x4*)(p.SG + (row0 + pt) * D + hc + 16 * pp); sg0 = sgp[0]; sg1 = sgp[1]; }
    SCAN_LOAD(0);
    for (int scx = 0; scx < nsc; ++scx) {
        const int sc = scx & 31;
        const size_t R = row0 + (size_t)sc * 64;
#pragma unroll
        for (int i = 0; i < 2; ++i) { const int pi = tid + 512 * i;
            *(LAS u32x4*)(lds + QT_OFF + (pi >> 4) * TOK_STRIDE + (pi & 15) * 16) = rq[i];
            *(LAS u32x4*)(lds + KH_OFF + (pi >> 3) * CH_STRIDE + (pi & 7) * 16) = rk[i];
            *(LAS u32x4*)(lds + VT_OFF + (pi >> 3) * CH_STRIDE + (pi & 7) * 16) = rv[i]; }
        if (tid < 64) *(LAS u32x4*)(lds + DEC_OFF + tid * 16) = rd;
        if (tid < 256) *(LAS u32x4*)(lds + KT_OFF + tid * 16) = rp;
        LDS_BARRIER();
        if (scx + 1 < nsc) { const u32x4* sgp = (const u32x4*)(p.SG + (row0 + (size_t)((scx + 1) & 31) * 64 + pt) * D + hc + 16 * pp); sg0n = sgp[0]; sg1n = sgp[1]; SCAN_LOAD(scx + 1); }
#pragma unroll
        for (int c = 0; c < 2; ++c) {
            const int tb = 32 * c;
            const LAS unsigned char* vrow = lds + VT_OFF + (16 * w + l16) * CH_STRIDE + (tb + 4 * g) * 2;
            const bf16x8 vfrag = mk8(*(const LAS u32x2*)vrow, *(const LAS u32x2*)(vrow + 32));
            bf16x8 pf[2], bq[2][4], ka[8]; f32x4 d4[8];
#pragma unroll
            for (int tt = 0; tt < 2; ++tt) {
                pf[tt] = mk8(*(const LAS u32x2*)(lds + KT_OFF + ((c * 4 + tt) * 64 + lane) * 8), *(const LAS u32x2*)(lds + KT_OFF + ((c * 4 + 2 + tt) * 64 + lane) * 8));
#pragma unroll
                for (int j2 = 0; j2 < 4; ++j2) { const LAS unsigned char* qrow = lds + QT_OFF + (tb + 16 * tt + l16) * TOK_STRIDE + (32 * j2 + 4 * g) * 2;
                    bq[tt][j2] = mk8(*(const LAS u32x2*)qrow, *(const LAS u32x2*)(qrow + 32)); }
            }
#pragma unroll
            for (int i = 0; i < 8; ++i) { d4[i] = *(const LAS f32x4*)(lds + DEC_OFF + c * 512 + (16 * i + 4 * g) * 4);
                const LAS unsigned char* krow = lds + KH_OFF + (16 * i + l16) * CH_STRIDE + (tb + 4 * g) * 2; ka[i] = mk8(*(const LAS u32x2*)krow, *(const LAS u32x2*)(krow + 32)); }
            bf16x8 sa[4];
#pragma unroll
            for (int j2 = 0; j2 < 4; ++j2) sa[j2] = pk8(S[2 * j2], S[2 * j2 + 1]);
            const f32x4 z4 = (f32x4){0.f, 0.f, 0.f, 0.f};
            f32x4 oa0 = __builtin_amdgcn_mfma_f32_16x16x32_bf16(vfrag, pf[0], z4, 0, 0, 0);
            f32x4 oa1 = __builtin_amdgcn_mfma_f32_16x16x32_bf16(vfrag, pf[1], z4, 0, 0, 0);
            f32x4 ob0 = __builtin_amdgcn_mfma_f32_16x16x32_bf16(sa[1], bq[0][1], z4, 0, 0, 0);
            f32x4 ob1 = __builtin_amdgcn_mfma_f32_16x16x32_bf16(sa[1], bq[1][1], z4, 0, 0, 0);
            oa0 = __builtin_amdgcn_mfma_f32_16x16x32_bf16(sa[0], bq[0][0], oa0, 0, 0, 0);
            oa1 = __builtin_amdgcn_mfma_f32_16x16x32_bf16(sa[0], bq[1][0], oa1, 0, 0, 0);
            ob0 = __builtin_amdgcn_mfma_f32_16x16x32_bf16(sa[3], bq[0][3], ob0, 0, 0, 0);
            ob1 = __builtin_amdgcn_mfma_f32_16x16x32_bf16(sa[3], bq[1][3], ob1, 0, 0, 0);
            oa0 = __builtin_amdgcn_mfma_f32_16x16x32_bf16(sa[2], bq[0][2], oa0, 0, 0, 0);
            oa1 = __builtin_amdgcn_mfma_f32_16x16x32_bf16(sa[2], bq[1][2], oa1, 0, 0, 0);
#pragma unroll
            for (int i = 0; i < 8; ++i) S[i] = __builtin_amdgcn_mfma_f32_16x16x32_bf16(ka[i], vfrag, S[i] * d4[i], 0, 0, 0);
            *(LAS f32x4*)(lds + OS_OFF + (tb + l16) * OS_STRIDE + (16 * w + 4 * g) * 4) = oa0 + ob0;
            *(LAS f32x4*)(lds + OS_OFF + (tb + 16 + l16) * OS_STRIDE + (16 * w + 4 * g) * 4) = oa1 + ob1;
        }
        LDS_BARRIER();
        {
            const LAS f32x4* op = (const LAS f32x4*)(lds + OS_OFF + pt * OS_STRIDE + pp * 64);
            f32x4 o[4]; float ss = 0.f;
#pragma unroll
            for (int q = 0; q < 4; ++q) { o[q] = op[q]; ss += (o[q].x * o[q].x + o[q].y * o[q].y) + (o[q].z * o[q].z + o[q].w * o[q].w); }
            ss += __shfl_xor(ss, 1); ss += __shfl_xor(ss, 2); ss += __shfl_xor(ss, 4);
            const float rstd = rsqrtf(ss * (1.0f / 128.0f) + EPS);
            const unsigned sgw[8] = {sg0.x, sg0.y, sg0.z, sg0.w, sg1.x, sg1.y, sg1.z, sg1.w};
            unsigned ow[8];
#pragma unroll
            for (int q = 0; q < 4; ++q) {
                const f32x4 v = o[q] * rstd * *(const LAS f32x4*)(lds + END + (16 * pp + 4 * q) * 4);
                ow[2 * q] = pk2(v.x * bf2f(sgw[2 * q] & 0xffffu), v.y * bf2f(sgw[2 * q] >> 16));
                ow[2 * q + 1] = pk2(v.z * bf2f(sgw[2 * q + 1] & 0xffffu), v.w * bf2f(sgw[2 * q + 1] >> 16));
            }
            u32x4* od = (u32x4*)(p.O2 + (R + pt) * D + hc + 16 * pp);
            od[0] = (u32x4){ow[0], ow[1], ow[2], ow[3]}; od[1] = (u32x4){ow[4], ow[5], ow[6], ow[7]};
        }
        sg0 = sg0n; sg1 = sg1n;
    }
#undef SCAN_LOAD
#pragma unroll
    for (int i = 0; i < 8; ++i)
#pragma unroll
        for (int j = 0; j < 4; ++j) Sout[(size_t)(16 * i + 4 * g + j) * 128 + 16 * w + l16] = S[i][j];
}

constexpr int DF_OFF = 0, DK_OFF = 2048, DQ_OFF = 4096, DV_OFF = 6144, DR_OFF = 8192, DW_OFF = 16384;
__device__ __forceinline__ void decode_items(LAS unsigned char* lds, const P& p, const float* state_in, float* state_out, int first, int stride, int nitems) {
    const int tid = threadIdx.x, lane = tid & 63, w = __builtin_amdgcn_readfirstlane(tid >> 6);
    const int v = tid & 127, kg = tid >> 7;
    float sA[32], sB[32];
    float lA = 0.f, gA = 0.f, lB = 0.f, gB = 0.f; unsigned qA = 0u, vA = 0u, sgA = 0u, qB = 0u, vB = 0u, sgB = 0u;
#define DEC_PREFETCH(itn_, s, c_l, c_q, c_v, c_sg, c_gn) do { const int itn = (itn_) & (BS * 16 - 1); \
        _Pragma("unroll") for (int q = 0; q < 4; ++q) { const float* sp = state_in + (size_t)itn * 16384 + (size_t)(32 * kg + 8 * q) * 128 + v; \
            _Pragma("unroll") for (int i = 0; i < 8; ++i) s[8 * q + i] = sp[i * 128]; } \
        const int hc_ = (itn & 15) * 128; const size_t off_ = ((size_t)NPROMPT + 4 * (itn >> 4) + kg) * D + hc_ + v; \
        c_l = p.LOGF[off_]; c_q = (unsigned)p.Qs[off_]; c_v = (unsigned)p.Vb[off_]; c_sg = (unsigned)p.SG[off_]; c_gn = p.gnorm[hc_ + v]; } while (0)
#define DEC_BODY(itx_, s, c_l, c_q, c_v, c_sg, c_gn) do { const int it = (itx_) & (BS * 16 - 1); \
        const size_t off = ((size_t)NPROMPT + 4 * (it >> 4) + kg) * D + (it & 15) * 128 + v; \
        const float gate = c_gn * bf2f(c_sg); \
        { const float f = __expf(c_l); \
          *(LAS float*)(lds + DF_OFF + tid * 4) = f; *(LAS float*)(lds + DK_OFF + tid * 4) = 1.0f - f; \
          *(LAS float*)(lds + DQ_OFF + tid * 4) = bf2f(c_q); *(LAS float*)(lds + DV_OFF + tid * 4) = bf2f(c_v); } \
        LDS_BARRIER(); \
        _Pragma("unroll 1") for (int t = 0; t < 4; ++t) { \
            const float vt = *(const LAS float*)(lds + DV_OFF + (t * 128 + v) * 4); \
            float a = 0.f; \
            _Pragma("unroll") for (int i4 = 0; i4 < 8; ++i4) { \
                const f32x4 f4 = *(const LAS f32x4*)(lds + DF_OFF + (t * 128 + 32 * kg + 4 * i4) * 4), k4 = *(const LAS f32x4*)(lds + DK_OFF + (t * 128 + 32 * kg + 4 * i4) * 4), \
                            q4 = *(const LAS f32x4*)(lds + DQ_OFF + (t * 128 + 32 * kg + 4 * i4) * 4); \
                _Pragma("unroll") for (int j = 0; j < 4; ++j) { const float sn = f4[j] * s[4 * i4 + j] + k4[j] * vt; s[4 * i4 + j] = sn; a += q4[j] * sn; } \
            } \
            *(LAS float*)(lds + DR_OFF + ((t * 4 + kg) * 128 + v) * 4) = a; \
        } \
        _Pragma("unroll") for (int q = 0; q < 4; ++q) { \
            float* so = state_out + (size_t)it * 16384 + (size_t)(32 * kg + 8 * q) * 128 + v; \
            _Pragma("unroll") for (int i = 0; i < 8; ++i) so[i * 128] = s[8 * q + i]; \
        } \
        if ((itx_) + 2 * stride < nitems) DEC_PREFETCH((itx_) + 2 * stride, s, c_l, c_q, c_v, c_sg, c_gn); \
        LDS_BARRIER(); \
        const LAS float* rr = (const LAS float*)(lds + DR_OFF + (kg * 4 * 128 + v) * 4); \
        const float o = (rr[0] + rr[128]) + (rr[256] + rr[384]); \
        const float ws = wave_sum(o * o); \
        if (lane == 0) *(LAS float*)(lds + DW_OFF + w * 4) = ws; \
        LDS_BARRIER(); \
        const float ss = *(const LAS float*)(lds + DW_OFF + (2 * kg) * 4) + *(const LAS float*)(lds + DW_OFF + (2 * kg + 1) * 4); \
        const float rstd = rsqrtf(ss * (1.0f / 128.0f) + EPS); \
        p.O2[off] = (bf16_t)(pk2(o * rstd * gate, 0.f) & 0xffffu); } while (0)
    if (first < nitems) DEC_PREFETCH(first, sA, lA, qA, vA, sgA, gA);
    if (first + stride < nitems) DEC_PREFETCH(first + stride, sB, lB, qB, vB, sgB, gB);
    for (int itx = first; itx < nitems; itx += 2 * stride) {
        DEC_BODY(itx, sA, lA, qA, vA, sgA, gA);
        if (itx + stride < nitems) DEC_BODY(itx + stride, sB, lB, qB, vB, sgB, gB);
    }
#undef DEC_BODY
#undef DEC_PREFETCH
}
}

namespace att {
constexpr int KS_OFF = 0, KS_STRIDE = 144;
constexpr int VT_OFF = 256 * 144, VT_STRIDE = 528;
struct P { const bf16_t* Qr; const bf16_t* Kb; const bf16_t* Vkv; const float* ck; const float* cv; const float* sinks; bf16_t* O; };

__device__ __forceinline__ void unit(LAS unsigned char* lds, const P& p, bool prompt, int b, int kvh, int qb) {
    const int tid = threadIdx.x, lane = tid & 63, w = __builtin_amdgcn_readfirstlane(tid >> 6), l16 = lane & 15, g = lane >> 4;
    const int h = kvh * 8 + w;
    bf16x8 qn0, qn1;
    { const size_t qrow0 = prompt ? (size_t)(b * TP + 128 * qb + l16) : (size_t)(NPROMPT + 4 * b + min(l16, 3));
      const bf16_t* qp = p.Qr + qrow0 * D + h * 64 + 8 * g; qn0 = *(const bf16x8*)qp; qn1 = *(const bf16x8*)(qp + 32); }
    __syncthreads();
#pragma unroll
    for (int i = 0; i < 4; ++i) {
        const int e = tid + 512 * i;
        {
            const int key = e >> 3, c8 = e & 7; u32x4 kv = (u32x4){0u, 0u, 0u, 0u};
            if (prompt) { if (qb > 0 || key >= 128) kv = *(const u32x4*)(p.Kb + (size_t)(b * TP + 128 * (qb - 1) + key) * 256 + kvh * 64 + c8 * 8); }
            else if (key < 128) { const f32x4* s = (const f32x4*)(p.ck + ((size_t)(b * 128 + key) * 4 + kvh) * 64 + c8 * 8); const f32x4 a = s[0], c = s[1]; kv = (u32x4){pk2(a.x, a.y), pk2(a.z, a.w), pk2(c.x, c.y), pk2(c.z, c.w)}; }
            else if (key < 132) kv = *(const u32x4*)(p.Kb + (size_t)(NPROMPT + 4 * b + key - 128) * 256 + kvh * 64 + c8 * 8);
            if (prompt || key < 160) *(LAS u32x4*)(lds + KS_OFF + key * KS_STRIDE + c8 * 16) = kv;
        }
        {
            const int key = e & 255, c8 = e >> 8; u32x4 vv = (u32x4){0u, 0u, 0u, 0u};
            if (prompt) { if (qb > 0 || key >= 128) vv = *(const u32x4*)(p.Vkv + (size_t)(b * TP + 128 * (qb - 1) + key) * 256 + kvh * 64 + c8 * 8); }
            else if (key < 128) { const f32x4* s = (const f32x4*)(p.cv + ((size_t)(b * 128 + key) * 4 + kvh) * 64 + c8 * 8); const f32x4 a = s[0], c = s[1]; vv = (u32x4){pk2(a.x, a.y), pk2(a.z, a.w), pk2(c.x, c.y), pk2(c.z, c.w)}; }
            else if (key < 132) vv = *(const u32x4*)(p.Vkv + (size_t)(NPROMPT + 4 * b + key - 128) * 256 + kvh * 64 + c8 * 8);
            if (prompt || key < 160) {
                LAS bf16_t* d = (LAS bf16_t*)(lds + VT_OFF + (c8 * 8) * VT_STRIDE + key * 2);
                d[0 * (VT_STRIDE / 2)] = (bf16_t)(vv.x & 0xffffu); d[1 * (VT_STRIDE / 2)] = (bf16_t)(vv.x >> 16);
                d[2 * (VT_STRIDE / 2)] = (bf16_t)(vv.y & 0xffffu); d[3 * (VT_STRIDE / 2)] = (bf16_t)(vv.y >> 16);
                d[4 * (VT_STRIDE / 2)] = (bf16_t)(vv.z & 0xffffu); d[5 * (VT_STRIDE / 2)] = (bf16_t)(vv.z >> 16);
                d[6 * (VT_STRIDE / 2)] = (bf16_t)(vv.w & 0xffffu); d[7 * (VT_STRIDE / 2)] = (bf16_t)(vv.w >> 16);
            }
        }
    }
    __syncthreads();
    const float sink = p.sinks[h];
    const bool hasprev = !prompt || qb > 0;
    const int nqt = prompt ? 8 : 1;
    for (int qt = 0; qt < nqt; ++qt) {
        const int qi = 16 * qt + l16;
        const size_t qrow = prompt ? (size_t)(b * TP + 128 * qb + qi) : (size_t)(NPROMPT + 4 * b + min(l16, 3));
        const bf16x8 qf[2] = {qn0, qn1};
        if (qt + 1 < nqt) { const bf16_t* qp = p.Qr + (qrow + 16) * D + h * 64 + 8 * g; qn0 = *(const bf16x8*)qp; qn1 = *(const bf16x8*)(qp + 32); }
        const int kt0 = 2 * (qt >> 1);
        f32x4 sc[10];
        float mx = -INFINITY;
#pragma unroll
        for (int ti = 0; ti < 10; ++ti) {
            const LAS unsigned char* kr = lds + KS_OFF + (16 * (kt0 + ti) + l16) * KS_STRIDE + 16 * g;
            f32x4 a4 = (f32x4){0.f, 0.f, 0.f, 0.f};
            a4 = __builtin_amdgcn_mfma_f32_16x16x32_bf16(*(const LAS bf16x8*)kr, qf[0], a4, 0, 0, 0);
            a4 = __builtin_amdgcn_mfma_f32_16x16x32_bf16(*(const LAS bf16x8*)(kr + 64), qf[1], a4, 0, 0, 0);
#pragma unroll
            for (int j = 0; j < 4; ++j) {
                const int jk = 16 * (kt0 + ti) + 4 * g + j;
                const bool valid = jk > qi && jk <= qi + 128 && (hasprev || jk >= 128);
                a4[j] = valid ? a4[j] : -INFINITY; mx = fmaxf(mx, a4[j]);
            }
            sc[ti] = a4;
        }
        mx = fmaxf(mx, __shfl_xor(mx, 16)); mx = fmaxf(mx, __shfl_xor(mx, 32)); mx = fmaxf(mx, sink);
        float sum = 0.f;
#pragma unroll
        for (int ti = 0; ti < 10; ++ti)
#pragma unroll
            for (int j = 0; j < 4; ++j) { const float e = __expf(sc[ti][j] - mx); sc[ti][j] = e; sum += e; }
        sum += __shfl_xor(sum, 16); sum += __shfl_xor(sum, 32);
        const float inv = 1.0f / (sum + __expf(sink - mx));
        f32x4 o[4];
#pragma unroll
        for (int dt = 0; dt < 4; ++dt) o[dt] = (f32x4){0.f, 0.f, 0.f, 0.f};
#pragma unroll
        for (int pp = 0; pp < 5; ++pp) {
            const bf16x8 pb = gla::pk8(sc[2 * pp], sc[2 * pp + 1]);
#pragma unroll
            for (int dt = 0; dt < 4; ++dt) {
                const LAS unsigned char* vr = lds + VT_OFF + (16 * dt + l16) * VT_STRIDE + (16 * (kt0 + 2 * pp) + 4 * g) * 2;
                const bf16x8 va = gla::mk8(*(const LAS u32x2*)vr, *(const LAS u32x2*)(vr + 32));
                o[dt] = __builtin_amdgcn_mfma_f32_16x16x32_bf16(va, pb, o[dt], 0, 0, 0);
            }
        }
        if (prompt || l16 < 4) {
#pragma unroll
            for (int dt = 0; dt < 4; ++dt) {
                const f32x4 v = o[dt] * inv; u32x2 wv; wv.x = pk2(v.x, v.y); wv.y = pk2(v.z, v.w);
                *(u32x2*)(p.O + qrow * D + h * 64 + 16 * dt + 4 * g) = wv;
            }
        }
    }
}
}

#define XB_TMO      128
#define XB_XCNT(j)  (256  + 64 * (j))
#define XB_XSUB(j)  (1280 + 64 * (j))
#define XB_XGEN(j)  (2304 + 64 * (j))
#define XB_TOP      3328
#define XB_TOPGEN   3392
#define XCD_BAR_WORDS 3456
#define XB_SPIN_CAP (1u << 18)
__device__ __forceinline__ unsigned xb_ld(unsigned* p)              { return __hip_atomic_load(p, __ATOMIC_RELAXED, __HIP_MEMORY_SCOPE_AGENT); }
__device__ __forceinline__ unsigned xb_add(unsigned* p, unsigned v) { return __hip_atomic_fetch_add(p, v, __ATOMIC_RELAXED, __HIP_MEMORY_SCOPE_AGENT); }
__device__ __forceinline__ unsigned xb_xcc_id() { return (unsigned)__builtin_amdgcn_s_getreg((3 << 11) | 20) & 0xFu; }
#define XB_SPIN(cond, bar) do { unsigned _sp = 0; while (cond) { __builtin_amdgcn_s_sleep(1); \
    if ((++_sp & 255u) == 0u) { if (xb_ld(&(bar)[XB_TMO])) break; if (_sp > XB_SPIN_CAP) { atomicAdd(&(bar)[XB_TMO], 1u); break; } } } } while (0)
struct XcdBarrier { unsigned* bar; unsigned x; volatile LAS unsigned* st; };
__device__ __forceinline__ XcdBarrier xcd_barrier_post(unsigned* bar, volatile LAS unsigned* st) {
    XcdBarrier b; b.bar = bar; b.x = xb_xcc_id(); b.st = st;
    if (threadIdx.x == 0) (void)xb_add(&bar[XB_XCNT(b.x)], 1u);
    return b;
}
__device__ __forceinline__ void xcd_barrier_complete(unsigned* bar, unsigned x, unsigned& nloc, unsigned& nx) {
    const unsigned G = gridDim.x * gridDim.y * gridDim.z;
    unsigned sum, cnt, mine, sp = 0u;
    for (;;) {
        sum = 0u; cnt = 0u; mine = 0u;
#pragma unroll
        for (unsigned j = 0; j < 16; ++j) { const unsigned c = xb_ld(&bar[XB_XCNT(j)]); sum += c; cnt += (c > 0u) ? 1u : 0u; mine = (j == x) ? c : mine; }
        if (sum == G) break;
        __builtin_amdgcn_s_sleep(1);
        if ((++sp & 255u) == 0u) { if (xb_ld(&bar[XB_TMO])) break; if (sp > XB_SPIN_CAP) { atomicAdd(&bar[XB_TMO], 1u); break; } }
    }
    nloc = mine > 0u ? mine : 1u; nx = cnt > 0u ? cnt : 1u;
}
__device__ __forceinline__ void xcd_barrier(const XcdBarrier& b) {
    asm volatile("s_waitcnt vmcnt(0)" ::: "memory");
    __syncthreads();
    if (threadIdx.x == 0) {
        unsigned* bar = b.bar;
        __builtin_amdgcn_s_waitcnt(0);
        unsigned nloc = b.st[0], nx = b.st[1];
        if (nloc == 0u) { xcd_barrier_complete(bar, b.x, nloc, nx); b.st[0] = nloc; b.st[1] = nx; }
        const unsigned old = xb_add(&bar[XB_XSUB(b.x)], 1u);
        const unsigned gen = old / nloc;
        if (old + 1u == (gen + 1u) * nloc) {
            __builtin_amdgcn_fence(__ATOMIC_RELEASE, "agent");
            asm volatile("s_waitcnt vmcnt(0)" ::: "memory");
            const unsigned og = xb_add(&bar[XB_TOP], 1u);
            const unsigned tg = og / nx;
            if (og + 1u == (tg + 1u) * nx) xb_add(&bar[XB_TOPGEN], 1u);
            else XB_SPIN(xb_ld(&bar[XB_TOPGEN]) == tg, bar);
            __builtin_amdgcn_fence(__ATOMIC_ACQUIRE, "agent");
            xb_add(&bar[XB_XGEN(b.x)], 1u);
            asm volatile("s_waitcnt vmcnt(0)" ::: "memory");
        } else {
            XB_SPIN(xb_ld(&bar[XB_XGEN(b.x)]) == gen, bar);
            __builtin_amdgcn_fence(__ATOMIC_ACQUIRE, "agent");
            asm volatile("s_waitcnt vmcnt(0)" ::: "memory");
        }
    }
    __syncthreads();
}

struct Args { const float* in[20]; float* out; unsigned char* ws; int ph_lo, ph_hi; };
constexpr int N_PHASES = 16;

__global__ void __launch_bounds__(NWAVES * 64, 2) mk_fwd(Args args) {
    extern __shared__ __attribute__((aligned(16))) unsigned char lds_raw[];
    LAS unsigned char* lds = (LAS unsigned char*)lds_raw;
    cg::grid_group grid = cg::this_grid();
    const int tid = threadIdx.x, lane = tid & 63, wave = __builtin_amdgcn_readfirstlane(tid >> 6);
    const int G = gridDim.x, cb = blockIdx.x;
    const int gw = cb * NWAVES + wave, NGW = G * NWAVES;
    unsigned char* ws = args.ws;
    const float* x_prompt = args.in[0]; const float* x_sample = args.in[1]; const float* state_in = args.in[2]; const float* cache_k = args.in[3]; const float* cache_v = args.in[4];
    const float* g_mix_pre = args.in[5]; const float* g_mix_post = args.in[6]; const float* g_ffn_pre = args.in[7]; const float* g_ffn_post = args.in[8];
    const float* w_in = args.in[9]; const float* lbraw = args.in[10]; const float* g_hnorm = args.in[11]; const float* w_hout = args.in[12];
    const float* g_kv = args.in[13]; const float* w_kv = args.in[14]; const float* w_q = args.in[15]; const float* sinks = args.in[16]; const float* w_ao = args.in[17];
    const float* w_gu = args.in[18]; const float* w_dn = args.in[19];
    bf16_t* Win_t = (bf16_t*)(ws + WS_WIN); bf16_t* Wout_t = (bf16_t*)(ws + WS_WOUT); bf16_t* Wkv_t = (bf16_t*)(ws + WS_WKV); bf16_t* Wq_t = (bf16_t*)(ws + WS_WQ); bf16_t* Wao_t = (bf16_t*)(ws + WS_WAO);
    bf16_t* Wgu_t[2] = {(bf16_t*)(ws + WS_WGU0), (bf16_t*)(ws + WS_WGU1)}; bf16_t* Wd_t[2] = {(bf16_t*)(ws + WS_WD0), (bf16_t*)(ws + WS_WD1)};
    f32x2* rope = (f32x2*)(ws + WS_ROPE);
    bf16_t* XN = (bf16_t*)(ws + WS_XN); bf16_t* O2 = (bf16_t*)(ws + WS_O2); bf16_t* Y = (bf16_t*)(ws + WS_Y);
    bf16_t* Qs = (bf16_t*)(ws + WS_QS); float* LOGF = (float*)(ws + WS_LOGF); bf16_t* Vb = (bf16_t*)(ws + WS_VB); bf16_t* SG = (bf16_t*)(ws + WS_SG);
    bf16_t* Hact = (bf16_t*)(ws + WS_HACT);
    bf16_t* XKV = (bf16_t*)(ws + WS_XKV); bf16_t* Qr = (bf16_t*)(ws + WS_QR); bf16_t* Kb = (bf16_t*)(ws + WS_KB); bf16_t* Vkv = (bf16_t*)(ws + WS_VKV);
    float* out = args.out; float* H = out + OUT_Y; bf16_t* Hb = (bf16_t*)(ws + WS_HB);
    float* slab = (float*)(ws + WS_SLAB); unsigned* cntw = (unsigned*)(ws + WS_CNT);
    const int lo = args.ph_lo, hi = args.ph_hi;
    LAS float* scr = (LAS float*)(lds + wave * 16384);
    constexpr int I_IN = 32 * 256, I_SQ = 32 * 64, I_KV = 32 * 16, I_GU = 32 * 352, I_DN = 88 * 64;
#define IN(k) (lo <= (k) && (k) < hi)
#define SEAM(k) do { if (IN(k) && IN((k) + 1)) { if (lo < 0) grid.sync(); else xcd_barrier(bar); } } while (0)
    volatile LAS unsigned* MISC = (volatile LAS unsigned*)(lds + 131072 + 320);
    if (tid < 32) MISC[tid] = 0u;
    __syncthreads();
    XcdBarrier bar; bar.bar = (unsigned*)ws; bar.x = 0; bar.st = nullptr;
    if (hi - lo > 1) bar = xcd_barrier_post((unsigned*)ws, MISC + 8);

    if (IN(0)) {
        cvt_stream<false>(w_in, D, 4 * D, Win_t, scr, gw, NGW, I_IN, lane);
        for (int e = cb * 512 + tid; e < (TP + TS) * 8; e += G * 512) {
            const int idx = e >> 3, f = e & 7; const double pos = idx < TP ? (double)idx : (double)(8192 + idx - TP);
            const double invf[8] = {1.0, 0.19392274474868576, 0.03760603093086393, 0.007292664737217109, 0.001414213562373095, 0.0002742481756762073, 5.318295896944988e-05, 1.031338537721246e-05};
            double iv = invf[0];
#pragma unroll
            for (int q = 1; q < 8; ++q) iv = f == q ? invf[q] : iv;
            const double ang = pos * (double)(float)iv;
            const double TWO_PI = 6.283185307179586476925286766559;
            const double r = ang - TWO_PI * __builtin_rint(ang / TWO_PI);
            const double r2 = r * r;
            double sn = 0.0, cs = 0.0;
#pragma unroll
            for (int k = 14; k >= 1; --k) { sn = (1.0 - sn) * r2 / (double)((2 * k) * (2 * k + 1)); cs = (1.0 - cs) * r2 / (double)((2 * k - 1) * (2 * k)); }
            rope[e] = (f32x2){(float)(1.0 - cs), (float)(r * (1.0 - sn))};
        }
        for (int m = gw; m < M; m += NGW) {
            const float* xr = m < NPROMPT ? x_prompt + (size_t)m * D : x_sample + (size_t)(m - NPROMPT) * D;
            row_pass<false, true, false>(xr, nullptr, nullptr, nullptr, g_mix_pre, XN + (size_t)m * D, nullptr, nullptr, lane);
        }
    }
    SEAM(0);
    if (IN(1)) {
        pg8::Gemm g{XN, Win_t, M, 4 * D, D}; pg8::StaticOrder S; S.init(M, 4 * D, G, cb, D);
        pg8::EpiIn E{Qs, LOGF, Vb, SG, lbraw};
        pg8::gemm_phase<pg8::EpiIn, pg8::StaticOrder, true, true>(lds, g, S, E);
        if (cb >= 64) {
            const int wv_ = (cb - 64) * NWAVES + wave;
            if (wv_ < 256) cvt_stream<false>(w_hout, D, D, Wout_t, scr, wv_, 256, I_SQ, lane);
            else if (wv_ < 512) cvt_stream<false>(w_q, D, D, Wq_t, scr, wv_ - 256, 256, I_SQ, lane);
            else if (wv_ < 768) cvt_stream<false>(w_ao, D, D, Wao_t, scr, wv_ - 512, 256, I_SQ, lane);
            else if (wv_ < 832) cvt_stream<false>(w_kv, D, 512, Wkv_t, scr, wv_ - 768, 64, I_KV, lane);
            else cvt_stream<false>(w_dn, DFF, D, Wd_t[0], scr, wv_ - 832, 704, I_DN, lane);
        }
    }
    SEAM(1);
    gla::P gp{Qs, LOGF, Vb, SG, g_hnorm, O2, ws + WS_GQT, ws + WS_GKH, ws + WS_GVT, ws + WS_GPS, ws + WS_GDEC};
    if (IN(2)) {
        gla::intra_items(lds, gp, cb, G, 2048);
    }
    SEAM(2);
    if (IN(3)) {
        const int nA = 64;
        if (cb < nA) gla::scan_seq(lds, gp, cb, out + OUT_SP + (size_t)cb * 16384, 32);
        else {
            gla::decode_items(lds, gp, state_in, out + OUT_SS, cb - nA, G - nA, BS * 16);
            __syncthreads();
            cvt_stream<true>(w_gu, D, 2 * DFF, Wgu_t[0], scr, (cb - nA) * NWAVES + wave, (G - nA) * NWAVES, I_GU, lane);
        }
    }
    SEAM(3);
    if (IN(4)) {
        pg8::Gemm g{O2, Wout_t, M, D, D}; pg8::SplitOrder S; S.init(D, G, cb, D);
        pg8::EpiF32 E{Y, D, slab, cntw + 0 * 1024};
        pg8::gemm_phase<pg8::EpiF32, pg8::SplitOrder, true, true>(lds, g, S, E);
    }
    SEAM(4);
    if (IN(5)) {
        for (int m = gw; m < M; m += NGW) {
            const float* xr = m < NPROMPT ? x_prompt + (size_t)m * D : x_sample + (size_t)(m - NPROMPT) * D;
            row_pass<true, true, false, false, true>(xr, Y + (size_t)m * D, g_mix_post, Hb + (size_t)m * D, g_ffn_pre, XN + (size_t)m * D, nullptr, nullptr, lane);
        }
    }
    SEAM(5);
    if (IN(6)) {
        pg8::Gemm g{XN, Wgu_t[0], M, 2 * DFF, D}; pg8::StaticOrder S; S.init(M, 2 * DFF, G, cb, D);
        pg8::EpiSwiGLU E{Hact};
        pg8::gemm_phase<pg8::EpiSwiGLU, pg8::StaticOrder, true, true>(lds, g, S, E);
    }
    SEAM(6);
    if (IN(7)) {
        pg8::Gemm g{Hact, Wd_t[0], M, D, DFF}; pg8::SplitOrder S; S.init(D, G, cb, DFF);
        pg8::EpiF32 E{Y, D, slab, cntw + 1 * 1024};
        pg8::gemm_phase<pg8::EpiF32, pg8::SplitOrder, true, true>(lds, g, S, E);
    }
    SEAM(7);
    if (IN(8)) {
        for (int m = gw; m < M; m += NGW)
            row_pass<true, true, true, true, true>(Hb + (size_t)m * D, Y + (size_t)m * D, g_ffn_post, Hb + (size_t)m * D, g_mix_pre + D, XN + (size_t)m * D, g_kv, XKV + (size_t)m * D, lane);
    }
    SEAM(8);
    if (IN(9)) {
        { pg8::Gemm g{XKV, Wkv_t, M, 512, D}; pg8::StaticOrder S; S.init(M, 512, G, cb, D);
          pg8::EpiRope<1> E{Kb, Vkv, rope, out + OUT_KWIN, out + OUT_VWIN, out + OUT_KNEW, out + OUT_VNEW};
          pg8::gemm_phase<pg8::EpiRope<1>, pg8::StaticOrder, true, true>(lds, g, S, E); }
        { pg8::Gemm g{XN, Wq_t, M, D, D}; pg8::StaticOrder S; S.init(M, D, G, (cb + G - (68 % G)) % G, D);
          pg8::EpiRope<0> E{Qr, nullptr, rope, nullptr, nullptr, nullptr, nullptr};
          pg8::gemm_phase<pg8::EpiRope<0>, pg8::StaticOrder, true, true>(lds, g, S, E); }
        if (cb >= 84) {
            const int wv_ = (cb - 84) * NWAVES + wave;
            if (wv_ < 917) cvt_stream<true>(w_gu + (size_t)D * 2 * DFF, D, 2 * DFF, Wgu_t[1], scr, wv_, 917, I_GU, lane);
            else cvt_stream<false>(w_dn + (size_t)DFF * D, DFF, D, Wd_t[1], scr, wv_ - 917, 459, I_DN, lane);
        }
    }
    SEAM(9);
    if (IN(10)) {
        att::P ap{Qr, Kb, Vkv, cache_k, cache_v, sinks, O2};
        for (int u = cb; u < 256 + 512; u += G) {
            if (u < 256) att::unit(lds, ap, true, u >> 6, (u >> 4) & 3, u & 15);
            else { const int v = u - 256; att::unit(lds, ap, false, v >> 2, v & 3, 0); }
        }
    }
    SEAM(10);
    if (IN(11)) {
        pg8::Gemm g{O2, Wao_t, M, D, D}; pg8::SplitOrder S; S.init(D, G, cb, D);
        pg8::EpiF32 E{Y, D, slab, cntw + 2 * 1024};
        pg8::gemm_phase<pg8::EpiF32, pg8::SplitOrder, true, true>(lds, g, S, E);
    }
    SEAM(11);
    if (IN(12)) {
        for (int m = gw; m < M; m += NGW)
            row_pass<true, true, false, true, true>(Hb + (size_t)m * D, Y + (size_t)m * D, g_mix_post + D, Hb + (size_t)m * D, g_ffn_pre + D, XN + (size_t)m * D, nullptr, nullptr, lane);
    }
    SEAM(12);
    if (IN(13)) {
        pg8::Gemm g{XN, Wgu_t[1], M, 2 * DFF, D}; pg8::StaticOrder S; S.init(M, 2 * DFF, G, cb, D);
        pg8::EpiSwiGLU E{Hact};
        pg8::gemm_phase<pg8::EpiSwiGLU, pg8::StaticOrder, true, true>(lds, g, S, E);
    }
    SEAM(13);
    if (IN(14)) {
        pg8::Gemm g{Hact, Wd_t[1], M, D, DFF}; pg8::SplitOrder S; S.init(D, G, cb, DFF);
        pg8::EpiF32 E{Y, D, slab, cntw + 3 * 1024};
        pg8::gemm_phase<pg8::EpiF32, pg8::SplitOrder, true, true>(lds, g, S, E);
    }
    SEAM(14);
    if (IN(15)) {
        for (int m = gw; m < M; m += NGW)
            row_pass<true, false, false, true, false>(Hb + (size_t)m * D, Y + (size_t)m * D, g_ffn_post + D, H + (size_t)m * D, nullptr, nullptr, nullptr, nullptr, lane);
    }
#undef IN
#undef SEAM
}

extern "C" void kernel_launch(void* const* d_in, const int* in_sizes, int n_in, void* d_out, int out_size, void* d_ws, size_t ws_size, hipStream_t stream) {
    static int grid = 0;
    if (grid == 0) {
        if (n_in != 20 || (size_t)out_size != OUT_END || ws_size < WS_END) { fprintf(stderr, "kernel_launch: unexpected shapes: n_in %d out %d ws %zu (need %zu)\n", n_in, out_size, ws_size, (size_t)WS_END); grid = -1; return; }
        int dev = 0, cus = 0, per_cu = 0;
        hipGetDevice(&dev); hipDeviceGetAttribute(&cus, hipDeviceAttributeMultiprocessorCount, dev);
        if (hipFuncSetAttribute((const void*)mk_fwd, hipFuncAttributeMaxDynamicSharedMemorySize, LDS_BYTES) != hipSuccess) { fprintf(stderr, "kernel_launch: hipFuncSetAttribute failed\n"); grid = -1; return; }
        hipOccupancyMaxActiveBlocksPerMultiprocessor(&per_cu, (const void*)mk_fwd, NWAVES * 64, LDS_BYTES);
        (void)hipGetLastError();
        if (per_cu < 1) per_cu = 1;
        if (cus < 256) { fprintf(stderr, "kernel_launch: built for a 256-CU device (got %d)\n", cus); grid = -1; return; }
        grid = 256;
        fprintf(stderr, "kernel_launch: cus %d per_cu %d grid %d\n", cus, per_cu, grid);
    }
    if (grid < 0) return;
    if (hipMemsetAsync(d_ws, 0, 131072, stream) != hipSuccess) { fprintf(stderr, "kernel_launch: memset failed\n"); return; }
    Args a{};
    for (int i = 0; i < 20; ++i) a.in[i] = (const float*)d_in[i];
    a.out = (float*)d_out; a.ws = (unsigned char*)d_ws;
#if MK_ONE_LAUNCH
    void* kargs[] = {&a};
    a.ph_lo = 0; a.ph_hi = N_PHASES;
    hipError_t e = hipLaunchCooperativeKernel((const void*)mk_fwd, dim3(grid), dim3(NWAVES * 64), kargs, LDS_BYTES, stream);
    if (e != hipSuccess) fprintf(stderr, "kernel_launch: cooperative launch failed: %s\n", hipGetErrorString(e));
#else
    for (int ph = 0; ph < N_PHASES; ++ph) {
        a.ph_lo = ph; a.ph_hi = ph + 1;
        hipLaunchKernelGGL(mk_fwd, dim3(grid), dim3(NWAVES * 64), LDS_BYTES, stream, a);
    }
#endif
}
```

```cpp
#include <hip/hip_runtime.h>
#include <hip/hip_cooperative_groups.h>
#include <cstdio>
#include <cstdint>
namespace cg = cooperative_groups;

#ifndef MK_ONE_LAUNCH
#define MK_ONE_LAUNCH 1
#endif

#define LAS __attribute__((address_space(3)))
typedef unsigned short bf16_t;
typedef short bf16x8 __attribute__((ext_vector_type(8)));
typedef float f32x4 __attribute__((ext_vector_type(4)));
typedef float f32x2 __attribute__((ext_vector_type(2)));
typedef unsigned u32x4 __attribute__((ext_vector_type(4)));
typedef unsigned u32x2 __attribute__((ext_vector_type(2)));
typedef __bf16 bf16x2_t __attribute__((ext_vector_type(2)));

constexpr int D = 2048, NPROMPT = 8192, NSAMPLE = 512, M = NPROMPT + NSAMPLE;
constexpr int TP = 2048, TS = 4, BS = 128;
constexpr int DFF = 5632;
constexpr float EPS = 1e-6f;

__device__ __forceinline__ unsigned pk2(float lo, float hi) { f32x2 v = {lo, hi}; bf16x2_t b = __builtin_convertvector(v, bf16x2_t); return __builtin_bit_cast(unsigned, b); }
__device__ __forceinline__ float bf2f(unsigned b) { return __uint_as_float(b << 16); }
__device__ __forceinline__ float silu_f(float x) { return x * __builtin_amdgcn_rcpf(1.0f + __expf(-x)); }
__device__ __forceinline__ float wave_sum(float v) {
#pragma unroll
    for (int o = 1; o < 64; o <<= 1) v += __shfl_xor(v, o);
    return v;
}

namespace pg8 {
constexpr int BM = 256, BK = 64, HALF = 128, HTB = HALF * BK * 2, STAGE_BYTES = 8 * HTB, NXCD = 8, WGM = 8;
__host__ __device__ __forceinline__ int lds_byte(int r, int c) { const int st = (r >> 4) * 2 + (c >> 5), rr = r & 15, cc = c & 31, ob = rr * 64 + cc * 2; return st * 1024 + (ob ^ (((ob >> 9) & 1) << 5)); }
__host__ __device__ __forceinline__ void stage_rc(int b, int& R, int& C) { const int st = b / 1024, sb = b % 1024, swz = sb ^ (((sb >> 9) & 1) << 5); R = (st >> 1) * 16 + swz / 64; C = (st & 1) * 32 + (swz % 64) / 2; }
__host__ __device__ __forceinline__ int perm32(int rho) { const int n = rho >> 4, i = rho & 15; return 8 * (i >> 2) + 4 * n + (i & 3); }

struct Unit { int pm, pn, kt0, nt, split, uid; };
struct Gemm { const bf16_t* A; const bf16_t* Bt; int M, N, K; };

struct StaticOrder {
    int nM, nN, nwg, G, c, ntk;
    __host__ __device__ void init(int M_, int N_, int G_, int c_, int K_) { nM = M_ / BM; nN = N_ / BM; nwg = nM * nN; G = G_; c = c_; ntk = K_ / BK; }
    __host__ __device__ bool next(int i, Unit& u) const {
        const long L = (long)i * G + c; if (L >= nwg) return false;
        u.kt0 = 0; u.nt = ntk; u.split = -1; u.uid = 0;
        int wgid = (int)L; { const int q = nwg / NXCD, r = nwg % NXCD, xcd = wgid % NXCD, off = wgid / NXCD; wgid = (xcd < r ? xcd * (q + 1) : r * (q + 1) + (xcd - r) * q) + off; }
        const int nig = WGM * nN, gid = wgid / nig, fm = gid * WGM, gsz = (nM - fm) < WGM ? (nM - fm) : WGM;
        u.pm = fm + ((wgid % nig) % gsz); u.pn = (wgid % nig) / gsz; return true;
    }
    __device__ __forceinline__ void a_ready(const Unit&) const {}
    __device__ __forceinline__ void done(const Unit&) const {}
};

struct SplitOrder {
    StaticOrder so; int c;
    __host__ __device__ void init(int N_, int G_, int c_, int K_) { so.init(8192, N_, G_, c_, K_); c = c_; }
    __host__ __device__ bool next(int i, Unit& u) const {
        if (i == 0) return so.next(0, u);
        if (i == 1 && c < 128) { const int j = c >> 3, sp = c & 7; u.pm = 32 + (j >> 3); u.pn = j & 7; u.split = sp; u.uid = j;
            if (so.ntk == 32) { u.kt0 = 4 * sp; u.nt = 4; } else { u.kt0 = sp < 4 ? 12 * sp : 48 + 10 * (sp - 4); u.nt = sp < 4 ? 12 : 10; }
            return true; }
        return false;
    }
    __device__ __forceinline__ void a_ready(const Unit&) const {}
    __device__ __forceinline__ void done(const Unit&) const {}
};


struct EpiIn {
    static constexpr bool PERM = true, AFTER_DRAIN = false;
    bf16_t* Qs; float* LOGF; bf16_t* Vb; bf16_t* SG; const float* lbraw;
    __device__ __forceinline__ void operator()(const f32x4 (&acc)[2][2][4][2], const Unit& u, int wr, int wc, int fr, int fq) const {
        const int seg = u.pn >> 3;
        const int row0 = u.pm * BM + wr * 64 + fr;
        const int col0 = (u.pn & 7) * BM + wc * 32 + 8 * fq;
        if (seg == 1) {
#pragma unroll
            for (int bj = 0; bj < 2; ++bj) {
                const int c = col0 + bj * HALF;
                float lb[8];
#pragma unroll
                for (int e = 0; e < 8; ++e) { const float a0 = lbraw[c + e], a1 = lbraw[D + c + e]; lb[e] = __builtin_amdgcn_rcpf(1.0f + __expf(a1 - a0)); }
#pragma unroll
                for (int ai = 0; ai < 2; ++ai)
#pragma unroll
                    for (int m = 0; m < 4; ++m) {
                        float* dst = LOGF + (size_t)(row0 + ai * HALF + m * 16) * D + c;
                        f32x4 o0, o1;
#pragma unroll
                        for (int j = 0; j < 4; ++j) {
                            const float s0 = __builtin_amdgcn_rcpf(1.0f + __expf(-acc[ai][bj][m][0][j])), s1 = __builtin_amdgcn_rcpf(1.0f + __expf(-acc[ai][bj][m][1][j]));
                            o0[j] = __logf(lb[j] + (1.0f - lb[j]) * s0); o1[j] = __logf(lb[4 + j] + (1.0f - lb[4 + j]) * s1);
                        }
                        *(f32x4*)dst = o0; *(f32x4*)(dst + 4) = o1;
                    }
            }
        } else {
            bf16_t* base = Qs + (size_t)seg * ((size_t)M * D);
#pragma unroll
            for (int ai = 0; ai < 2; ++ai)
#pragma unroll
                for (int m = 0; m < 4; ++m)
#pragma unroll
                    for (int bj = 0; bj < 2; ++bj) {
                        f32x4 v0 = acc[ai][bj][m][0], v1 = acc[ai][bj][m][1];
                        if (seg != 2) {
#pragma unroll
                            for (int j = 0; j < 4; ++j) { v0[j] = silu_f(v0[j]); v1[j] = silu_f(v1[j]); }
                        }
                        u32x4 w; w.x = pk2(v0[0], v0[1]); w.y = pk2(v0[2], v0[3]); w.z = pk2(v1[0], v1[1]); w.w = pk2(v1[2], v1[3]);
                        *(u32x4*)(base + (size_t)(row0 + ai * HALF + m * 16) * D + col0 + bj * HALF) = w;
                    }
        }
    }
};
struct EpiF32 {
    static constexpr bool PERM = true, AFTER_DRAIN = false;
    bf16_t* Y; int ldc; float* slab; unsigned* cnt;
    __device__ __forceinline__ void operator()(const f32x4 (&acc)[2][2][4][2], const Unit& u, int wr, int wc, int fr, int fq) const {
        const int row0 = u.pm * BM + wr * 64 + fr, col0 = u.pn * BM + wc * 32 + 8 * fq;
        if (u.split < 0) {
#pragma unroll
            for (int ai = 0; ai < 2; ++ai)
#pragma unroll
                for (int m = 0; m < 4; ++m)
#pragma unroll
                    for (int bj = 0; bj < 2; ++bj) {
                        const f32x4 v0 = acc[ai][bj][m][0], v1 = acc[ai][bj][m][1];
                        u32x4 w4; w4.x = pk2(v0[0], v0[1]); w4.y = pk2(v0[2], v0[3]); w4.z = pk2(v1[0], v1[1]); w4.w = pk2(v1[2], v1[3]);
                        *(u32x4*)(Y + (size_t)(row0 + ai * HALF + m * 16) * ldc + col0 + bj * HALF) = w4;
                    }
            return;
        }
        const int tid = threadIdx.x;
        f32x4* mine = (f32x4*)(slab + (size_t)(u.uid * 8 + u.split) * 65536) + tid;
#pragma unroll
        for (int ai = 0; ai < 2; ++ai)
#pragma unroll
            for (int m = 0; m < 4; ++m)
#pragma unroll
                for (int bj = 0; bj < 2; ++bj)
#pragma unroll
                    for (int n = 0; n < 2; ++n) mine[(((ai * 4 + m) * 2 + bj) * 2 + n) * 512] = acc[ai][bj][m][n];
        asm volatile("s_waitcnt vmcnt(0)" ::: "memory");
        __syncthreads();
        if (tid == 0) {
            unsigned* cw = cnt + 64 * u.uid;
            __builtin_amdgcn_fence(__ATOMIC_RELEASE, "agent");
            asm volatile("s_waitcnt vmcnt(0)" ::: "memory");
            __hip_atomic_fetch_add(cw, 1u, __ATOMIC_RELAXED, __HIP_MEMORY_SCOPE_AGENT);
            unsigned sp = 0;
            while (__hip_atomic_load(cw, __ATOMIC_RELAXED, __HIP_MEMORY_SCOPE_AGENT) < 8u) { __builtin_amdgcn_s_sleep(2); if (++sp > (1u << 22)) break; }
            __builtin_amdgcn_fence(__ATOMIC_ACQUIRE, "agent");
            asm volatile("s_waitcnt vmcnt(0)" ::: "memory");
        }
        __syncthreads();
        const int ai = u.split >> 2, m = u.split & 3;
        f32x4 sum[2][2];
#pragma unroll
        for (int bj = 0; bj < 2; ++bj)
#pragma unroll
            for (int n = 0; n < 2; ++n) sum[bj][n] = (f32x4){0.f, 0.f, 0.f, 0.f};
        const f32x4* base = (const f32x4*)(slab + (size_t)(u.uid * 8) * 65536) + tid + (size_t)(u.split * 4) * 512;
#pragma unroll
        for (int sp = 0; sp < 8; ++sp)
#pragma unroll
            for (int bj = 0; bj < 2; ++bj)
#pragma unroll
                for (int n = 0; n < 2; ++n) sum[bj][n] += base[(size_t)sp * 16384 + (bj * 2 + n) * 512];
#pragma unroll
        for (int bj = 0; bj < 2; ++bj) {
            const f32x4 v0 = sum[bj][0], v1 = sum[bj][1];
            u32x4 w4; w4.x = pk2(v0[0], v0[1]); w4.y = pk2(v0[2], v0[3]); w4.z = pk2(v1[0], v1[1]); w4.w = pk2(v1[2], v1[3]);
            *(u32x4*)(Y + (size_t)(row0 + ai * HALF + m * 16) * ldc + col0 + bj * HALF) = w4;
        }
    }
};
struct EpiSwiGLU {
    static constexpr bool PERM = true, AFTER_DRAIN = false;
    bf16_t* Hact;
    __device__ __forceinline__ void operator()(const f32x4 (&acc)[2][2][4][2], const Unit& u, int wr, int wc, int fr, int fq) const {
        const int row0 = u.pm * BM + wr * 64 + fr, col0 = u.pn * HALF + wc * 32 + 8 * fq;
#pragma unroll
        for (int ai = 0; ai < 2; ++ai)
#pragma unroll
            for (int m = 0; m < 4; ++m) {
                f32x4 v0, v1;
#pragma unroll
                for (int j = 0; j < 4; ++j) { v0[j] = silu_f(acc[ai][0][m][0][j]) * acc[ai][1][m][0][j]; v1[j] = silu_f(acc[ai][0][m][1][j]) * acc[ai][1][m][1][j]; }
                u32x4 w; w.x = pk2(v0[0], v0[1]); w.y = pk2(v0[2], v0[3]); w.z = pk2(v1[0], v1[1]); w.w = pk2(v1[2], v1[3]);
                *(u32x4*)(Hact + (size_t)(row0 + ai * HALF + m * 16) * DFF + col0) = w;
            }
    }
};
template <int MODE> struct EpiRope {
    static constexpr bool PERM = true, AFTER_DRAIN = false;
    bf16_t* O0; bf16_t* O1; const f32x2* rope;
    float* kwin; float* vwin; float* knew; float* vnew;
    __device__ __forceinline__ void operator()(const f32x4 (&accin)[2][2][4][2], const Unit& u, int wr, int wc, int fr, int fq) const {
        const int row0 = u.pm * BM + wr * 64 + fr;
        const bool do_rope = (MODE == 0 || u.pn == 0) && ((wc & 1) == 0);
        const float scale = MODE == 0 ? 0.125f : 1.0f;
#pragma unroll
        for (int ai = 0; ai < 2; ++ai)
#pragma unroll
            for (int m = 0; m < 4; ++m) {
                const int row = row0 + ai * HALF + m * 16;
                f32x4 v[2][2];
#pragma unroll
                for (int bj = 0; bj < 2; ++bj) { v[bj][0] = accin[ai][bj][m][0]; v[bj][1] = accin[ai][bj][m][1]; }
                if (do_rope) {
                    const int idx = row < NPROMPT ? (row & (TP - 1)) : (TP + (row & 3));
                    const f32x4* rp = (const f32x4*)(rope + (size_t)idx * 8);
                    f32x4 cs[4];
#pragma unroll
                    for (int q = 0; q < 4; ++q) cs[q] = rp[q];
#pragma unroll
                    for (int bj = 0; bj < 2; ++bj)
#pragma unroll
                        for (int n = 0; n < 2; ++n)
#pragma unroll
                            for (int j = 0; j < 4; ++j) {
                                const int f = 4 * n + j;
                                const float c = cs[f >> 1][(f & 1) * 2], s = cs[f >> 1][(f & 1) * 2 + 1];
                                const float x = v[bj][n][j];
                                const float px = __shfl_xor(x, 16);
                                const float r = fq == 0 ? x * c - px * s : x * c + px * s;
                                v[bj][n][j] = fq < 2 ? r : x;
                            }
                }
#pragma unroll
                for (int bj = 0; bj < 2; ++bj) {
                    const f32x4 a = v[bj][0] * scale, b = v[bj][1] * scale;
                    u32x4 w; w.x = pk2(a[0], a[1]); w.y = pk2(a[2], a[3]); w.z = pk2(b[0], b[1]); w.w = pk2(b[2], b[3]);
                    const int ct = bj * HALF + wc * 32 + 8 * fq;
                    if (MODE == 0) {
                        *(u32x4*)(O0 + (size_t)row * D + u.pn * BM + ct) = w;
                    } else {
                        bf16_t* ob = u.pn == 0 ? O0 : O1;
                        *(u32x4*)(ob + (size_t)row * 256 + ct) = w;
                        float* fo = nullptr;
                        if (u.pm >= NPROMPT / BM) fo = (u.pn == 0 ? knew : vnew) + (size_t)(row - NPROMPT) * 256 + ct;
                        else if ((u.pm & 7) == 7 && ai == 1) fo = (u.pn == 0 ? kwin : vwin) + (size_t)((u.pm >> 3) * 128 + (row & 127)) * 256 + ct;
                        if (fo) { *(f32x4*)fo = a; *(f32x4*)(fo + 4) = b; }
                    }
                }
            }
    }
};

template <class Epi, class Sched, bool ALIGN_EPI = false, bool SP2 = false>
__device__ __forceinline__ void gemm_phase(LAS unsigned char* lds, const Gemm g, const Sched& S, const Epi& E) {
    const int tid = threadIdx.x, wid = __builtin_amdgcn_readfirstlane(tid >> 6), lane = tid & 63, wr = wid >> 2, wc = wid & 3, fr = lane & 15, fq = lane >> 4;
    const int K = g.K;
    unsigned voffA[2], voffB[2];
#pragma unroll
    for (int i = 0; i < 2; ++i) { int R, C; stage_rc(tid * 16 + i * 8192, R, C); const int Rb = Epi::PERM ? ((R & ~31) + perm32(R & 31)) : R;
        voffA[i] = (unsigned)(R * K + C) * 2u; voffB[i] = (unsigned)(Rb * K + C) * 2u; }
    const size_t kstep = (size_t)(BK * 2);
    const size_t hstep = (size_t)HALF * K * 2;
    const size_t tstep = 2 * hstep;
    const unsigned ldsw = (unsigned)wid * 1024u;
    const int aoff = lds_byte(wr * 64 + fr, fq * 8), boff = lds_byte(wc * 32 + fr, fq * 8);
#define PG8_SA(b, h) (((b) * 2 + (h)) * HTB)
#define PG8_SB(b, h) ((4 + (b) * 2 + (h)) * HTB)
#define PG8_STAGE(bufoff, gbase, voff) do { _Pragma("unroll") for (int _i = 0; _i < 2; ++_i) \
        __builtin_amdgcn_global_load_lds((const unsigned*)((const char*)(gbase) + (voff)[_i]), (LAS unsigned*)(lds + (bufoff) + ldsw + _i * 8192), 16, 0, 0); } while (0)
#define PG8_LDA(dst, b, h) do { _Pragma("unroll") for (int m = 0; m < 4; ++m) _Pragma("unroll") for (int k = 0; k < 2; ++k) dst[m][k] = *(const LAS bf16x8*)(lds + PG8_SA(b, h) + aoff + m * 2048 + k * 1024); } while (0)
#define PG8_LDB(dst, b, h) do { _Pragma("unroll") for (int n = 0; n < 2; ++n) _Pragma("unroll") for (int k = 0; k < 2; ++k) dst[n][k] = *(const LAS bf16x8*)(lds + PG8_SB(b, h) + boff + n * 2048 + k * 1024); } while (0)
#define PG8_MMA(ai, bj, At, Bt) do { __builtin_amdgcn_s_setprio(1); _Pragma("unroll") for (int m = 0; m < 4; ++m) _Pragma("unroll") for (int n = 0; n < 2; ++n) _Pragma("unroll") for (int k = 0; k < 2; ++k) \
        acc[ai][bj][m][n] = __builtin_amdgcn_mfma_f32_16x16x32_bf16(Bt[n][k], At[m][k], acc[ai][bj][m][n], 0, 0, 0); __builtin_amdgcn_s_setprio(0); } while (0)
#define PG8_WAIT_V(n) asm volatile("s_waitcnt vmcnt(" #n ")" ::: "memory")
#define PG8_WAIT_L(n) asm volatile("s_waitcnt lgkmcnt(" #n ")" ::: "memory")
#define PG8_BAR __builtin_amdgcn_s_barrier()
#define PG8_SCHED __builtin_amdgcn_sched_barrier(0)
    Unit cur, nxt; int ui = 0;
    if (!S.next(0, cur)) return;
    f32x4 acc[2][2][4][2];
#pragma unroll
    for (int a = 0; a < 2; ++a)
#pragma unroll
        for (int b = 0; b < 2; ++b)
#pragma unroll
            for (int m = 0; m < 4; ++m)
#pragma unroll
                for (int n = 0; n < 2; ++n) acc[a][b][m][n] = (f32x4){0.f, 0.f, 0.f, 0.f};
    bf16x8 At[4][2], B0[2][2], B1[2][2];
    const char* cA = (const char*)g.A + (size_t)cur.pm * tstep + (size_t)cur.kt0 * kstep; const char* cB = (const char*)g.Bt + (size_t)cur.pn * tstep + (size_t)cur.kt0 * kstep;
    S.a_ready(cur);
    if constexpr (SP2) {
        PG8_STAGE(PG8_SB(0, 0), cB, voffB); PG8_STAGE(PG8_SB(0, 1), cB + hstep, voffB); PG8_STAGE(PG8_SA(0, 0), cA, voffA); PG8_STAGE(PG8_SA(0, 1), cA + hstep, voffA);
        if (wr == 1) PG8_BAR;
        PG8_WAIT_V(2); PG8_BAR;
        PG8_STAGE(PG8_SB(1, 0), cB + kstep, voffB); PG8_STAGE(PG8_SA(1, 0), cA + kstep, voffA); PG8_STAGE(PG8_SB(1, 1), cB + hstep + kstep, voffB);
        PG8_WAIT_V(6); PG8_BAR;
    } else {
        PG8_STAGE(PG8_SB(0, 0), cB, voffB); PG8_STAGE(PG8_SA(0, 0), cA, voffA); PG8_STAGE(PG8_SB(0, 1), cB + hstep, voffB); PG8_STAGE(PG8_SA(0, 1), cA + hstep, voffA);
        if (wr == 1) PG8_BAR;
        PG8_WAIT_V(4); PG8_BAR;
        PG8_STAGE(PG8_SB(1, 0), cB + kstep, voffB); PG8_STAGE(PG8_SA(1, 0), cA + kstep, voffA); PG8_STAGE(PG8_SB(1, 1), cB + hstep + kstep, voffB);
        PG8_WAIT_V(6); PG8_BAR;
    }
    for (;;) {
        const bool has_next = S.next(ui + 1, nxt);
        const char* nA = has_next ? (const char*)g.A + (size_t)nxt.pm * tstep + (size_t)nxt.kt0 * kstep : cA; const char* nB = has_next ? (const char*)g.Bt + (size_t)nxt.pn * tstep + (size_t)nxt.kt0 * kstep : cB;
        const int nt = cur.nt;
        for (int t = 0; t < nt; t += 2) {
            const bool last = (t == nt - 2);
            const char* a1 = cA + (size_t)(t + 1) * kstep;
            const char* a2 = last ? nA : cA + (size_t)(t + 2) * kstep; const char* b2 = last ? nB : cB + (size_t)(t + 2) * kstep;
            const char* a3 = a2 + kstep; const char* b3 = b2 + kstep;
            if (last && has_next) S.a_ready(nxt);
            if constexpr (SP2) {
            PG8_LDB(B0, 0, 0); PG8_LDB(B1, 0, 1); PG8_SCHED; PG8_LDA(At, 0, 0); PG8_STAGE(PG8_SA(1, 1), a1 + hstep, voffA);
            PG8_WAIT_V(8); PG8_WAIT_L(0); PG8_BAR; PG8_MMA(0, 0, At, B0); PG8_MMA(0, 1, At, B1); PG8_BAR; PG8_SCHED;
            PG8_LDA(At, 0, 1); PG8_STAGE(PG8_SB(0, 0), b2, voffB); PG8_STAGE(PG8_SB(0, 1), b2 + hstep, voffB); PG8_STAGE(PG8_SA(0, 0), a2, voffA);
            PG8_WAIT_V(8); PG8_WAIT_L(0); PG8_BAR; PG8_MMA(1, 0, At, B0); PG8_MMA(1, 1, At, B1); PG8_BAR; PG8_SCHED;
            PG8_LDB(B0, 1, 0); PG8_LDB(B1, 1, 1); PG8_SCHED; PG8_LDA(At, 1, 0); PG8_STAGE(PG8_SA(0, 1), a2 + hstep, voffA);
            PG8_WAIT_V(8); PG8_WAIT_L(0); PG8_BAR; PG8_MMA(0, 0, At, B0); PG8_MMA(0, 1, At, B1); PG8_BAR; PG8_SCHED;
            PG8_LDA(At, 1, 1); PG8_STAGE(PG8_SB(1, 0), b3, voffB); PG8_STAGE(PG8_SB(1, 1), b3 + hstep, voffB); PG8_STAGE(PG8_SA(1, 0), a3, voffA);
            PG8_WAIT_V(8); PG8_WAIT_L(0); PG8_BAR; PG8_MMA(1, 0, At, B0); PG8_MMA(1, 1, At, B1); PG8_BAR; PG8_SCHED;
            } else {
            PG8_LDB(B0, 0, 0); PG8_SCHED; PG8_LDA(At, 0, 0); PG8_STAGE(PG8_SA(1, 1), a1 + hstep, voffA);
            PG8_WAIT_L(8); PG8_BAR; PG8_WAIT_L(0); PG8_MMA(0, 0, At, B0); PG8_BAR; PG8_SCHED;
            PG8_LDB(B1, 0, 1); PG8_STAGE(PG8_SB(0, 0), b2, voffB);
            PG8_BAR; PG8_WAIT_L(0); PG8_MMA(0, 1, At, B1); PG8_BAR;
            PG8_LDA(At, 0, 1); PG8_STAGE(PG8_SA(0, 0), a2, voffA);
            PG8_BAR; PG8_WAIT_L(0); PG8_MMA(1, 0, At, B0); PG8_BAR; PG8_SCHED;
            PG8_STAGE(PG8_SB(0, 1), b2 + hstep, voffB);
            PG8_WAIT_V(6); PG8_BAR; PG8_MMA(1, 1, At, B1); PG8_BAR;
            PG8_LDB(B0, 1, 0); PG8_SCHED; PG8_LDA(At, 1, 0); PG8_STAGE(PG8_SA(0, 1), a2 + hstep, voffA);
            PG8_WAIT_L(8); PG8_BAR; PG8_WAIT_L(0); PG8_MMA(0, 0, At, B0); PG8_BAR; PG8_SCHED;
            PG8_LDB(B1, 1, 1); PG8_STAGE(PG8_SB(1, 0), b3, voffB);
            PG8_BAR; PG8_WAIT_L(0); PG8_MMA(0, 1, At, B1); PG8_BAR;
            PG8_LDA(At, 1, 1); PG8_STAGE(PG8_SA(1, 0), a3, voffA);
            PG8_BAR; PG8_WAIT_L(0); PG8_MMA(1, 0, At, B0); PG8_BAR; PG8_SCHED;
            PG8_STAGE(PG8_SB(1, 1), b3 + hstep, voffB);
            PG8_WAIT_V(6); PG8_BAR; PG8_MMA(1, 1, At, B1); PG8_BAR;
            }
        }
        if constexpr (ALIGN_EPI) { if (wr == 0) PG8_BAR; }
        if constexpr (!Epi::AFTER_DRAIN) { E(acc, cur, wr, wc, fr, fq); S.done(cur); }
        if (!has_next) break;
#pragma unroll
        for (int a = 0; a < 2; ++a)
#pragma unroll
            for (int b = 0; b < 2; ++b)
#pragma unroll
                for (int m = 0; m < 4; ++m)
#pragma unroll
                    for (int n = 0; n < 2; ++n) acc[a][b][m][n] = (f32x4){0.f, 0.f, 0.f, 0.f};
        cur = nxt; cA = nA; cB = nB; ++ui;
        if constexpr (ALIGN_EPI) { if (wr == 1) PG8_BAR; }
    }
    PG8_WAIT_V(0);
    if constexpr (!ALIGN_EPI) { if (wr == 0) PG8_BAR; }
    PG8_BAR;
#undef PG8_SA
#undef PG8_SB
#undef PG8_STAGE
#undef PG8_LDA
#undef PG8_LDB
#undef PG8_MMA
#undef PG8_WAIT_V
#undef PG8_WAIT_L
#undef PG8_BAR
#undef PG8_SCHED
}
}

constexpr size_t MiB = 1u << 20;
constexpr size_t WS_WIN = 1 * MiB, WS_WOUT = 33 * MiB, WS_WKV = 41 * MiB, WS_WQ = 43 * MiB, WS_WAO = 51 * MiB, WS_WGU0 = 59 * MiB, WS_WGU1 = 103 * MiB,
                 WS_WD0 = 147 * MiB, WS_WD1 = 169 * MiB, WS_ROPE = 191 * MiB, WS_XN = 192 * MiB, WS_Y = 226 * MiB, WS_O2 = 294 * MiB, WS_R1 = 328 * MiB;
constexpr size_t WS_GQT = 192 * MiB, WS_GKH = 224 * MiB, WS_GVT = 256 * MiB;
constexpr size_t WS_GPS = WS_R1 + 34 * MiB, WS_GDEC = WS_R1 + 42 * MiB;
constexpr size_t WS_QS = WS_R1, WS_VB = WS_R1 + 68 * MiB, WS_SG = WS_R1 + 102 * MiB, WS_LOGF = WS_R1 + 136 * MiB;
constexpr size_t WS_HACT = WS_R1;
constexpr size_t WS_XKV = WS_R1, WS_QR = WS_R1 + 34 * MiB, WS_KB = WS_R1 + 68 * MiB, WS_VKV = WS_R1 + 73 * MiB;
constexpr size_t WS_SLAB = WS_R1 + 204 * MiB;
constexpr size_t WS_END = WS_SLAB + 32 * MiB;
constexpr size_t WS_HB = WS_LOGF;
constexpr size_t WS_CNT = 65536;
constexpr size_t OUT_Y = 0, OUT_SP = (size_t)M * D, OUT_SS = OUT_SP + 4 * 16 * 16384, OUT_KWIN = OUT_SS + (size_t)128 * 16 * 16384, OUT_VWIN = OUT_KWIN + 131072,
                 OUT_KNEW = OUT_VWIN + 131072, OUT_VNEW = OUT_KNEW + 131072, OUT_END = OUT_VNEW + 131072;

constexpr int LDS_BYTES = 147456;
constexpr int NWAVES = 8;

template <bool GU> __device__ __forceinline__ void p0_transpose_item(const float* W, int K, int N, bf16_t* WT, LAS float* scr, int item, int lane) {
    const int nblk = N / 32, kb = item / nblk, nb = item % nblk, k0 = 64 * kb, n0 = 32 * nb;
    f32x4 wv[8];
#pragma unroll
    for (int i = 0; i < 8; ++i) wv[i] = *(const f32x4*)(W + (size_t)(k0 + 8 * i + (lane >> 3)) * N + n0 + 4 * (lane & 7));
#pragma unroll
    for (int i = 0; i < 8; ++i) { LAS float* d = scr + (8 * i + (lane >> 3)) * 33 + 4 * (lane & 7); d[0] = wv[i][0]; d[1] = wv[i][1]; d[2] = wv[i][2]; d[3] = wv[i][3]; }
    asm volatile("s_waitcnt lgkmcnt(0)" ::: "memory");
    int r0 = n0;
    if (GU) { const int half = n0 >= DFF ? 1 : 0, rem = n0 - half * DFF; r0 = (rem >> 7) * 256 + half * 128 + (rem & 127); }
    const int c = lane & 7;
#pragma unroll
    for (int j = 0; j < 4; ++j) { const int n = (lane >> 3) + 8 * j; const LAS float* s = scr + (8 * c) * 33 + n;
        u32x4 o; o.x = pk2(s[0 * 33], s[1 * 33]); o.y = pk2(s[2 * 33], s[3 * 33]); o.z = pk2(s[4 * 33], s[5 * 33]); o.w = pk2(s[6 * 33], s[7 * 33]);
        *(u32x4*)(WT + (size_t)(r0 + n) * K + k0 + 8 * c) = o; }
    asm volatile("s_waitcnt lgkmcnt(0)" ::: "memory");
}

template <bool GU> __device__ __forceinline__ void cvt_stream(const float* W, int K, int N, bf16_t* WT, LAS float* scr, int first, int stride, int nitems, int lane) {
    if (first >= nitems) return;
    const int nblk = N / 32, lr = lane >> 3, lc = 4 * (lane & 7);
    f32x4 wv[8];
    { const int k0 = 64 * (first / nblk), n0 = 32 * (first % nblk);
#pragma unroll
      for (int i = 0; i < 8; ++i) wv[i] = *(const f32x4*)(W + (size_t)(k0 + 8 * i + lr) * N + n0 + lc); }
    for (int it = first; it < nitems; it += stride) {
        const int k0 = 64 * (it / nblk), n0 = 32 * (it % nblk);
#pragma unroll
        for (int i = 0; i < 8; ++i) { LAS float* d = scr + (8 * i + lr) * 33 + lc; d[0] = wv[i][0]; d[1] = wv[i][1]; d[2] = wv[i][2]; d[3] = wv[i][3]; }
        const int itn = it + stride;
        if (itn < nitems) { const int k1 = 64 * (itn / nblk), n1 = 32 * (itn % nblk);
#pragma unroll
            for (int i = 0; i < 8; ++i) wv[i] = *(const f32x4*)(W + (size_t)(k1 + 8 * i + lr) * N + n1 + lc); }
        asm volatile("s_waitcnt lgkmcnt(0)" ::: "memory");
        int r0 = n0;
        if (GU) { const int half = n0 >= DFF ? 1 : 0, rem = n0 - half * DFF; r0 = (rem >> 7) * 256 + half * 128 + (rem & 127); }
        const int c = lane & 7;
#pragma unroll
        for (int j = 0; j < 4; ++j) { const int n = (lane >> 3) + 8 * j; const LAS float* sp = scr + (8 * c) * 33 + n;
            u32x4 o; o.x = pk2(sp[0 * 33], sp[1 * 33]); o.y = pk2(sp[2 * 33], sp[3 * 33]); o.z = pk2(sp[4 * 33], sp[5 * 33]); o.w = pk2(sp[6 * 33], sp[7 * 33]);
            *(u32x4*)(WT + (size_t)(r0 + n) * K + k0 + 8 * c) = o; }
        asm volatile("s_waitcnt lgkmcnt(0)" ::: "memory");
    }
}

template <bool HASY, bool HASA, bool HASB, bool HIN16 = false, bool HOUT16 = false>
__device__ __forceinline__ void row_pass(const void* hin, const bf16_t* Yrow, const float* gpost, void* hout, const float* gA, bf16_t* outA, const float* gB, bf16_t* outB, int lane) {
    f32x4 h[8], gp[8], ga[8], gb[8]; u32x2 yw[8];
    if (HIN16) { const u32x2* hr = (const u32x2*)hin + lane;
#pragma unroll
        for (int j = 0; j < 8; ++j) { const u32x2 hw = hr[64 * j]; h[j] = (f32x4){bf2f(hw.x & 0xffffu), __uint_as_float(hw.x & 0xffff0000u), bf2f(hw.y & 0xffffu), __uint_as_float(hw.y & 0xffff0000u)}; }
    } else { const f32x4* hr = (const f32x4*)hin + lane;
#pragma unroll
        for (int j = 0; j < 8; ++j) h[j] = hr[64 * j];
    }
    if (HASY) {
#pragma unroll
        for (int j = 0; j < 8; ++j) { yw[j] = ((const u32x2*)Yrow + lane)[64 * j]; gp[j] = ((const f32x4*)gpost + lane)[64 * j]; }
    }
    if (HASA) {
#pragma unroll
        for (int j = 0; j < 8; ++j) ga[j] = ((const f32x4*)gA + lane)[64 * j];
    }
    if (HASB) {
#pragma unroll
        for (int j = 0; j < 8; ++j) gb[j] = ((const f32x4*)gB + lane)[64 * j];
    }
    if (HASY) {
        f32x4 y[8]; float ss = 0.f;
#pragma unroll
        for (int j = 0; j < 8; ++j) { y[j] = (f32x4){bf2f(yw[j].x & 0xffffu), __uint_as_float(yw[j].x & 0xffff0000u), bf2f(yw[j].y & 0xffffu), __uint_as_float(yw[j].y & 0xffff0000u)}; ss += (y[j].x * y[j].x + y[j].y * y[j].y) + (y[j].z * y[j].z + y[j].w * y[j].w); }
        const float rstd = rsqrtf(wave_sum(ss) * (1.0f / D) + EPS);
#pragma unroll
        for (int j = 0; j < 8; ++j) { h[j] = h[j] + y[j] * rstd * gp[j];
            if (HOUT16) { u32x2 w; w.x = pk2(h[j].x, h[j].y); w.y = pk2(h[j].z, h[j].w); ((u32x2*)hout + lane)[64 * j] = w; } else ((f32x4*)hout + lane)[64 * j] = h[j]; }
    }
    if (HASA || HASB) {
        float ss = 0.f;
#pragma unroll
        for (int j = 0; j < 8; ++j) ss += (h[j].x * h[j].x + h[j].y * h[j].y) + (h[j].z * h[j].z + h[j].w * h[j].w);
        const float rstd = rsqrtf(wave_sum(ss) * (1.0f / D) + EPS);
        if (HASA) { u32x2* oa = (u32x2*)outA + lane;
#pragma unroll
            for (int j = 0; j < 8; ++j) { const f32x4 v = h[j] * rstd * ga[j]; u32x2 w; w.x = pk2(v.x, v.y); w.y = pk2(v.z, v.w); oa[64 * j] = w; } }
        if (HASB) { u32x2* ob = (u32x2*)outB + lane;
#pragma unroll
            for (int j = 0; j < 8; ++j) { const f32x4 v = h[j] * rstd * gb[j]; u32x2 w; w.x = pk2(v.x, v.y); w.y = pk2(v.z, v.w); ob[64 * j] = w; } }
    }
}

#define LDS_BARRIER() do { asm volatile("s_waitcnt lgkmcnt(0)" ::: "memory"); __builtin_amdgcn_s_barrier(); asm volatile("" ::: "memory"); } while (0)
namespace gla {
constexpr int QT_OFF = 0, TOK_STRIDE = 272;
constexpr int KT_OFF = 64 * 272;
constexpr int KH_OFF = 2 * 64 * 272, CH_STRIDE = 144;
constexpr int VT_OFF = KH_OFF + 128 * 144;
constexpr int DEC_OFF = VT_OFF + 128 * 144;
constexpr int OS_OFF = DEC_OFF + 1024, OS_STRIDE = 528;
constexpr int END = OS_OFF + 64 * 528;
static_assert(END <= 131072, "gla lds");
struct P { const bf16_t* Qs; const float* LOGF; const bf16_t* Vb; const bf16_t* SG; const float* gnorm; bf16_t* O2;
           unsigned char* G_QT; unsigned char* G_KH; unsigned char* G_VT; unsigned char* G_PS; unsigned char* G_DEC; };

__device__ __forceinline__ bf16x8 mk8(u32x2 lo, u32x2 hi) { u32x4 t; t.x = lo.x; t.y = lo.y; t.z = hi.x; t.w = hi.y; return __builtin_bit_cast(bf16x8, t); }
__device__ __forceinline__ bf16x8 pk8(f32x4 a, f32x4 b) { u32x4 t; t.x = pk2(a[0], a[1]); t.y = pk2(a[2], a[3]); t.z = pk2(b[0], b[1]); t.w = pk2(b[2], b[3]); return __builtin_bit_cast(bf16x8, t); }

__device__ __forceinline__ void intra_items(LAS unsigned char* lds, const P& p, int first, int stride, int nitems) {
    const int tid = threadIdx.x, lane = tid & 63, w = __builtin_amdgcn_readfirstlane(tid >> 6), l16 = lane & 15, g = lane >> 4;
    const int pk = tid & 127, grp = tid >> 7, pc = grp >> 1, hf = grp & 1;
    float lfo[16]; unsigned qv[16], vv[16];
#define GLA_LOAD_RAW(id) do { const int bh_ = (id) >> 5; const size_t R_ = (size_t)(bh_ >> 4) * TP + (size_t)((id) & 31) * 64; const int hc_ = (bh_ & 15) * 128; \
        _Pragma("unroll") for (int i = 0; i < 16; ++i) { const int tok = 16 * grp + i; lfo[i] = p.LOGF[(R_ + tok) * D + hc_ + pk]; \
            qv[i] = (unsigned)p.Qs[(R_ + tok) * D + hc_ + pk]; vv[i] = (unsigned)p.Vb[(R_ + tok) * D + hc_ + pk]; } } while (0)
    if (first < nitems) GLA_LOAD_RAW(first);
    for (int id = first; id < nitems; id += stride) {
        {
            float so = 0.f;
#pragma unroll
            for (int i = 0; i < 16; ++i) so += lfo[i];
            *(LAS float*)(lds + OS_OFF + tid * 4) = so;
            LDS_BARRIER();
            const float sx = *(const LAS float*)(lds + OS_OFF + (tid ^ 128) * 4);
            const float tot = so + sx;
            float b = hf ? sx : 0.f;
            unsigned khp[8], vtp[8]; float khprev = 0.f;
#pragma unroll
            for (int i = 0; i < 16; ++i) {
                const float l = lfo[i];
                b += l;
                const float kk = 1.0f - __expf(l);
                const float bc = fmaxf(b, -80.f);
                const float qq = bf2f(qv[i]) * __expf(bc);
                const float kt = kk * __expf(-bc);
                const float kh = kk * __expf(tot - b);
                const int t = 16 * grp + i;
                *(LAS bf16_t*)(lds + QT_OFF + t * TOK_STRIDE + pk * 2) = (bf16_t)(pk2(qq, 0.f) & 0xffffu);
                *(LAS bf16_t*)(lds + KT_OFF + t * TOK_STRIDE + pk * 2) = (bf16_t)(pk2(kt, 0.f) & 0xffffu);
                if (i & 1) { khp[i >> 1] = pk2(khprev, kh); vtp[i >> 1] = vv[i - 1] | (vv[i] << 16); } else khprev = kh;
            }
            LAS u32x4* khd = (LAS u32x4*)(lds + KH_OFF + pk * CH_STRIDE + grp * 32); LAS u32x4* vtd = (LAS u32x4*)(lds + VT_OFF + pk * CH_STRIDE + grp * 32);
            khd[0] = (u32x4){khp[0], khp[1], khp[2], khp[3]}; khd[1] = (u32x4){khp[4], khp[5], khp[6], khp[7]};
            vtd[0] = (u32x4){vtp[0], vtp[1], vtp[2], vtp[3]}; vtd[1] = (u32x4){vtp[4], vtp[5], vtp[6], vtp[7]};
            if (hf == 0) *(LAS float*)(lds + DEC_OFF + pc * 512 + pk * 4) = __expf(tot);
        }
        LDS_BARRIER();
        if (id + stride < nitems) GLA_LOAD_RAW(id + stride);
        {
            const int c = w >> 2, st = (w >> 1) & 1, tt = w & 1, tb = 32 * c;
            f32x4 a4 = (f32x4){0.f, 0.f, 0.f, 0.f};
#pragma unroll
            for (int ks = 0; ks < 4; ++ks) {
                const bf16x8 a = *(const LAS bf16x8*)(lds + KT_OFF + (tb + 16 * st + l16) * TOK_STRIDE + (32 * ks + 8 * g) * 2);
                const bf16x8 bq = *(const LAS bf16x8*)(lds + QT_OFF + (tb + 16 * tt + l16) * TOK_STRIDE + (32 * ks + 8 * g) * 2);
                a4 = __builtin_amdgcn_mfma_f32_16x16x32_bf16(a, bq, a4, 0, 0, 0);
            }
#pragma unroll
            for (int j = 0; j < 4; ++j) { const int s_ = 16 * st + 4 * g + j, t_ = 16 * tt + l16; a4[j] = s_ <= t_ ? a4[j] : 0.f; }
            u32x2 pw; pw.x = pk2(a4[0], a4[1]); pw.y = pk2(a4[2], a4[3]);
            *(u32x2*)(p.G_PS + (size_t)id * 4096 + w * 512 + lane * 8) = pw;
        }
#pragma unroll
        for (int i = 0; i < 2; ++i) { const int pi = tid + 512 * i;
            *(u32x4*)(p.G_QT + (size_t)id * 16384 + pi * 16) = *(const LAS u32x4*)(lds + QT_OFF + (pi >> 4) * TOK_STRIDE + (pi & 15) * 16);
            *(u32x4*)(p.G_KH + (size_t)id * 16384 + pi * 16) = *(const LAS u32x4*)(lds + KH_OFF + (pi >> 3) * CH_STRIDE + (pi & 7) * 16);
            *(u32x4*)(p.G_VT + (size_t)id * 16384 + pi * 16) = *(const LAS u32x4*)(lds + VT_OFF + (pi >> 3) * CH_STRIDE + (pi & 7) * 16); }
        if (tid < 64) *(u32x4*)(p.G_DEC + (size_t)id * 1024 + tid * 16) = *(const LAS u32x4*)(lds + DEC_OFF + tid * 16);
        LDS_BARRIER();
    }
#undef GLA_LOAD_RAW
}

__device__ __forceinline__ void scan_seq(LAS unsigned char* lds, const P& p, int bh, float* Sout, int nsc) {
    const int tid = threadIdx.x, lane = tid & 63, w = __builtin_amdgcn_readfirstlane(tid >> 6), l16 = lane & 15, g = lane >> 4;
    const int pt = tid >> 3, pp = tid & 7;
    const int hc = (bh & 15) * 128; const size_t row0 = (size_t)(bh >> 4) * TP;
    if (tid < 128) *(LAS float*)(lds + END + tid * 4) = p.gnorm[hc + tid];
    f32x4 S[8];
#pragma unroll
    for (int i = 0; i < 8; ++i) S[i] = (f32x4){0.f, 0.f, 0.f, 0.f};
    u32x4 rq[2], rk[2], rv[2], rd, rp;
    u32x4 sg0, sg1, sg0n = (u32x4){0u, 0u, 0u, 0u}, sg1n = sg0n;
#define SCAN_LOAD(sc) do { const size_t id_ = (size_t)bh * 32 + ((sc) & 31); \
        _Pragma("unroll") for (int i = 0; i < 2; ++i) { const int pi = tid + 512 * i; rq[i] = *(const u32x4*)(p.G_QT + id_ * 16384 + pi * 16); rk[i] = *(const u32x4*)(p.G_KH + id_ * 16384 + pi * 16); rv[i] = *(const u32x4*)(p.G_VT + id_ * 16384 + pi * 16); } \
        rd = *(const u32x4*)(p.G_DEC + id_ * 1024 + (tid & 63) * 16); rp = *(const u32x4*)(p.G_PS + id_ * 4096 + (tid & 255) * 16); } while (0)
    { const u32x4* sgp = (const u32x4*)(p.SG + (row0 + pt) * D + hc + 16 * pp); sg0 = sgp[0]; sg1 = sgp[1]; }
    SCAN_LOAD(0);
    for (int scx = 0; scx < nsc; ++scx) {
        const int sc = scx & 31;
        const size_t R = row0 + (size_t)sc * 64;
#pragma unroll
        for (int i = 0; i < 2; ++i) { const int pi = tid + 512 * i;
            *(LAS u32x4*)(lds + QT_OFF + (pi >> 4) * TOK_STRIDE + (pi & 15) * 16) = rq[i];
            *(LAS u32x4*)(lds + KH_OFF + (pi >> 3) * CH_STRIDE + (pi & 7) * 16) = rk[i];
            *(LAS u32x4*)(lds + VT_OFF + (pi >> 3) * CH_STRIDE + (pi & 7) * 16) = rv[i]; }
        if (tid < 64) *(LAS u32x4*)(lds + DEC_OFF + tid * 16) = rd;
        if (tid < 256) *(LAS u32x4*)(lds + KT_OFF + tid * 16) = rp;
        LDS_BARRIER();
        if (scx + 1 < nsc) { const u32x4* sgp = (const u32x4*)(p.SG + (row0 + (size_t)((scx + 1) & 31) * 64 + pt) * D + hc + 16 * pp); sg0n = sgp[0]; sg1n = sgp[1]; SCAN_LOAD(scx + 1); }
#pragma unroll
        for (int c = 0; c < 2; ++c) {
            const int tb = 32 * c;
            const LAS unsigned char* vrow = lds + VT_OFF + (16 * w + l16) * CH_STRIDE + (tb + 4 * g) * 2;
            const bf16x8 vfrag = mk8(*(const LAS u32x2*)vrow, *(const LAS u32x2*)(vrow + 32));
            bf16x8 pf[2], bq[2][4], ka[8]; f32x4 d4[8];
#pragma unroll
            for (int tt = 0; tt < 2; ++tt) {
                pf[tt] = mk8(*(const LAS u32x2*)(lds + KT_OFF + ((c * 4 + tt) * 64 + lane) * 8), *(const LAS u32x2*)(lds + KT_OFF + ((c * 4 + 2 + tt) * 64 + lane) * 8));
#pragma unroll
                for (int j2 = 0; j2 < 4; ++j2) { const LAS unsigned char* qrow = lds + QT_OFF + (tb + 16 * tt + l16) * TOK_STRIDE + (32 * j2 + 4 * g) * 2;
                    bq[tt][j2] = mk8(*(const LAS u32x2*)qrow, *(const LAS u32x2*)(qrow + 32)); }
            }
#pragma unroll
            for (int i = 0; i < 8; ++i) { d4[i] = *(const LAS f32x4*)(lds + DEC_OFF + c * 512 + (16 * i + 4 * g) * 4);
                const LAS unsigned char* krow = lds + KH_OFF + (16 * i + l16) * CH_STRIDE + (tb + 4 * g) * 2; ka[i] = mk8(*(const LAS u32x2*)krow, *(const LAS u32x2*)(krow + 32)); }
            bf16x8 sa[4];
#pragma unroll
            for (int j2 = 0; j2 < 4; ++j2) sa[j2] = pk8(S[2 * j2], S[2 * j2 + 1]);
            const f32x4 z4 = (f32x4){0.f, 0.f, 0.f, 0.f};
            f32x4 oa0 = __builtin_amdgcn_mfma_f32_16x16x32_bf16(vfrag, pf[0], z4, 0, 0, 0);
            f32x4 oa1 = __builtin_amdgcn_mfma_f32_16x16x32_bf16(vfrag, pf[1], z4, 0, 0, 0);
            f32x4 ob0 = __builtin_amdgcn_mfma_f32_16x16x32_bf16(sa[1], bq[0][1], z4, 0, 0, 0);
            f32x4 ob1 = __builtin_amdgcn_mfma_f32_16x16x32_bf16(sa[1], bq[1][1], z4, 0, 0, 0);
            oa0 = __builtin_amdgcn_mfma_f32_16x16x32_bf16(sa[0], bq[0][0], oa0, 0, 0, 0);
            oa1 = __builtin_amdgcn_mfma_f32_16x16x32_bf16(sa[0], bq[1][0], oa1, 0, 0, 0);
            ob0 = __builtin_amdgcn_mfma_f32_16x16x32_bf16(sa[3], bq[0][3], ob0, 0, 0, 0);
            ob1 = __builtin_amdgcn_mfma_f32_16x16x32_bf16(sa[3], bq[1][3], ob1, 0, 0, 0);
            oa0 = __builtin_amdgcn_mfma_f32_16x16x32_bf16(sa[2], bq[0][2], oa0, 0, 0, 0);
            oa1 = __builtin_amdgcn_mfma_f32_16x16x32_bf16(sa[2], bq[1][2], oa1, 0, 0, 0);
#pragma unroll
            for (int i = 0; i < 8; ++i) S[i] = __builtin_amdgcn_mfma_f32_16x16x32_bf16(ka[i], vfrag, S[i] * d4[i], 0, 0, 0);
            *(LAS f32x4*)(lds + OS_OFF + (tb + l16) * OS_STRIDE + (16 * w + 4 * g) * 4) = oa0 + ob0;
            *(LAS f32x4*)(lds + OS_OFF + (tb + 16 + l16) * OS_STRIDE + (16 * w + 4 * g) * 4) = oa1 + ob1;
        }
        LDS_BARRIER();
        {
            const LAS f32x4* op = (const LAS f32x4*)(lds + OS_OFF + pt * OS_STRIDE + pp * 64);
            f32x4 o[4]; float ss = 0.f;
#pragma unroll
            for (int q = 0; q < 4; ++q) { o[q] = op[q]; ss += (o[q].x * o[q].x + o[q].y * o[q].y) + (o[q].z * o[q].z + o[q].w * o[q].w); }
            ss += __shfl_xor(ss, 1); ss += __shfl_xor(ss, 2); ss += __shfl_xor(ss, 4);
            const float rstd = rsqrtf(ss * (1.0f / 128.0f) + EPS);
            const unsigned sgw[8] = {sg0.x, sg0.y, sg0.z, sg0.w, sg1.x, sg1.y, sg1.z, sg1.w};
            unsigned ow[8];
#pragma unroll
            for (int q = 0; q < 4; ++q) {
                const f32x4 v = o[q] * rstd * *(const LAS f32x4*)(lds + END + (16 * pp + 4 * q) * 4);
                ow[2 * q] = pk2(v.x * bf2f(sgw[2 * q] & 0xffffu), v.y * bf2f(sgw[2 * q] >> 16));
                ow[2 * q + 1] = pk2(v.z * bf2f(sgw[2 * q + 1] & 0xffffu), v.w * bf2f(sgw[2 * q + 1] >> 16));
            }
            u32x4* od = (u32x4*)(p.O2 + (R + pt) * D + hc + 16 * pp);
            od[0] = (u32x4){ow[0], ow[1], ow[2], ow[3]}; od[1] = (u32x4){ow[4], ow[5], ow[6], ow[7]};
        }
        sg0 = sg0n; sg1 = sg1n;
    }
#undef SCAN_LOAD
#pragma unroll
    for (int i = 0; i < 8; ++i)
#pragma unroll
        for (int j = 0; j < 4; ++j) Sout[(size_t)(16 * i + 4 * g + j) * 128 + 16 * w + l16] = S[i][j];
}

constexpr int DF_OFF = 0, DK_OFF = 2048, DQ_OFF = 4096, DV_OFF = 6144, DR_OFF = 8192, DW_OFF = 16384;
__device__ __forceinline__ void decode_items(LAS unsigned char* lds, const P& p, const float* state_in, float* state_out, int first, int stride, int nitems) {
    const int tid = threadIdx.x, lane = tid & 63, w = __builtin_amdgcn_readfirstlane(tid >> 6);
    const int v = tid & 127, kg = tid >> 7;
    float sA[32], sB[32];
    float lA = 0.f, gA = 0.f, lB = 0.f, gB = 0.f; unsigned qA = 0u, vA = 0u, sgA = 0u, qB = 0u, vB = 0u, sgB = 0u;
#define DEC_PREFETCH(itn_, s, c_l, c_q, c_v, c_sg, c_gn) do { const int itn = (itn_) & (BS * 16 - 1); \
        _Pragma("unroll") for (int q = 0; q < 4; ++q) { const float* sp = state_in + (size_t)itn * 16384 + (size_t)(32 * kg + 8 * q) * 128 + v; \
            _Pragma("unroll") for (int i = 0; i < 8; ++i) s[8 * q + i] = sp[i * 128]; } \
        const int hc_ = (itn & 15) * 128; const size_t off_ = ((size_t)NPROMPT + 4 * (itn >> 4) + kg) * D + hc_ + v; \
        c_l = p.LOGF[off_]; c_q = (unsigned)p.Qs[off_]; c_v = (unsigned)p.Vb[off_]; c_sg = (unsigned)p.SG[off_]; c_gn = p.gnorm[hc_ + v]; } while (0)
#define DEC_BODY(itx_, s, c_l, c_q, c_v, c_sg, c_gn) do { const int it = (itx_) & (BS * 16 - 1); \
        const size_t off = ((size_t)NPROMPT + 4 * (it >> 4) + kg) * D + (it & 15) * 128 + v; \
        const float gate = c_gn * bf2f(c_sg); \
        { const float f = __expf(c_l); \
          *(LAS float*)(lds + DF_OFF + tid * 4) = f; *(LAS float*)(lds + DK_OFF + tid * 4) = 1.0f - f; \
          *(LAS float*)(lds + DQ_OFF + tid * 4) = bf2f(c_q); *(LAS float*)(lds + DV_OFF + tid * 4) = bf2f(c_v); } \
        LDS_BARRIER(); \
        _Pragma("unroll 1") for (int t = 0; t < 4; ++t) { \
            const float vt = *(const LAS float*)(lds + DV_OFF + (t * 128 + v) * 4); \
            float a = 0.f; \
            _Pragma("unroll") for (int i4 = 0; i4 < 8; ++i4) { \
                const f32x4 f4 = *(const LAS f32x4*)(lds + DF_OFF + (t * 128 + 32 * kg + 4 * i4) * 4), k4 = *(const LAS f32x4*)(lds + DK_OFF + (t * 128 + 32 * kg + 4 * i4) * 4), \
                            q4 = *(const LAS f32x4*)(lds + DQ_OFF + (t * 128 + 32 * kg + 4 * i4) * 4); \
                _Pragma("unroll") for (int j = 0; j < 4; ++j) { const float sn = f4[j] * s[4 * i4 + j] + k4[j] * vt; s[4 * i4 + j] = sn; a += q4[j] * sn; } \
            } \
            *(LAS float*)(lds + DR_OFF + ((t * 4 + kg) * 128 + v) * 4) = a; \
        } \
        _Pragma("unroll") for (int q = 0; q < 4; ++q) { \
            float* so = state_out + (size_t)it * 16384 + (size_t)(32 * kg + 8 * q) * 128 + v; \
            _Pragma("unroll") for (int i = 0; i < 8; ++i) so[i * 128] = s[8 * q + i]; \
        } \
        if ((itx_) + 2 * stride < nitems) DEC_PREFETCH((itx_) + 2 * stride, s, c_l, c_q, c_v, c_sg, c_gn); \
        LDS_BARRIER(); \
        const LAS float* rr = (const LAS float*)(lds + DR_OFF + (kg * 4 * 128 + v) * 4); \
        const float o = (rr[0] + rr[128]) + (rr[256] + rr[384]); \
        const float ws = wave_sum(o * o); \
        if (lane == 0) *(LAS float*)(lds + DW_OFF + w * 4) = ws; \
        LDS_BARRIER(); \
        const float ss = *(const LAS float*)(lds + DW_OFF + (2 * kg) * 4) + *(const LAS float*)(lds + DW_OFF + (2 * kg + 1) * 4); \
        const float rstd = rsqrtf(ss * (1.0f / 128.0f) + EPS); \
        p.O2[off] = (bf16_t)(pk2(o * rstd * gate, 0.f) & 0xffffu); } while (0)
    if (first < nitems) DEC_PREFETCH(first, sA, lA, qA, vA, sgA, gA);
    if (first + stride < nitems) DEC_PREFETCH(first + stride, sB, lB, qB, vB, sgB, gB);
    for (int itx = first; itx < nitems; itx += 2 * stride) {
        DEC_BODY(itx, sA, lA, qA, vA, sgA, gA);
        if (itx + stride < nitems) DEC_BODY(itx + stride, sB, lB, qB, vB, sgB, gB);
    }
#undef DEC_BODY
#undef DEC_PREFETCH
}
}

namespace att {
constexpr int KS_OFF = 0, KS_STRIDE = 144;
constexpr int VT_OFF = 256 * 144, VT_STRIDE = 528;
struct P { const bf16_t* Qr; const bf16_t* Kb; const bf16_t* Vkv; const float* ck; const float* cv; const float* sinks; bf16_t* O; };

__device__ __forceinline__ void unit(LAS unsigned char* lds, const P& p, bool prompt, int b, int kvh, int qb) {
    const int tid = threadIdx.x, lane = tid & 63, w = __builtin_amdgcn_readfirstlane(tid >> 6), l16 = lane & 15, g = lane >> 4;
    const int h = kvh * 8 + w;
    bf16x8 qn0, qn1;
    { const size_t qrow0 = prompt ? (size_t)(b * TP + 128 * qb + l16) : (size_t)(NPROMPT + 4 * b + min(l16, 3));
      const bf16_t* qp = p.Qr + qrow0 * D + h * 64 + 8 * g; qn0 = *(const bf16x8*)qp; qn1 = *(const bf16x8*)(qp + 32); }
    __syncthreads();
#pragma unroll
    for (int i = 0; i < 4; ++i) {
        const int e = tid + 512 * i;
        {
            const int key = e >> 3, c8 = e & 7; u32x4 kv = (u32x4){0u, 0u, 0u, 0u};
            if (prompt) { if (qb > 0 || key >= 128) kv = *(const u32x4*)(p.Kb + (size_t)(b * TP + 128 * (qb - 1) + key) * 256 + kvh * 64 + c8 * 8); }
            else if (key < 128) { const f32x4* s = (const f32x4*)(p.ck + ((size_t)(b * 128 + key) * 4 + kvh) * 64 + c8 * 8); const f32x4 a = s[0], c = s[1]; kv = (u32x4){pk2(a.x, a.y), pk2(a.z, a.w), pk2(c.x, c.y), pk2(c.z, c.w)}; }
            else if (key < 132) kv = *(const u32x4*)(p.Kb + (size_t)(NPROMPT + 4 * b + key - 128) * 256 + kvh * 64 + c8 * 8);
            if (prompt || key < 160) *(LAS u32x4*)(lds + KS_OFF + key * KS_STRIDE + c8 * 16) = kv;
        }
        {
            const int key = e & 255, c8 = e >> 8; u32x4 vv = (u32x4){0u, 0u, 0u, 0u};
            if (prompt) { if (qb > 0 || key >= 128) vv = *(const u32x4*)(p.Vkv + (size_t)(b * TP + 128 * (qb - 1) + key) * 256 + kvh * 64 + c8 * 8); }
            else if (key < 128) { const f32x4* s = (const f32x4*)(p.cv + ((size_t)(b * 128 + key) * 4 + kvh) * 64 + c8 * 8); const f32x4 a = s[0], c = s[1]; vv = (u32x4){pk2(a.x, a.y), pk2(a.z, a.w), pk2(c.x, c.y), pk2(c.z, c.w)}; }
            else if (key < 132) vv = *(const u32x4*)(p.Vkv + (size_t)(NPROMPT + 4 * b + key - 128) * 256 + kvh * 64 + c8 * 8);
            if (prompt || key < 160) {
                LAS bf16_t* d = (LAS bf16_t*)(lds + VT_OFF + (c8 * 8) * VT_STRIDE + key * 2);
                d[0 * (VT_STRIDE / 2)] = (bf16_t)(vv.x & 0xffffu); d[1 * (VT_STRIDE / 2)] = (bf16_t)(vv.x >> 16);
                d[2 * (VT_STRIDE / 2)] = (bf16_t)(vv.y & 0xffffu); d[3 * (VT_STRIDE / 2)] = (bf16_t)(vv.y >> 16);
                d[4 * (VT_STRIDE / 2)] = (bf16_t)(vv.z & 0xffffu); d[5 * (VT_STRIDE / 2)] = (bf16_t)(vv.z >> 16);
                d[6 * (VT_STRIDE / 2)] = (bf16_t)(vv.w & 0xffffu); d[7 * (VT_STRIDE / 2)] = (bf16_t)(vv.w >> 16);
            }
        }
    }
    __syncthreads();
    const float sink = p.sinks[h];
    const bool hasprev = !prompt || qb > 0;
    const int nqt = prompt ? 8 : 1;
    for (int qt = 0; qt < nqt; ++qt) {
        const int qi = 16 * qt + l16;
        const size_t qrow = prompt ? (size_t)(b * TP + 128 * qb + qi) : (size_t)(NPROMPT + 4 * b + min(l16, 3));
        const bf16x8 qf[2] = {qn0, qn1};
        if (qt + 1 < nqt) { const bf16_t* qp = p.Qr + (qrow + 16) * D + h * 64 + 8 * g; qn0 = *(const bf16x8*)qp; qn1 = *(const bf16x8*)(qp + 32); }
        const int kt0 = 2 * (qt >> 1);
        f32x4 sc[10];
        float mx = -INFINITY;
#pragma unroll
        for (int ti = 0; ti < 10; ++ti) {
            const LAS unsigned char* kr = lds + KS_OFF + (16 * (kt0 + ti) + l16) * KS_STRIDE + 16 * g;
            f32x4 a4 = (f32x4){0.f, 0.f, 0.f, 0.f};
            a4 = __builtin_amdgcn_mfma_f32_16x16x32_bf16(*(const LAS bf16x8*)kr, qf[0], a4, 0, 0, 0);
            a4 = __builtin_amdgcn_mfma_f32_16x16x32_bf16(*(const LAS bf16x8*)(kr + 64), qf[1], a4, 0, 0, 0);
#pragma unroll
            for (int j = 0; j < 4; ++j) {
                const int jk = 16 * (kt0 + ti) + 4 * g + j;
                const bool valid = jk > qi && jk <= qi + 128 && (hasprev || jk >= 128);
                a4[j] = valid ? a4[j] : -INFINITY; mx = fmaxf(mx, a4[j]);
            }
            sc[ti] = a4;
        }
        mx = fmaxf(mx, __shfl_xor(mx, 16)); mx = fmaxf(mx, __shfl_xor(mx, 32)); mx = fmaxf(mx, sink);
        float sum = 0.f;
#pragma unroll
        for (int ti = 0; ti < 10; ++ti)
#pragma unroll
            for (int j = 0; j < 4; ++j) { const float e = __expf(sc[ti][j] - mx); sc[ti][j] = e; sum += e; }
        sum += __shfl_xor(sum, 16); sum += __shfl_xor(sum, 32);
        const float inv = 1.0f / (sum + __expf(sink - mx));
        f32x4 o[4];
#pragma unroll
        for (int dt = 0; dt < 4; ++dt) o[dt] = (f32x4){0.f, 0.f, 0.f, 0.f};
#pragma unroll
        for (int pp = 0; pp < 5; ++pp) {
            const bf16x8 pb = gla::pk8(sc[2 * pp], sc[2 * pp + 1]);
#pragma unroll
            for (int dt = 0; dt < 4; ++dt) {
                const LAS unsigned char* vr = lds + VT_OFF + (16 * dt + l16) * VT_STRIDE + (16 * (kt0 + 2 * pp) + 4 * g) * 2;
                const bf16x8 va = gla::mk8(*(const LAS u32x2*)vr, *(const LAS u32x2*)(vr + 32));
                o[dt] = __builtin_amdgcn_mfma_f32_16x16x32_bf16(va, pb, o[dt], 0, 0, 0);
            }
        }
        if (prompt || l16 < 4) {
#pragma unroll
            for (int dt = 0; dt < 4; ++dt) {
                const f32x4 v = o[dt] * inv; u32x2 wv; wv.x = pk2(v.x, v.y); wv.y = pk2(v.z, v.w);
                *(u32x2*)(p.O + qrow * D + h * 64 + 16 * dt + 4 * g) = wv;
            }
        }
    }
}
}

#define XB_TMO      128
#define XB_XCNT(j)  (256  + 64 * (j))
#define XB_XSUB(j)  (1280 + 64 * (j))
#define XB_XGEN(j)  (2304 + 64 * (j))
#define XB_TOP      3328
#define XB_TOPGEN   3392
#define XCD_BAR_WORDS 3456
#define XB_SPIN_CAP (1u << 18)
__device__ __forceinline__ unsigned xb_ld(unsigned* p)              { return __hip_atomic_load(p, __ATOMIC_RELAXED, __HIP_MEMORY_SCOPE_AGENT); }
__device__ __forceinline__ unsigned xb_add(unsigned* p, unsigned v) { return __hip_atomic_fetch_add(p, v, __ATOMIC_RELAXED, __HIP_MEMORY_SCOPE_AGENT); }
__device__ __forceinline__ unsigned xb_xcc_id() { return (unsigned)__builtin_amdgcn_s_getreg((3 << 11) | 20) & 0xFu; }
#define XB_SPIN(cond, bar) do { unsigned _sp = 0; while (cond) { __builtin_amdgcn_s_sleep(1); \
    if ((++_sp & 255u) == 0u) { if (xb_ld(&(bar)[XB_TMO])) break; if (_sp > XB_SPIN_CAP) { atomicAdd(&(bar)[XB_TMO], 1u); break; } } } } while (0)
struct XcdBarrier { unsigned* bar; unsigned x; volatile LAS unsigned* st; };
__device__ __forceinline__ XcdBarrier xcd_barrier_post(unsigned* bar, volatile LAS unsigned* st) {
    XcdBarrier b; b.bar = bar; b.x = xb_xcc_id(); b.st = st;
    if (threadIdx.x == 0) (void)xb_add(&bar[XB_XCNT(b.x)], 1u);
    return b;
}
__device__ __forceinline__ void xcd_barrier_complete(unsigned* bar, unsigned x, unsigned& nloc, unsigned& nx) {
    const unsigned G = gridDim.x * gridDim.y * gridDim.z;
    unsigned sum, cnt, mine, sp = 0u;
    for (;;) {
        sum = 0u; cnt = 0u; mine = 0u;
#pragma unroll
        for (unsigned j = 0; j < 16; ++j) { const unsigned c = xb_ld(&bar[XB_XCNT(j)]); sum += c; cnt += (c > 0u) ? 1u : 0u; mine = (j == x) ? c : mine; }
        if (sum == G) break;
        __builtin_amdgcn_s_sleep(1);
        if ((++sp & 255u) == 0u) { if (xb_ld(&bar[XB_TMO])) break; if (sp > XB_SPIN_CAP) { atomicAdd(&bar[XB_TMO], 1u); break; } }
    }
    nloc = mine > 0u ? mine : 1u; nx = cnt > 0u ? cnt : 1u;
}
__device__ __forceinline__ void xcd_barrier(const XcdBarrier& b) {
    asm volatile("s_waitcnt vmcnt(0)" ::: "memory");
    __syncthreads();
    if (threadIdx.x == 0) {
        unsigned* bar = b.bar;
        __builtin_amdgcn_s_waitcnt(0);
        unsigned nloc = b.st[0], nx = b.st[1];
        if (nloc == 0u) { xcd_barrier_complete(bar, b.x, nloc, nx); b.st[0] = nloc; b.st[1] = nx; }
        const unsigned old = xb_add(&bar[XB_XSUB(b.x)], 1u);
        const unsigned gen = old / nloc;
        if (old + 1u == (gen + 1u) * nloc) {
            __builtin_amdgcn_fence(__ATOMIC_RELEASE, "agent");
            asm volatile("s_waitcnt vmcnt(0)" ::: "memory");
            const unsigned og = xb_add(&bar[XB_TOP], 1u);
            const unsigned tg = og / nx;
            if (og + 1u == (tg + 1u) * nx) xb_add(&bar[XB_TOPGEN], 1u);
            else XB_SPIN(xb_ld(&bar[XB_TOPGEN]) == tg, bar);
            __builtin_amdgcn_fence(__ATOMIC_ACQUIRE, "agent");
            xb_add(&bar[XB_XGEN(b.x)], 1u);
            asm volatile("s_waitcnt vmcnt(0)" ::: "memory");
        } else {
            XB_SPIN(xb_ld(&bar[XB_XGEN(b.x)]) == gen, bar);
            __builtin_amdgcn_fence(__ATOMIC_ACQUIRE, "agent");
            asm volatile("s_waitcnt vmcnt(0)" ::: "memory");
        }
    }
    __syncthreads();
}

struct Args { const float* in[20]; float* out; unsigned char* ws; int ph_lo, ph_hi; };
constexpr int N_PHASES = 16;

__global__ void __launch_bounds__(NWAVES * 64, 2) mk_fwd(Args args) {
    extern __shared__ __attribute__((aligned(16))) unsigned char lds_raw[];
    LAS unsigned char* lds = (LAS unsigned char*)lds_raw;
    cg::grid_group grid = cg::this_grid();
    const int tid = threadIdx.x, lane = tid & 63, wave = __builtin_amdgcn_readfirstlane(tid >> 6);
    const int G = gridDim.x, cb = blockIdx.x;
    const int gw = cb * NWAVES + wave, NGW = G * NWAVES;
    unsigned char* ws = args.ws;
    const float* x_prompt = args.in[0]; const float* x_sample = args.in[1]; const float* state_in = args.in[2]; const float* cache_k = args.in[3]; const float* cache_v = args.in[4];
    const float* g_mix_pre = args.in[5]; const float* g_mix_post = args.in[6]; const float* g_ffn_pre = args.in[7]; const float* g_ffn_post = args.in[8];
    const float* w_in = args.in[9]; const float* lbraw = args.in[10]; const float* g_hnorm = args.in[11]; const float* w_hout = args.in[12];
    const float* g_kv = args.in[13]; const float* w_kv = args.in[14]; const float* w_q = args.in[15]; const float* sinks = args.in[16]; const float* w_ao = args.in[17];
    const float* w_gu = args.in[18]; const float* w_dn = args.in[19];
    bf16_t* Win_t = (bf16_t*)(ws + WS_WIN); bf16_t* Wout_t = (bf16_t*)(ws + WS_WOUT); bf16_t* Wkv_t = (bf16_t*)(ws + WS_WKV); bf16_t* Wq_t = (bf16_t*)(ws + WS_WQ); bf16_t* Wao_t = (bf16_t*)(ws + WS_WAO);
    bf16_t* Wgu_t[2] = {(bf16_t*)(ws + WS_WGU0), (bf16_t*)(ws + WS_WGU1)}; bf16_t* Wd_t[2] = {(bf16_t*)(ws + WS_WD0), (bf16_t*)(ws + WS_WD1)};
    f32x2* rope = (f32x2*)(ws + WS_ROPE);
    bf16_t* XN = (bf16_t*)(ws + WS_XN); bf16_t* O2 = (bf16_t*)(ws + WS_O2); bf16_t* Y = (bf16_t*)(ws + WS_Y);
    bf16_t* Qs = (bf16_t*)(ws + WS_QS); float* LOGF = (float*)(ws + WS_LOGF); bf16_t* Vb = (bf16_t*)(ws + WS_VB); bf16_t* SG = (bf16_t*)(ws + WS_SG);
    bf16_t* Hact = (bf16_t*)(ws + WS_HACT);
    bf16_t* XKV = (bf16_t*)(ws + WS_XKV); bf16_t* Qr = (bf16_t*)(ws + WS_QR); bf16_t* Kb = (bf16_t*)(ws + WS_KB); bf16_t* Vkv = (bf16_t*)(ws + WS_VKV);
    float* out = args.out; float* H = out + OUT_Y; bf16_t* Hb = (bf16_t*)(ws + WS_HB);
    float* slab = (float*)(ws + WS_SLAB); unsigned* cntw = (unsigned*)(ws + WS_CNT);
    const int lo = args.ph_lo, hi = args.ph_hi;
    LAS float* scr = (LAS float*)(lds + wave * 16384);
    constexpr int I_IN = 32 * 256, I_SQ = 32 * 64, I_KV = 32 * 16, I_GU = 32 * 352, I_DN = 88 * 64;
#define IN(k) (lo <= (k) && (k) < hi)
#define SEAM(k) do { if (IN(k) && IN((k) + 1)) { if (lo < 0) grid.sync(); else xcd_barrier(bar); } } while (0)
    volatile LAS unsigned* MISC = (volatile LAS unsigned*)(lds + 131072 + 320);
    if (tid < 32) MISC[tid] = 0u;
    __syncthreads();
    XcdBarrier bar; bar.bar = (unsigned*)ws; bar.x = 0; bar.st = nullptr;
    if (hi - lo > 1) bar = xcd_barrier_post((unsigned*)ws, MISC + 8);

    if (IN(0)) {
        cvt_stream<false>(w_in, D, 4 * D, Win_t, scr, gw, NGW, I_IN, lane);
        for (int e = cb * 512 + tid; e < (TP + TS) * 8; e += G * 512) {
            const int idx = e >> 3, f = e & 7; const double pos = idx < TP ? (double)idx : (double)(8192 + idx - TP);
            const double invf[8] = {1.0, 0.19392274474868576, 0.03760603093086393, 0.007292664737217109, 0.001414213562373095, 0.0002742481756762073, 5.318295896944988e-05, 1.031338537721246e-05};
            double iv = invf[0];
#pragma unroll
            for (int q = 1; q < 8; ++q) iv = f == q ? invf[q] : iv;
            const double ang = pos * (double)(float)iv;
            const double TWO_PI = 6.283185307179586476925286766559;
            const double r = ang - TWO_PI * __builtin_rint(ang / TWO_PI);
            const double r2 = r * r;
            double sn = 0.0, cs = 0.0;
#pragma unroll
            for (int k = 14; k >= 1; --k) { sn = (1.0 - sn) * r2 / (double)((2 * k) * (2 * k + 1)); cs = (1.0 - cs) * r2 / (double)((2 * k - 1) * (2 * k)); }
            rope[e] = (f32x2){(float)(1.0 - cs), (float)(r * (1.0 - sn))};
        }
        for (int m = gw; m < M; m += NGW) {
            const float* xr = m < NPROMPT ? x_prompt + (size_t)m * D : x_sample + (size_t)(m - NPROMPT) * D;
            row_pass<false, true, false>(xr, nullptr, nullptr, nullptr, g_mix_pre, XN + (size_t)m * D, nullptr, nullptr, lane);
        }
    }
    SEAM(0);
    if (IN(1)) {
        pg8::Gemm g{XN, Win_t, M, 4 * D, D}; pg8::StaticOrder S; S.init(M, 4 * D, G, cb, D);
        pg8::EpiIn E{Qs, LOGF, Vb, SG, lbraw};
        pg8::gemm_phase<pg8::EpiIn, pg8::StaticOrder, true, true>(lds, g, S, E);
        if (cb >= 64) {
            const int wv_ = (cb - 64) * NWAVES + wave;
            if (wv_ < 256) cvt_stream<false>(w_hout, D, D, Wout_t, scr, wv_, 256, I_SQ, lane);
            else if (wv_ < 512) cvt_stream<false>(w_q, D, D, Wq_t, scr, wv_ - 256, 256, I_SQ, lane);
            else if (wv_ < 768) cvt_stream<false>(w_ao, D, D, Wao_t, scr, wv_ - 512, 256, I_SQ, lane);
            else if (wv_ < 832) cvt_stream<false>(w_kv, D, 512, Wkv_t, scr, wv_ - 768, 64, I_KV, lane);
            else cvt_stream<false>(w_dn, DFF, D, Wd_t[0], scr, wv_ - 832, 704, I_DN, lane);
        }
    }
    SEAM(1);
    gla::P gp{Qs, LOGF, Vb, SG, g_hnorm, O2, ws + WS_GQT, ws + WS_GKH, ws + WS_GVT, ws + WS_GPS, ws + WS_GDEC};
    if (IN(2)) {
        gla::intra_items(lds, gp, cb, G, 2048);
    }
    SEAM(2);
    if (IN(3)) {
        const int nA = 64;
        if (cb < nA) gla::scan_seq(lds, gp, cb, out + OUT_SP + (size_t)cb * 16384, 32);
        else {
            gla::decode_items(lds, gp, state_in, out + OUT_SS, cb - nA, G - nA, BS * 16);
            __syncthreads();
            cvt_stream<true>(w_gu, D, 2 * DFF, Wgu_t[0], scr, (cb - nA) * NWAVES + wave, (G - nA) * NWAVES, I_GU, lane);
        }
    }
    SEAM(3);
    if (IN(4)) {
        pg8::Gemm g{O2, Wout_t, M, D, D}; pg8::SplitOrder S; S.init(D, G, cb, D);
        pg8::EpiF32 E{Y, D, slab, cntw + 0 * 1024};
        pg8::gemm_phase<pg8::EpiF32, pg8::SplitOrder, true, true>(lds, g, S, E);
    }
    SEAM(4);
    if (IN(5)) {
        for (int m = gw; m < M; m += NGW) {
            const float* xr = m < NPROMPT ? x_prompt + (size_t)m * D : x_sample + (size_t)(m - NPROMPT) * D;
            row_pass<true, true, false, false, true>(xr, Y + (size_t)m * D, g_mix_post, Hb + (size_t)m * D, g_ffn_pre, XN + (size_t)m * D, nullptr, nullptr, lane);
        }
    }
    SEAM(5);
    if (IN(6)) {
        pg8::Gemm g{XN, Wgu_t[0], M, 2 * DFF, D}; pg8::StaticOrder S; S.init(M, 2 * DFF, G, cb, D);
        pg8::EpiSwiGLU E{Hact};
        pg8::gemm_phase<pg8::EpiSwiGLU, pg8::StaticOrder, true, true>(lds, g, S, E);
    }
    SEAM(6);
    if (IN(7)) {
        pg8::Gemm g{Hact, Wd_t[0], M, D, DFF}; pg8::SplitOrder S; S.init(D, G, cb, DFF);
        pg8::EpiF32 E{Y, D, slab, cntw + 1 * 1024};
        pg8::gemm_phase<pg8::EpiF32, pg8::SplitOrder, true, true>(lds, g, S, E);
    }
    SEAM(7);
    if (IN(8)) {
        for (int m = gw; m < M; m += NGW)
            row_pass<true, true, true, true, true>(Hb + (size_t)m * D, Y + (size_t)m * D, g_ffn_post, Hb + (size_t)m * D, g_mix_pre + D, XN + (size_t)m * D, g_kv, XKV + (size_t)m * D, lane);
    }
    SEAM(8);
    if (IN(9)) {
        { pg8::Gemm g{XKV, Wkv_t, M, 512, D}; pg8::StaticOrder S; S.init(M, 512, G, cb, D);
          pg8::EpiRope<1> E{Kb, Vkv, rope, out + OUT_KWIN, out + OUT_VWIN, out + OUT_KNEW, out + OUT_VNEW};
          pg8::gemm_phase<pg8::EpiRope<1>, pg8::StaticOrder, true, true>(lds, g, S, E); }
        { pg8::Gemm g{XN, Wq_t, M, D, D}; pg8::StaticOrder S; S.init(M, D, G, (cb + G - (68 % G)) % G, D);
          pg8::EpiRope<0> E{Qr, nullptr, rope, nullptr, nullptr, nullptr, nullptr};
          pg8::gemm_phase<pg8::EpiRope<0>, pg8::StaticOrder, true, true>(lds, g, S, E); }
        if (cb >= 84) {
            const int wv_ = (cb - 84) * NWAVES + wave;
            if (wv_ < 917) cvt_stream<true>(w_gu + (size_t)D * 2 * DFF, D, 2 * DFF, Wgu_t[1], scr, wv_, 917, I_GU, lane);
            else cvt_stream<false>(w_dn + (size_t)DFF * D, DFF, D, Wd_t[1], scr, wv_ - 917, 459, I_DN, lane);
        }
    }
    SEAM(9);
    if (IN(10)) {
        att::P ap{Qr, Kb, Vkv, cache_k, cache_v, sinks, O2};
        for (int u = cb; u < 256 + 512; u += G) {
            if (u < 256) att::unit(lds, ap, true, u >> 6, (u >> 4) & 3, u & 15);
            else { const int v = u - 256; att::unit(lds, ap, false, v >> 2, v & 3, 0); }
        }
    }
    SEAM(10);
    if (IN(11)) {
        pg8::Gemm g{O2, Wao_t, M, D, D}; pg8::SplitOrder S; S.init(D, G, cb, D);
        pg8::EpiF32 E{Y, D, slab, cntw + 2 * 1024};
        pg8::gemm_phase<pg8::EpiF32, pg8::SplitOrder, true, true>(lds, g, S, E);
    }
    SEAM(11);
    if (IN(12)) {
        for (int m = gw; m < M; m += NGW)
            row_pass<true, true, false, true, true>(Hb + (size_t)m * D, Y + (size_t)m * D, g_mix_post + D, Hb + (size_t)m * D, g_ffn_pre + D, XN + (size_t)m * D, nullptr, nullptr, lane);
    }
    SEAM(12);
    if (IN(13)) {
        pg8::Gemm g{XN, Wgu_t[1], M, 2 * DFF, D}; pg8::StaticOrder S; S.init(M, 2 * DFF, G, cb, D);
        pg8::EpiSwiGLU E{Hact};
        pg8::gemm_phase<pg8::EpiSwiGLU, pg8::StaticOrder, true, true>(lds, g, S, E);
    }
    SEAM(13);
    if (IN(14)) {
        pg8::Gemm g{Hact, Wd_t[1], M, D, DFF}; pg8::SplitOrder S; S.init(D, G, cb, DFF);
        pg8::EpiF32 E{Y, D, slab, cntw + 3 * 1024};
        pg8::gemm_phase<pg8::EpiF32, pg8::SplitOrder, true, true>(lds, g, S, E);
    }
    SEAM(14);
    if (IN(15)) {
        for (int m = gw; m < M; m += NGW)
            row_pass<true, false, false, true, false>(Hb + (size_t)m * D, Y + (size_t)m * D, g_ffn_post + D, H + (size_t)m * D, nullptr, nullptr, nullptr, nullptr, lane);
    }
#undef IN
#undef SEAM
}

extern "C" void kernel_launch(void* const* d_in, const int* in_sizes, int n_in, void* d_out, int out_size, void* d_ws, size_t ws_size, hipStream_t stream) {
    static int grid = 0;
    if (grid == 0) {
        if (n_in != 20 || (size_t)out_size != OUT_END || ws_size < WS_END) { fprintf(stderr, "kernel_launch: unexpected shapes: n_in %d out %d ws %zu (need %zu)\n", n_in, out_size, ws_size, (size_t)WS_END); grid = -1; return; }
        int dev = 0, cus = 0, per_cu = 0;
        hipGetDevice(&dev); hipDeviceGetAttribute(&cus, hipDeviceAttributeMultiprocessorCount, dev);
        if (hipFuncSetAttribute((const void*)mk_fwd, hipFuncAttributeMaxDynamicSharedMemorySize, LDS_BYTES) != hipSuccess) { fprintf(stderr, "kernel_launch: hipFuncSetAttribute failed\n"); grid = -1; return; }
        hipOccupancyMaxActiveBlocksPerMultiprocessor(&per_cu, (const void*)mk_fwd, NWAVES * 64, LDS_BYTES);
        (void)hipGetLastError();
        if (per_cu < 1) per_cu = 1;
        if (cus < 256) { fprintf(stderr, "kernel_launch: built for a 256-CU device (got %d)\n", cus); grid = -1; return; }
        grid = 256;
        fprintf(stderr, "kernel_launch: cus %d per_cu %d grid %d\n", cus, per_cu, grid);
    }
    if (grid < 0) return;
    if (hipMemsetAsync(d_ws, 0, 131072, stream) != hipSuccess) { fprintf(stderr, "kernel_launch: memset failed\n"); return; }
    Args a{};
    for (int i = 0; i < 20; ++i) a.in[i] = (const float*)d_in[i];
    a.out = (float*)d_out; a.ws = (unsigned char*)d_ws;
#if MK_ONE_LAUNCH
    void* kargs[] = {&a};
    a.ph_lo = 0; a.ph_hi = N_PHASES;
    hipError_t e = hipLaunchCooperativeKernel((const void*)mk_fwd, dim3(grid), dim3(NWAVES * 64), kargs, LDS_BYTES, stream);
    if (e != hipSuccess) fprintf(stderr, "kernel_launch: cooperative launch failed: %s\n", hipGetErrorString(e));
#else
    for (int ph = 0; ph < N_PHASES; ++ph) {
        a.ph_lo = ph; a.ph_hi = ph + 1;
        hipLaunchKernelGGL(mk_fwd, dim3(grid), dim3(NWAVES * 64), LDS_BYTES, stream, a);
    }
#endif
}
```

```cpp
#include <hip/hip_runtime.h>
#include <hip/hip_cooperative_groups.h>
#include <cstdio>
#include <cstdint>
namespace cg = cooperative_groups;

#ifndef MK_ONE_LAUNCH
#define MK_ONE_LAUNCH 1
#endif

#define LAS __attribute__((address_space(3)))
typedef unsigned short bf16_t;
typedef short bf16x8 __attribute__((ext_vector_type(8)));
typedef float f32x4 __attribute__((ext_vector_type(4)));
typedef float f32x2 __attribute__((ext_vector_type(2)));
typedef unsigned u32x4 __attribute__((ext_vector_type(4)));
typedef unsigned u32x2 __attribute__((ext_vector_type(2)));
typedef __bf16 bf16x2_t __attribute__((ext_vector_type(2)));

constexpr int D = 2048, NPROMPT = 8192, NSAMPLE = 512, M = NPROMPT + NSAMPLE;
constexpr int TP = 2048, TS = 4, BS = 128;
constexpr int DFF = 5632;
constexpr float EPS = 1e-6f;

__device__ __forceinline__ unsigned pk2(float lo, float hi) { f32x2 v = {lo, hi}; bf16x2_t b = __builtin_convertvector(v, bf16x2_t); return __builtin_bit_cast(unsigned, b); }
__device__ __forceinline__ float bf2f(unsigned b) { return __uint_as_float(b << 16); }
__device__ __forceinline__ float silu_f(float x) { return x * __builtin_amdgcn_rcpf(1.0f + __expf(-x)); }
__device__ __forceinline__ float wave_sum(float v) {
#pragma unroll
    for (int o = 1; o < 64; o <<= 1) v += __shfl_xor(v, o);
    return v;
}

namespace pg8 {
constexpr int BM = 256, BK = 64, HALF = 128, HTB = HALF * BK * 2, STAGE_BYTES = 8 * HTB, NXCD = 8, WGM = 8;
__host__ __device__ __forceinline__ int lds_byte(int r, int c) { const int st = (r >> 4) * 2 + (c >> 5), rr = r & 15, cc = c & 31, ob = rr * 64 + cc * 2; return st * 1024 + (ob ^ (((ob >> 9) & 1) << 5)); }
__host__ __device__ __forceinline__ void stage_rc(int b, int& R, int& C) { const int st = b / 1024, sb = b % 1024, swz = sb ^ (((sb >> 9) & 1) << 5); R = (st >> 1) * 16 + swz / 64; C = (st & 1) * 32 + (swz % 64) / 2; }
__host__ __device__ __forceinline__ int perm32(int rho) { const int n = rho >> 4, i = rho & 15; return 8 * (i >> 2) + 4 * n + (i & 3); }

struct Unit { int pm, pn, kt0, nt, split, uid; };
struct Gemm { const bf16_t* A; const bf16_t* Bt; int M, N, K; };

struct StaticOrder {
    int nM, nN, nwg, G, c, ntk;
    __host__ __device__ void init(int M_, int N_, int G_, int c_, int K_) { nM = M_ / BM; nN = N_ / BM; nwg = nM * nN; G = G_; c = c_; ntk = K_ / BK; }
    __host__ __device__ bool next(int i, Unit& u) const {
        const long L = (long)i * G + c; if (L >= nwg) return false;
        u.kt0 = 0; u.nt = ntk; u.split = -1; u.uid = 0;
        int wgid = (int)L; { const int q = nwg / NXCD, r = nwg % NXCD, xcd = wgid % NXCD, off = wgid / NXCD; wgid = (xcd < r ? xcd * (q + 1) : r * (q + 1) + (xcd - r) * q) + off; }
        const int nig = WGM * nN, gid = wgid / nig, fm = gid * WGM, gsz = (nM - fm) < WGM ? (nM - fm) : WGM;
        u.pm = fm + ((wgid % nig) % gsz); u.pn = (wgid % nig) / gsz; return true;
    }
    __device__ __forceinline__ void a_ready(const Unit&) const {}
    __device__ __forceinline__ void done(const Unit&) const {}
};

struct SplitOrder {
    StaticOrder so; int c;
    __host__ __device__ void init(int N_, int G_, int c_, int K_) { so.init(8192, N_, G_, c_, K_); c = c_; }
    __host__ __device__ bool next(int i, Unit& u) const {
        if (i == 0) return so.next(0, u);
        if (i == 1 && c < 128) { const int j = c >> 3, sp = c & 7; u.pm = 32 + (j >> 3); u.pn = j & 7; u.split = sp; u.uid = j;
            if (so.ntk == 32) { u.kt0 = 4 * sp; u.nt = 4; } else { u.kt0 = sp < 4 ? 12 * sp : 48 + 10 * (sp - 4); u.nt = sp < 4 ? 12 : 10; }
            return true; }
        return false;
    }
    __device__ __forceinline__ void a_ready(const Unit&) const {}
    __device__ __forceinline__ void done(const Unit&) const {}
};


struct EpiIn {
    static constexpr bool PERM = true, AFTER_DRAIN = false;
    bf16_t* Qs; float* LOGF; bf16_t* Vb; bf16_t* SG; const float* lbraw;
    __device__ __forceinline__ void operator()(const f32x4 (&acc)[2][2][4][2], const Unit& u, int wr, int wc, int fr, int fq) const {
        const int seg = u.pn >> 3;
        const int row0 = u.pm * BM + wr * 64 + fr;
        const int col0 = (u.pn & 7) * BM + wc * 32 + 8 * fq;
        if (seg == 1) {
#pragma unroll
            for (int bj = 0; bj < 2; ++bj) {
                const int c = col0 + bj * HALF;
                float lb[8];
#pragma unroll
                for (int e = 0; e < 8; ++e) { const float a0 = lbraw[c + e], a1 = lbraw[D + c + e]; lb[e] = __builtin_amdgcn_rcpf(1.0f + __expf(a1 - a0)); }
#pragma unroll
                for (int ai = 0; ai < 2; ++ai)
#pragma unroll
                    for (int m = 0; m < 4; ++m) {
                        float* dst = LOGF + (size_t)(row0 + ai * HALF + m * 16) * D + c;
                        f32x4 o0, o1;
#pragma unroll
                        for (int j = 0; j < 4; ++j) {
                            const float s0 = __builtin_amdgcn_rcpf(1.0f + __expf(-acc[ai][bj][m][0][j])), s1 = __builtin_amdgcn_rcpf(1.0f + __expf(-acc[ai][bj][m][1][j]));
                            o0[j] = __logf(lb[j] + (1.0f - lb[j]) * s0); o1[j] = __logf(lb[4 + j] + (1.0f - lb[4 + j]) * s1);
                        }
                        *(f32x4*)dst = o0; *(f32x4*)(dst + 4) = o1;
                    }
            }
        } else {
            bf16_t* base = Qs + (size_t)seg * ((size_t)M * D);
#pragma unroll
            for (int ai = 0; ai < 2; ++ai)
#pragma unroll
                for (int m = 0; m < 4; ++m)
#pragma unroll
                    for (int bj = 0; bj < 2; ++bj) {
                        f32x4 v0 = acc[ai][bj][m][0], v1 = acc[ai][bj][m][1];
                        if (seg != 2) {
#pragma unroll
                            for (int j = 0; j < 4; ++j) { v0[j] = silu_f(v0[j]); v1[j] = silu_f(v1[j]); }
                        }
                        u32x4 w; w.x = pk2(v0[0], v0[1]); w.y = pk2(v0[2], v0[3]); w.z = pk2(v1[0], v1[1]); w.w = pk2(v1[2], v1[3]);
                        *(u32x4*)(base + (size_t)(row0 + ai * HALF + m * 16) * D + col0 + bj * HALF) = w;
                    }
        }
    }
};
struct EpiF32 {
    static constexpr bool PERM = true, AFTER_DRAIN = false;
    bf16_t* Y; int ldc; float* slab; unsigned* cnt;
    __device__ __forceinline__ void operator()(const f32x4 (&acc)[2][2][4][2], const Unit& u, int wr, int wc, int fr, int fq) const {
        const int row0 = u.pm * BM + wr * 64 + fr, col0 = u.pn * BM + wc * 32 + 8 * fq;
        if (u.split < 0) {
#pragma unroll
            for (int ai = 0; ai < 2; ++ai)
#pragma unroll
                for (int m = 0; m < 4; ++m)
#pragma unroll
                    for (int bj = 0; bj < 2; ++bj) {
                        const f32x4 v0 = acc[ai][bj][m][0], v1 = acc[ai][bj][m][1];
                        u32x4 w4; w4.x = pk2(v0[0], v0[1]); w4.y = pk2(v0[2], v0[3]); w4.z = pk2(v1[0], v1[1]); w4.w = pk2(v1[2], v1[3]);
                        *(u32x4*)(Y + (size_t)(row0 + ai * HALF + m * 16) * ldc + col0 + bj * HALF) = w4;
                    }
            return;
        }
        const int tid = threadIdx.x;
        u32x4* mine = (u32x4*)((unsigned char*)slab + (size_t)(u.uid * 8 + u.split) * 131072) + tid;
#pragma unroll
        for (int ai = 0; ai < 2; ++ai)
#pragma unroll
            for (int m = 0; m < 4; ++m)
#pragma unroll
                for (int bj = 0; bj < 2; ++bj) { const f32x4 v0 = acc[ai][bj][m][0], v1 = acc[ai][bj][m][1];
                    u32x4 w4; w4.x = pk2(v0[0], v0[1]); w4.y = pk2(v0[2], v0[3]); w4.z = pk2(v1[0], v1[1]); w4.w = pk2(v1[2], v1[3]);
                    mine[((ai * 4 + m) * 2 + bj) * 512] = w4; }
        asm volatile("s_waitcnt vmcnt(0)" ::: "memory");
        __syncthreads();
        if (tid == 0) {
            unsigned* cw = cnt + 64 * u.uid;
            __builtin_amdgcn_fence(__ATOMIC_RELEASE, "agent");
            asm volatile("s_waitcnt vmcnt(0)" ::: "memory");
            __hip_atomic_fetch_add(cw, 1u, __ATOMIC_RELAXED, __HIP_MEMORY_SCOPE_AGENT);
            unsigned sp = 0;
            while (__hip_atomic_load(cw, __ATOMIC_RELAXED, __HIP_MEMORY_SCOPE_AGENT) < 8u) { __builtin_amdgcn_s_sleep(2); if (++sp > (1u << 22)) break; }
            __builtin_amdgcn_fence(__ATOMIC_ACQUIRE, "agent");
            asm volatile("s_waitcnt vmcnt(0)" ::: "memory");
        }
        __syncthreads();
        const int ai = u.split >> 2, m = u.split & 3;
        const u32x4* base = (const u32x4*)((const unsigned char*)slab + (size_t)(u.uid * 8) * 131072) + tid + (size_t)(u.split * 2) * 512;
        u32x4 pw[8][2];
#pragma unroll
        for (int sp = 0; sp < 8; ++sp)
#pragma unroll
            for (int bj = 0; bj < 2; ++bj) pw[sp][bj] = base[(size_t)sp * 8192 + bj * 512];
#pragma unroll
        for (int bj = 0; bj < 2; ++bj) {
            f32x4 v0 = (f32x4){0.f, 0.f, 0.f, 0.f}, v1 = v0;
#pragma unroll
            for (int sp = 0; sp < 8; ++sp) { const u32x4 q = pw[sp][bj];
                v0 += (f32x4){bf2f(q.x & 0xffffu), __uint_as_float(q.x & 0xffff0000u), bf2f(q.y & 0xffffu), __uint_as_float(q.y & 0xffff0000u)};
                v1 += (f32x4){bf2f(q.z & 0xffffu), __uint_as_float(q.z & 0xffff0000u), bf2f(q.w & 0xffffu), __uint_as_float(q.w & 0xffff0000u)}; }
            u32x4 w4; w4.x = pk2(v0[0], v0[1]); w4.y = pk2(v0[2], v0[3]); w4.z = pk2(v1[0], v1[1]); w4.w = pk2(v1[2], v1[3]);
            *(u32x4*)(Y + (size_t)(row0 + ai * HALF + m * 16) * ldc + col0 + bj * HALF) = w4;
        }
    }
};
struct EpiSwiGLU {
    static constexpr bool PERM = true, AFTER_DRAIN = false;
    bf16_t* Hact;
    __device__ __forceinline__ void operator()(const f32x4 (&acc)[2][2][4][2], const Unit& u, int wr, int wc, int fr, int fq) const {
        const int row0 = u.pm * BM + wr * 64 + fr, col0 = u.pn * HALF + wc * 32 + 8 * fq;
#pragma unroll
        for (int ai = 0; ai < 2; ++ai)
#pragma unroll
            for (int m = 0; m < 4; ++m) {
                f32x4 v0, v1;
#pragma unroll
                for (int j = 0; j < 4; ++j) { v0[j] = silu_f(acc[ai][0][m][0][j]) * acc[ai][1][m][0][j]; v1[j] = silu_f(acc[ai][0][m][1][j]) * acc[ai][1][m][1][j]; }
                u32x4 w; w.x = pk2(v0[0], v0[1]); w.y = pk2(v0[2], v0[3]); w.z = pk2(v1[0], v1[1]); w.w = pk2(v1[2], v1[3]);
                *(u32x4*)(Hact + (size_t)(row0 + ai * HALF + m * 16) * DFF + col0) = w;
            }
    }
};
template <int MODE> struct EpiRope {
    static constexpr bool PERM = true, AFTER_DRAIN = false;
    bf16_t* O0; bf16_t* O1; const f32x2* rope;
    float* kwin; float* vwin; float* knew; float* vnew;
    __device__ __forceinline__ void operator()(const f32x4 (&accin)[2][2][4][2], const Unit& u, int wr, int wc, int fr, int fq) const {
        const int row0 = u.pm * BM + wr * 64 + fr;
        const bool do_rope = (MODE == 0 || u.pn == 0) && ((wc & 1) == 0);
        const float scale = MODE == 0 ? 0.125f : 1.0f;
#pragma unroll
        for (int ai = 0; ai < 2; ++ai)
#pragma unroll
            for (int m = 0; m < 4; ++m) {
                const int row = row0 + ai * HALF + m * 16;
                f32x4 v[2][2];
#pragma unroll
                for (int bj = 0; bj < 2; ++bj) { v[bj][0] = accin[ai][bj][m][0]; v[bj][1] = accin[ai][bj][m][1]; }
                if (do_rope) {
                    const int idx = row < NPROMPT ? (row & (TP - 1)) : (TP + (row & 3));
                    const f32x4* rp = (const f32x4*)(rope + (size_t)idx * 8);
                    f32x4 cs[4];
#pragma unroll
                    for (int q = 0; q < 4; ++q) cs[q] = rp[q];
#pragma unroll
                    for (int bj = 0; bj < 2; ++bj)
#pragma unroll
                        for (int n = 0; n < 2; ++n)
#pragma unroll
                            for (int j = 0; j < 4; ++j) {
                                const int f = 4 * n + j;
                                const float c = cs[f >> 1][(f & 1) * 2], s = cs[f >> 1][(f & 1) * 2 + 1];
                                const float x = v[bj][n][j];
                                const float px = __shfl_xor(x, 16);
                                const float r = fq == 0 ? x * c - px * s : x * c + px * s;
                                v[bj][n][j] = fq < 2 ? r : x;
                            }
                }
#pragma unroll
                for (int bj = 0; bj < 2; ++bj) {
                    const f32x4 a = v[bj][0] * scale, b = v[bj][1] * scale;
                    u32x4 w; w.x = pk2(a[0], a[1]); w.y = pk2(a[2], a[3]); w.z = pk2(b[0], b[1]); w.w = pk2(b[2], b[3]);
                    const int ct = bj * HALF + wc * 32 + 8 * fq;
                    if (MODE == 0) {
                        *(u32x4*)(O0 + (size_t)row * D + u.pn * BM + ct) = w;
                    } else {
                        bf16_t* ob = u.pn == 0 ? O0 : O1;
                        *(u32x4*)(ob + (size_t)row * 256 + ct) = w;
                        float* fo = nullptr;
                        if (u.pm >= NPROMPT / BM) fo = (u.pn == 0 ? knew : vnew) + (size_t)(row - NPROMPT) * 256 + ct;
                        else if ((u.pm & 7) == 7 && ai == 1) fo = (u.pn == 0 ? kwin : vwin) + (size_t)((u.pm >> 3) * 128 + (row & 127)) * 256 + ct;
                        if (fo) { *(f32x4*)fo = a; *(f32x4*)(fo + 4) = b; }
                    }
                }
            }
    }
};

template <class Epi, class Sched, bool ALIGN_EPI = false, bool SP2 = false>
__device__ __forceinline__ void gemm_phase(LAS unsigned char* lds, const Gemm g, const Sched& S, const Epi& E) {
    const int tid = threadIdx.x, wid = __builtin_amdgcn_readfirstlane(tid >> 6), lane = tid & 63, wr = wid >> 2, wc = wid & 3, fr = lane & 15, fq = lane >> 4;
    const int K = g.K;
    unsigned voffA[2], voffB[2];
#pragma unroll
    for (int i = 0; i < 2; ++i) { int R, C; stage_rc(tid * 16 + i * 8192, R, C); const int Rb = Epi::PERM ? ((R & ~31) + perm32(R & 31)) : R;
        voffA[i] = (unsigned)(R * K + C) * 2u; voffB[i] = (unsigned)(Rb * K + C) * 2u; }
    const size_t kstep = (size_t)(BK * 2);
    const size_t hstep = (size_t)HALF * K * 2;
    const size_t tstep = 2 * hstep;
    const unsigned ldsw = (unsigned)wid * 1024u;
    const int aoff = lds_byte(wr * 64 + fr, fq * 8), boff = lds_byte(wc * 32 + fr, fq * 8);
#define PG8_SA(b, h) (((b) * 2 + (h)) * HTB)
#define PG8_SB(b, h) ((4 + (b) * 2 + (h)) * HTB)
#define PG8_STAGE(bufoff, gbase, voff) do { _Pragma("unroll") for (int _i = 0; _i < 2; ++_i) \
        __builtin_amdgcn_global_load_lds((const unsigned*)((const char*)(gbase) + (voff)[_i]), (LAS unsigned*)(lds + (bufoff) + ldsw + _i * 8192), 16, 0, 0); } while (0)
#define PG8_LDA(dst, b, h) do { _Pragma("unroll") for (int m = 0; m < 4; ++m) _Pragma("unroll") for (int k = 0; k < 2; ++k) dst[m][k] = *(const LAS bf16x8*)(lds + PG8_SA(b, h) + aoff + m * 2048 + k * 1024); } while (0)
#define PG8_LDB(dst, b, h) do { _Pragma("unroll") for (int n = 0; n < 2; ++n) _Pragma("unroll") for (int k = 0; k < 2; ++k) dst[n][k] = *(const LAS bf16x8*)(lds + PG8_SB(b, h) + boff + n * 2048 + k * 1024); } while (0)
#define PG8_MMA(ai, bj, At, Bt) do { __builtin_amdgcn_s_setprio(1); _Pragma("unroll") for (int m = 0; m < 4; ++m) _Pragma("unroll") for (int n = 0; n < 2; ++n) _Pragma("unroll") for (int k = 0; k < 2; ++k) \
        acc[ai][bj][m][n] = __builtin_amdgcn_mfma_f32_16x16x32_bf16(Bt[n][k], At[m][k], acc[ai][bj][m][n], 0, 0, 0); __builtin_amdgcn_s_setprio(0); } while (0)
#define PG8_WAIT_V(n) asm volatile("s_waitcnt vmcnt(" #n ")" ::: "memory")
#define PG8_WAIT_L(n) asm volatile("s_waitcnt lgkmcnt(" #n ")" ::: "memory")
#define PG8_BAR __builtin_amdgcn_s_barrier()
#define PG8_SCHED __builtin_amdgcn_sched_barrier(0)
    Unit cur, nxt; int ui = 0;
    if (!S.next(0, cur)) return;
    f32x4 acc[2][2][4][2];
#pragma unroll
    for (int a = 0; a < 2; ++a)
#pragma unroll
        for (int b = 0; b < 2; ++b)
#pragma unroll
            for (int m = 0; m < 4; ++m)
#pragma unroll
                for (int n = 0; n < 2; ++n) acc[a][b][m][n] = (f32x4){0.f, 0.f, 0.f, 0.f};
    bf16x8 At[4][2], B0[2][2], B1[2][2];
    const char* cA = (const char*)g.A + (size_t)cur.pm * tstep + (size_t)cur.kt0 * kstep; const char* cB = (const char*)g.Bt + (size_t)cur.pn * tstep + (size_t)cur.kt0 * kstep;
    S.a_ready(cur);
    if constexpr (SP2) {
        PG8_STAGE(PG8_SB(0, 0), cB, voffB); PG8_STAGE(PG8_SB(0, 1), cB + hstep, voffB); PG8_STAGE(PG8_SA(0, 0), cA, voffA); PG8_STAGE(PG8_SA(0, 1), cA + hstep, voffA);
        if (wr == 1) PG8_BAR;
        PG8_WAIT_V(2); PG8_BAR;
        PG8_STAGE(PG8_SB(1, 0), cB + kstep, voffB); PG8_STAGE(PG8_SA(1, 0), cA + kstep, voffA); PG8_STAGE(PG8_SB(1, 1), cB + hstep + kstep, voffB);
        PG8_WAIT_V(6); PG8_BAR;
    } else {
        PG8_STAGE(PG8_SB(0, 0), cB, voffB); PG8_STAGE(PG8_SA(0, 0), cA, voffA); PG8_STAGE(PG8_SB(0, 1), cB + hstep, voffB); PG8_STAGE(PG8_SA(0, 1), cA + hstep, voffA);
        if (wr == 1) PG8_BAR;
        PG8_WAIT_V(4); PG8_BAR;
        PG8_STAGE(PG8_SB(1, 0), cB + kstep, voffB); PG8_STAGE(PG8_SA(1, 0), cA + kstep, voffA); PG8_STAGE(PG8_SB(1, 1), cB + hstep + kstep, voffB);
        PG8_WAIT_V(6); PG8_BAR;
    }
    for (;;) {
        const bool has_next = S.next(ui + 1, nxt);
        const char* nA = has_next ? (const char*)g.A + (size_t)nxt.pm * tstep + (size_t)nxt.kt0 * kstep : cA; const char* nB = has_next ? (const char*)g.Bt + (size_t)nxt.pn * tstep + (size_t)nxt.kt0 * kstep : cB;
        const int nt = cur.nt;
        for (int t = 0; t < nt; t += 2) {
            const bool last = (t == nt - 2);
            const char* a1 = cA + (size_t)(t + 1) * kstep;
            const char* a2 = last ? nA : cA + (size_t)(t + 2) * kstep; const char* b2 = last ? nB : cB + (size_t)(t + 2) * kstep;
            const char* a3 = a2 + kstep; const char* b3 = b2 + kstep;
            if (last && has_next) S.a_ready(nxt);
            if constexpr (SP2) {
            PG8_LDB(B0, 0, 0); PG8_LDB(B1, 0, 1); PG8_SCHED; PG8_LDA(At, 0, 0); PG8_STAGE(PG8_SA(1, 1), a1 + hstep, voffA);
            PG8_WAIT_V(8); PG8_WAIT_L(0); PG8_BAR; PG8_MMA(0, 0, At, B0); PG8_MMA(0, 1, At, B1); PG8_BAR; PG8_SCHED;
            PG8_LDA(At, 0, 1); PG8_STAGE(PG8_SB(0, 0), b2, voffB); PG8_STAGE(PG8_SB(0, 1), b2 + hstep, voffB); PG8_STAGE(PG8_SA(0, 0), a2, voffA);
            PG8_WAIT_V(8); PG8_WAIT_L(0); PG8_BAR; PG8_MMA(1, 0, At, B0); PG8_MMA(1, 1, At, B1); PG8_BAR; PG8_SCHED;
            PG8_LDB(B0, 1, 0); PG8_LDB(B1, 1, 1); PG8_SCHED; PG8_LDA(At, 1, 0); PG8_STAGE(PG8_SA(0, 1), a2 + hstep, voffA);
            PG8_WAIT_V(8); PG8_WAIT_L(0); PG8_BAR; PG8_MMA(0, 0, At, B0); PG8_MMA(0, 1, At, B1); PG8_BAR; PG8_SCHED;
            PG8_LDA(At, 1, 1); PG8_STAGE(PG8_SB(1, 0), b3, voffB); PG8_STAGE(PG8_SB(1, 1), b3 + hstep, voffB); PG8_STAGE(PG8_SA(1, 0), a3, voffA);
            PG8_WAIT_V(8); PG8_WAIT_L(0); PG8_BAR; PG8_MMA(1, 0, At, B0); PG8_MMA(1, 1, At, B1); PG8_BAR; PG8_SCHED;
            } else {
            PG8_LDB(B0, 0, 0); PG8_SCHED; PG8_LDA(At, 0, 0); PG8_STAGE(PG8_SA(1, 1), a1 + hstep, voffA);
            PG8_WAIT_L(8); PG8_BAR; PG8_WAIT_L(0); PG8_MMA(0, 0, At, B0); PG8_BAR; PG8_SCHED;
            PG8_LDB(B1, 0, 1); PG8_STAGE(PG8_SB(0, 0), b2, voffB);
            PG8_BAR; PG8_WAIT_L(0); PG8_MMA(0, 1, At, B1); PG8_BAR;
            PG8_LDA(At, 0, 1); PG8_STAGE(PG8_SA(0, 0), a2, voffA);
            PG8_BAR; PG8_WAIT_L(0); PG8_MMA(1, 0, At, B0); PG8_BAR; PG8_SCHED;
            PG8_STAGE(PG8_SB(0, 1), b2 + hstep, voffB);
            PG8_WAIT_V(6); PG8_BAR; PG8_MMA(1, 1, At, B1); PG8_BAR;
            PG8_LDB(B0, 1, 0); PG8_SCHED; PG8_LDA(At, 1, 0); PG8_STAGE(PG8_SA(0, 1), a2 + hstep, voffA);
            PG8_WAIT_L(8); PG8_BAR; PG8_WAIT_L(0); PG8_MMA(0, 0, At, B0); PG8_BAR; PG8_SCHED;
            PG8_LDB(B1, 1, 1); PG8_STAGE(PG8_SB(1, 0), b3, voffB);
            PG8_BAR; PG8_WAIT_L(0); PG8_MMA(0, 1, At, B1); PG8_BAR;
            PG8_LDA(At, 1, 1); PG8_STAGE(PG8_SA(1, 0), a3, voffA);
            PG8_BAR; PG8_WAIT_L(0); PG8_MMA(1, 0, At, B0); PG8_BAR; PG8_SCHED;
            PG8_STAGE(PG8_SB(1, 1), b3 + hstep, voffB);
            PG8_WAIT_V(6); PG8_BAR; PG8_MMA(1, 1, At, B1); PG8_BAR;
            }
        }
        if constexpr (ALIGN_EPI) { if (wr == 0) PG8_BAR; }
        if constexpr (!Epi::AFTER_DRAIN) { E(acc, cur, wr, wc, fr, fq); S.done(cur); }
        if (!has_next) break;
#pragma unroll
        for (int a = 0; a < 2; ++a)
#pragma unroll
            for (int b = 0; b < 2; ++b)
#pragma unroll
                for (int m = 0; m < 4; ++m)
#pragma unroll
                    for (int n = 0; n < 2; ++n) acc[a][b][m][n] = (f32x4){0.f, 0.f, 0.f, 0.f};
        cur = nxt; cA = nA; cB = nB; ++ui;
        if constexpr (ALIGN_EPI) { if (wr == 1) PG8_BAR; }
    }
    PG8_WAIT_V(0);
    if constexpr (!ALIGN_EPI) { if (wr == 0) PG8_BAR; }
    PG8_BAR;
#undef PG8_SA
#undef PG8_SB
#undef PG8_STAGE
#undef PG8_LDA
#undef PG8_LDB
#undef PG8_MMA
#undef PG8_WAIT_V
#undef PG8_WAIT_L
#undef PG8_BAR
#undef PG8_SCHED
}
}

constexpr size_t MiB = 1u << 20;
constexpr size_t WS_WIN = 1 * MiB, WS_WOUT = 33 * MiB, WS_WKV = 41 * MiB, WS_WQ = 43 * MiB, WS_WAO = 51 * MiB, WS_WGU0 = 59 * MiB, WS_WGU1 = 103 * MiB,
                 WS_WD0 = 147 * MiB, WS_WD1 = 169 * MiB, WS_ROPE = 191 * MiB, WS_XN = 192 * MiB, WS_Y = 226 * MiB, WS_O2 = 294 * MiB, WS_R1 = 328 * MiB;
constexpr size_t WS_GQT = 192 * MiB, WS_GKH = 224 * MiB, WS_GVT = 256 * MiB;
constexpr size_t WS_GPS = WS_R1 + 34 * MiB, WS_GDEC = WS_R1 + 42 * MiB;
constexpr size_t WS_QS = WS_R1, WS_VB = WS_R1 + 68 * MiB, WS_SG = WS_R1 + 102 * MiB, WS_LOGF = WS_R1 + 136 * MiB;
constexpr size_t WS_HACT = WS_R1;
constexpr size_t WS_XKV = WS_R1, WS_QR = WS_R1 + 34 * MiB, WS_KB = WS_R1 + 68 * MiB, WS_VKV = WS_R1 + 73 * MiB;
constexpr size_t WS_SLAB = WS_R1 + 204 * MiB;
constexpr size_t WS_END = WS_SLAB + 32 * MiB;
constexpr size_t WS_HB = WS_LOGF;
constexpr size_t WS_CNT = 65536;
constexpr size_t OUT_Y = 0, OUT_SP = (size_t)M * D, OUT_SS = OUT_SP + 4 * 16 * 16384, OUT_KWIN = OUT_SS + (size_t)128 * 16 * 16384, OUT_VWIN = OUT_KWIN + 131072,
                 OUT_KNEW = OUT_VWIN + 131072, OUT_VNEW = OUT_KNEW + 131072, OUT_END = OUT_VNEW + 131072;

constexpr int LDS_BYTES = 147456;
constexpr int NWAVES = 8;

template <bool GU> __device__ __forceinline__ void p0_transpose_item(const float* W, int K, int N, bf16_t* WT, LAS float* scr, int item, int lane) {
    const int nblk = N / 32, kb = item / nblk, nb = item % nblk, k0 = 64 * kb, n0 = 32 * nb;
    f32x4 wv[8];
#pragma unroll
    for (int i = 0; i < 8; ++i) wv[i] = *(const f32x4*)(W + (size_t)(k0 + 8 * i + (lane >> 3)) * N + n0 + 4 * (lane & 7));
#pragma unroll
    for (int i = 0; i < 8; ++i) { LAS float* d = scr + (8 * i + (lane >> 3)) * 33 + 4 * (lane & 7); d[0] = wv[i][0]; d[1] = wv[i][1]; d[2] = wv[i][2]; d[3] = wv[i][3]; }
    asm volatile("s_waitcnt lgkmcnt(0)" ::: "memory");
    int r0 = n0;
    if (GU) { const int half = n0 >= DFF ? 1 : 0, rem = n0 - half * DFF; r0 = (rem >> 7) * 256 + half * 128 + (rem & 127); }
    const int c = lane & 7;
#pragma unroll
    for (int j = 0; j < 4; ++j) { const int n = (lane >> 3) + 8 * j; const LAS float* s = scr + (8 * c) * 33 + n;
        u32x4 o; o.x = pk2(s[0 * 33], s[1 * 33]); o.y = pk2(s[2 * 33], s[3 * 33]); o.z = pk2(s[4 * 33], s[5 * 33]); o.w = pk2(s[6 * 33], s[7 * 33]);
        *(u32x4*)(WT + (size_t)(r0 + n) * K + k0 + 8 * c) = o; }
    asm volatile("s_waitcnt lgkmcnt(0)" ::: "memory");
}

template <bool GU> __device__ __forceinline__ void cvt_stream(const float* W, int K, int N, bf16_t* WT, LAS float* scr, int first, int stride, int nitems, int lane) {
    if (first >= nitems) return;
    const int nblk = N / 32, lr = lane >> 3, lc = 4 * (lane & 7);
    f32x4 wv[8];
    { const int k0 = 64 * (first / nblk), n0 = 32 * (first % nblk);
#pragma unroll
      for (int i = 0; i < 8; ++i) wv[i] = *(const f32x4*)(W + (size_t)(k0 + 8 * i + lr) * N + n0 + lc); }
    for (int it = first; it < nitems; it += stride) {
        const int k0 = 64 * (it / nblk), n0 = 32 * (it % nblk);
#pragma unroll
        for (int i = 0; i < 8; ++i) { LAS float* d = scr + (8 * i + lr) * 33 + lc; d[0] = wv[i][0]; d[1] = wv[i][1]; d[2] = wv[i][2]; d[3] = wv[i][3]; }
        const int itn = it + stride;
        if (itn < nitems) { const int k1 = 64 * (itn / nblk), n1 = 32 * (itn % nblk);
#pragma unroll
            for (int i = 0; i < 8; ++i) wv[i] = *(const f32x4*)(W + (size_t)(k1 + 8 * i + lr) * N + n1 + lc); }
        asm volatile("s_waitcnt lgkmcnt(0)" ::: "memory");
        int r0 = n0;
        if (GU) { const int half = n0 >= DFF ? 1 : 0, rem = n0 - half * DFF; r0 = (rem >> 7) * 256 + half * 128 + (rem & 127); }
        const int c = lane & 7;
#pragma unroll
        for (int j = 0; j < 4; ++j) { const int n = (lane >> 3) + 8 * j; const LAS float* sp = scr + (8 * c) * 33 + n;
            u32x4 o; o.x = pk2(sp[0 * 33], sp[1 * 33]); o.y = pk2(sp[2 * 33], sp[3 * 33]); o.z = pk2(sp[4 * 33], sp[5 * 33]); o.w = pk2(sp[6 * 33], sp[7 * 33]);
            *(u32x4*)(WT + (size_t)(r0 + n) * K + k0 + 8 * c) = o; }
        asm volatile("s_waitcnt lgkmcnt(0)" ::: "memory");
    }
}

template <bool HASY, bool HASA, bool HASB, bool HIN16 = false, bool HOUT16 = false>
__device__ __forceinline__ void row_pass(const void* hin, const bf16_t* Yrow, const float* gpost, void* hout, const float* gA, bf16_t* outA, const float* gB, bf16_t* outB, int lane) {
    f32x4 h[8], gp[8], ga[8], gb[8]; u32x2 yw[8];
    if (HIN16) { const u32x2* hr = (const u32x2*)hin + lane;
#pragma unroll
        for (int j = 0; j < 8; ++j) { const u32x2 hw = hr[64 * j]; h[j] = (f32x4){bf2f(hw.x & 0xffffu), __uint_as_float(hw.x & 0xffff0000u), bf2f(hw.y & 0xffffu), __uint_as_float(hw.y & 0xffff0000u)}; }
    } else { const f32x4* hr = (const f32x4*)hin + lane;
#pragma unroll
        for (int j = 0; j < 8; ++j) h[j] = hr[64 * j];
    }
    if (HASY) {
#pragma unroll
        for (int j = 0; j < 8; ++j) { yw[j] = ((const u32x2*)Yrow + lane)[64 * j]; gp[j] = ((const f32x4*)gpost + lane)[64 * j]; }
    }
    if (HASA) {
#pragma unroll
        for (int j = 0; j < 8; ++j) ga[j] = ((const f32x4*)gA + lane)[64 * j];
    }
    if (HASB) {
#pragma unroll
        for (int j = 0; j < 8; ++j) gb[j] = ((const f32x4*)gB + lane)[64 * j];
    }
    if (HASY) {
        f32x4 y[8]; float ss = 0.f;
#pragma unroll
        for (int j = 0; j < 8; ++j) { y[j] = (f32x4){bf2f(yw[j].x & 0xffffu), __uint_as_float(yw[j].x & 0xffff0000u), bf2f(yw[j].y & 0xffffu), __uint_as_float(yw[j].y & 0xffff0000u)}; ss += (y[j].x * y[j].x + y[j].y * y[j].y) + (y[j].z * y[j].z + y[j].w * y[j].w); }
        const float rstd = rsqrtf(wave_sum(ss) * (1.0f / D) + EPS);
#pragma unroll
        for (int j = 0; j < 8; ++j) { h[j] = h[j] + y[j] * rstd * gp[j];
            if (HOUT16) { u32x2 w; w.x = pk2(h[j].x, h[j].y); w.y = pk2(h[j].z, h[j].w); ((u32x2*)hout + lane)[64 * j] = w; } else ((f32x4*)hout + lane)[64 * j] = h[j]; }
    }
    if (HASA || HASB) {
        float ss = 0.f;
#pragma unroll
        for (int j = 0; j < 8; ++j) ss += (h[j].x * h[j].x + h[j].y * h[j].y) + (h[j].z * h[j].z + h[j].w * h[j].w);
        const float rstd = rsqrtf(wave_sum(ss) * (1.0f / D) + EPS);
        if (HASA) { u32x2* oa = (u32x2*)outA + lane;
#pragma unroll
            for (int j = 0; j < 8; ++j) { const f32x4 v = h[j] * rstd * ga[j]; u32x2 w; w.x = pk2(v.x, v.y); w.y = pk2(v.z, v.w); oa[64 * j] = w; } }
        if (HASB) { u32x2* ob = (u32x2*)outB + lane;
#pragma unroll
            for (int j = 0; j < 8; ++j) { const f32x4 v = h[j] * rstd * gb[j]; u32x2 w; w.x = pk2(v.x, v.y); w.y = pk2(v.z, v.w); ob[64 * j] = w; } }
    }
}

#define LDS_BARRIER() do { asm volatile("s_waitcnt lgkmcnt(0)" ::: "memory"); __builtin_amdgcn_s_barrier(); asm volatile("" ::: "memory"); } while (0)
namespace gla {
constexpr int QT_OFF = 0, TOK_STRIDE = 272;
constexpr int KT_OFF = 64 * 272;
constexpr int KH_OFF = 2 * 64 * 272, CH_STRIDE = 144;
constexpr int VT_OFF = KH_OFF + 128 * 144;
constexpr int DEC_OFF = VT_OFF + 128 * 144;
constexpr int OS_OFF = DEC_OFF + 1024, OS_STRIDE = 528;
constexpr int END = OS_OFF + 64 * 528;
static_assert(END <= 131072, "gla lds");
struct P { const bf16_t* Qs; const float* LOGF; const bf16_t* Vb; const bf16_t* SG; const float* gnorm; bf16_t* O2;
           unsigned char* G_QT; unsigned char* G_KH; unsigned char* G_VT; unsigned char* G_PS; unsigned char* G_DEC; };

__device__ __forceinline__ bf16x8 mk8(u32x2 lo, u32x2 hi) { u32x4 t; t.x = lo.x; t.y = lo.y; t.z = hi.x; t.w = hi.y; return __builtin_bit_cast(bf16x8, t); }
__device__ __forceinline__ bf16x8 pk8(f32x4 a, f32x4 b) { u32x4 t; t.x = pk2(a[0], a[1]); t.y = pk2(a[2], a[3]); t.z = pk2(b[0], b[1]); t.w = pk2(b[2], b[3]); return __builtin_bit_cast(bf16x8, t); }

__device__ __forceinline__ void intra_items(LAS unsigned char* lds, const P& p, int first, int stride, int nitems) {
    const int tid = threadIdx.x, lane = tid & 63, w = __builtin_amdgcn_readfirstlane(tid >> 6), l16 = lane & 15, g = lane >> 4;
    const int pk = tid & 127, grp = tid >> 7, pc = grp >> 1, hf = grp & 1;
    float lfo[16]; unsigned qv[16], vv[16];
#define GLA_LOAD_RAW(id) do { const int bh_ = (id) >> 5; const size_t R_ = (size_t)(bh_ >> 4) * TP + (size_t)((id) & 31) * 64; const int hc_ = (bh_ & 15) * 128; \
        _Pragma("unroll") for (int i = 0; i < 16; ++i) { const int tok = 16 * grp + i; lfo[i] = p.LOGF[(R_ + tok) * D + hc_ + pk]; \
            qv[i] = (unsigned)p.Qs[(R_ + tok) * D + hc_ + pk]; vv[i] = (unsigned)p.Vb[(R_ + tok) * D + hc_ + pk]; } } while (0)
    if (first < nitems) GLA_LOAD_RAW(first);
    for (int id = first; id < nitems; id += stride) {
        {
            float so = 0.f;
#pragma unroll
            for (int i = 0; i < 16; ++i) so += lfo[i];
            *(LAS float*)(lds + OS_OFF + tid * 4) = so;
            LDS_BARRIER();
            const float sx = *(const LAS float*)(lds + OS_OFF + (tid ^ 128) * 4);
            const float tot = so + sx;
            float b = hf ? sx : 0.f;
            unsigned khp[8], vtp[8]; float khprev = 0.f;
#pragma unroll
            for (int i = 0; i < 16; ++i) {
                const float l = lfo[i];
                b += l;
                const float kk = 1.0f - __expf(l);
                const float bc = fmaxf(b, -80.f);
                const float qq = bf2f(qv[i]) * __expf(bc);
                const float kt = kk * __expf(-bc);
                const float kh = kk * __expf(tot - b);
                const int t = 16 * grp + i;
                *(LAS bf16_t*)(lds + QT_OFF + t * TOK_STRIDE + pk * 2) = (bf16_t)(pk2(qq, 0.f) & 0xffffu);
                *(LAS bf16_t*)(lds + KT_OFF + t * TOK_STRIDE + pk * 2) = (bf16_t)(pk2(kt, 0.f) & 0xffffu);
                if (i & 1) { khp[i >> 1] = pk2(khprev, kh); vtp[i >> 1] = vv[i - 1] | (vv[i] << 16); } else khprev = kh;
            }
            LAS u32x4* khd = (LAS u32x4*)(lds + KH_OFF + pk * CH_STRIDE + grp * 32); LAS u32x4* vtd = (LAS u32x4*)(lds + VT_OFF + pk * CH_STRIDE + grp * 32);
            khd[0] = (u32x4){khp[0], khp[1], khp[2], khp[3]}; khd[1] = (u32x4){khp[4], khp[5], khp[6], khp[7]};
            vtd[0] = (u32x4){vtp[0], vtp[1], vtp[2], vtp[3]}; vtd[1] = (u32x4){vtp[4], vtp[5], vtp[6], vtp[7]};
            if (hf == 0) *(LAS float*)(lds + DEC_OFF + pc * 512 + pk * 4) = __expf(tot);
        }
        LDS_BARRIER();
        if (id + stride < nitems) GLA_LOAD_RAW(id + stride);
        {
            const int c = w >> 2, st = (w >> 1) & 1, tt = w & 1, tb = 32 * c;
            f32x4 a4 = (f32x4){0.f, 0.f, 0.f, 0.f};
#pragma unroll
            for (int ks = 0; ks < 4; ++ks) {
                const bf16x8 a = *(const LAS bf16x8*)(lds + KT_OFF + (tb + 16 * st + l16) * TOK_STRIDE + (32 * ks + 8 * g) * 2);
                const bf16x8 bq = *(const LAS bf16x8*)(lds + QT_OFF + (tb + 16 * tt + l16) * TOK_STRIDE + (32 * ks + 8 * g) * 2);
                a4 = __builtin_amdgcn_mfma_f32_16x16x32_bf16(a, bq, a4, 0, 0, 0);
            }
#pragma unroll
            for (int j = 0; j < 4; ++j) { const int s_ = 16 * st + 4 * g + j, t_ = 16 * tt + l16; a4[j] = s_ <= t_ ? a4[j] : 0.f; }
            u32x2 pw; pw.x = pk2(a4[0], a4[1]); pw.y = pk2(a4[2], a4[3]);
            *(u32x2*)(p.G_PS + (size_t)id * 4096 + w * 512 + lane * 8) = pw;
        }
#pragma unroll
        for (int i = 0; i < 2; ++i) { const int pi = tid + 512 * i;
            *(u32x4*)(p.G_QT + (size_t)id * 16384 + pi * 16) = *(const LAS u32x4*)(lds + QT_OFF + (pi >> 4) * TOK_STRIDE + (pi & 15) * 16);
            *(u32x4*)(p.G_KH + (size_t)id * 16384 + pi * 16) = *(const LAS u32x4*)(lds + KH_OFF + (pi >> 3) * CH_STRIDE + (pi & 7) * 16);
            *(u32x4*)(p.G_VT + (size_t)id * 16384 + pi * 16) = *(const LAS u32x4*)(lds + VT_OFF + (pi >> 3) * CH_STRIDE + (pi & 7) * 16); }
        if (tid < 64) *(u32x4*)(p.G_DEC + (size_t)id * 1024 + tid * 16) = *(const LAS u32x4*)(lds + DEC_OFF + tid * 16);
        LDS_BARRIER();
    }
#undef GLA_LOAD_RAW
}

__device__ __forceinline__ void scan_seq(LAS unsigned char* lds, const P& p, int bh, float* Sout, int nsc) {
    const int tid = threadIdx.x, lane = tid & 63, w = __builtin_amdgcn_readfirstlane(tid >> 6), l16 = lane & 15, g = lane >> 4;
    const int pt = tid >> 3, pp = tid & 7;
    const int hc = (bh & 15) * 128; const size_t row0 = (size_t)(bh >> 4) * TP;
    if (tid < 128) *(LAS float*)(lds + END + tid * 4) = p.gnorm[hc + tid];
    f32x4 S[8];
#pragma unroll
    for (int i = 0; i < 8; ++i) S[i] = (f32x4){0.f, 0.f, 0.f, 0.f};
    u32x4 rq[2], rk[2], rv[2], rd, rp;
    u32x4 sg0, sg1, sg0n = (u32x4){0u, 0u, 0u, 0u}, sg1n = sg0n;
#define SCAN_LOAD(sc) do { const size_t id_ = (size_t)bh * 32 + ((sc) & 31); \
        _Pragma("unroll") for (int i = 0; i < 2; ++i) { const int pi = tid + 512 * i; rq[i] = *(const u32x4*)(p.G_QT + id_ * 16384 + pi * 16); rk[i] = *(const u32x4*)(p.G_KH + id_ * 16384 + pi * 16); rv[i] = *(const u32x4*)(p.G_VT + id_ * 16384 + pi * 16); } \
        rd = *(const u32x4*)(p.G_DEC + id_ * 1024 + (tid & 63) * 16); rp = *(const u32x4*)(p.G_PS + id_ * 4096 + (tid & 255) * 16); } while (0)
    { const u32x4* sgp = (const u32x4*)(p.SG + (row0 + pt) * D + hc + 16 * pp); sg0 = sgp[0]; sg1 = sgp[1]; }
    SCAN_LOAD(0);
    for (int scx = 0; scx < nsc; ++scx) {
        const int sc = scx & 31;
        const size_t R = row0 + (size_t)sc * 64;
#pragma unroll
        for (int i = 0; i < 2; ++i) { const int pi = tid + 512 * i;
            *(LAS u32x4*)(lds + QT_OFF + (pi >> 4) * TOK_STRIDE + (pi & 15) * 16) = rq[i];
            *(LAS u32x4*)(lds + KH_OFF + (pi >> 3) * CH_STRIDE + (pi & 7) * 16) = rk[i];
            *(LAS u32x4*)(lds + VT_OFF + (pi >> 3) * CH_STRIDE + (pi & 7) * 16) = rv[i]; }
        if (tid < 64) *(LAS u32x4*)(lds + DEC_OFF + tid * 16) = rd;
        if (tid < 256) *(LAS u32x4*)(lds + KT_OFF + tid * 16) = rp;
        LDS_BARRIER();
        if (scx + 1 < nsc) { const u32x4* sgp = (const u32x4*)(p.SG + (row0 + (size_t)((scx + 1) & 31) * 64 + pt) * D + hc + 16 * pp); sg0n = sgp[0]; sg1n = sgp[1]; SCAN_LOAD(scx + 1); }
#pragma unroll
        for (int c = 0; c < 2; ++c) {
            const int tb = 32 * c;
            const LAS unsigned char* vrow = lds + VT_OFF + (16 * w + l16) * CH_STRIDE + (tb + 4 * g) * 2;
            const bf16x8 vfrag = mk8(*(const LAS u32x2*)vrow, *(const LAS u32x2*)(vrow + 32));
            bf16x8 pf[2], bq[2][4], ka[8]; f32x4 d4[8];
#pragma unroll
            for (int tt = 0; tt < 2; ++tt) {
                pf[tt] = mk8(*(const LAS u32x2*)(lds + KT_OFF + ((c * 4 + tt) * 64 + lane) * 8), *(const LAS u32x2*)(lds + KT_OFF + ((c * 4 + 2 + tt) * 64 + lane) * 8));
#pragma unroll
                for (int j2 = 0; j2 < 4; ++j2) { const LAS unsigned char* qrow = lds + QT_OFF + (tb + 16 * tt + l16) * TOK_STRIDE + (32 * j2 + 4 * g) * 2;
                    bq[tt][j2] = mk8(*(const LAS u32x2*)qrow, *(const LAS u32x2*)(qrow + 32)); }
            }
#pragma unroll
            for (int i = 0; i < 8; ++i) { d4[i] = *(const LAS f32x4*)(lds + DEC_OFF + c * 512 + (16 * i + 4 * g) * 4);
                const LAS unsigned char* krow = lds + KH_OFF + (16 * i + l16) * CH_STRIDE + (tb + 4 * g) * 2; ka[i] = mk8(*(const LAS u32x2*)krow, *(const LAS u32x2*)(krow + 32)); }
            bf16x8 sa[4];
#pragma unroll
            for (int j2 = 0; j2 < 4; ++j2) sa[j2] = pk8(S[2 * j2], S[2 * j2 + 1]);
            const f32x4 z4 = (f32x4){0.f, 0.f, 0.f, 0.f};
            f32x4 oa0 = __builtin_amdgcn_mfma_f32_16x16x32_bf16(vfrag, pf[0], z4, 0, 0, 0);
            f32x4 oa1 = __builtin_amdgcn_mfma_f32_16x16x32_bf16(vfrag, pf[1], z4, 0, 0, 0);
            f32x4 ob0 = __builtin_amdgcn_mfma_f32_16x16x32_bf16(sa[1], bq[0][1], z4, 0, 0, 0);
            f32x4 ob1 = __builtin_amdgcn_mfma_f32_16x16x32_bf16(sa[1], bq[1][1], z4, 0, 0, 0);
            oa0 = __builtin_amdgcn_mfma_f32_16x16x32_bf16(sa[0], bq[0][0], oa0, 0, 0, 0);
            oa1 = __builtin_amdgcn_mfma_f32_16x16x32_bf16(sa[0], bq[1][0], oa1, 0, 0, 0);
            ob0 = __builtin_amdgcn_mfma_f32_16x16x32_bf16(sa[3], bq[0][3], ob0, 0, 0, 0);
            ob1 = __builtin_amdgcn_mfma_f32_16x16x32_bf16(sa[3], bq[1][3], ob1, 0, 0, 0);
            oa0 = __builtin_amdgcn_mfma_f32_16x16x32_bf16(sa[2], bq[0][2], oa0, 0, 0, 0);
            oa1 = __builtin_amdgcn_mfma_f32_16x16x32_bf16(sa[2], bq[1][2], oa1, 0, 0, 0);
#pragma unroll
            for (int i = 0; i < 8; ++i) S[i] = __builtin_amdgcn_mfma_f32_16x16x32_bf16(ka[i], vfrag, S[i] * d4[i], 0, 0, 0);
            *(LAS f32x4*)(lds + OS_OFF + (tb + l16) * OS_STRIDE + (16 * w + 4 * g) * 4) = oa0 + ob0;
            *(LAS f32x4*)(lds + OS_OFF + (tb + 16 + l16) * OS_STRIDE + (16 * w + 4 * g) * 4) = oa1 + ob1;
        }
        LDS_BARRIER();
        {
            const LAS f32x4* op = (const LAS f32x4*)(lds + OS_OFF + pt * OS_STRIDE + pp * 64);
            f32x4 o[4]; float ss = 0.f;
#pragma unroll
            for (int q = 0; q < 4; ++q) { o[q] = op[q]; ss += (o[q].x * o[q].x + o[q].y * o[q].y) + (o[q].z * o[q].z + o[q].w * o[q].w); }
            ss += __shfl_xor(ss, 1); ss += __shfl_xor(ss, 2); ss += __shfl_xor(ss, 4);
            const float rstd = rsqrtf(ss * (1.0f / 128.0f) + EPS);
            const unsigned sgw[8] = {sg0.x, sg0.y, sg0.z, sg0.w, sg1.x, sg1.y, sg1.z, sg1.w};
            unsigned ow[8];
#pragma unroll
            for (int q = 0; q < 4; ++q) {
                const f32x4 v = o[q] * rstd * *(const LAS f32x4*)(lds + END + (16 * pp + 4 * q) * 4);
                ow[2 * q] = pk2(v.x * bf2f(sgw[2 * q] & 0xffffu), v.y * bf2f(sgw[2 * q] >> 16));
                ow[2 * q + 1] = pk2(v.z * bf2f(sgw[2 * q + 1] & 0xffffu), v.w * bf2f(sgw[2 * q + 1] >> 16));
            }
            u32x4* od = (u32x4*)(p.O2 + (R + pt) * D + hc + 16 * pp);
            od[0] = (u32x4){ow[0], ow[1], ow[2], ow[3]}; od[1] = (u32x4){ow[4], ow[5], ow[6], ow[7]};
        }
        sg0 = sg0n; sg1 = sg1n;
    }
#undef SCAN_LOAD
#pragma unroll
    for (int i = 0; i < 8; ++i)
#pragma unroll
        for (int j = 0; j < 4; ++j) Sout[(size_t)(16 * i + 4 * g + j) * 128 + 16 * w + l16] = S[i][j];
}

constexpr int DF_OFF = 0, DK_OFF = 2048, DQ_OFF = 4096, DV_OFF = 6144, DR_OFF = 8192, DW_OFF = 16384;
__device__ __forceinline__ void decode_items(LAS unsigned char* lds, const P& p, const float* state_in, float* state_out, int first, int stride, int nitems) {
    const int tid = threadIdx.x, lane = tid & 63, w = __builtin_amdgcn_readfirstlane(tid >> 6);
    const int v = tid & 127, kg = tid >> 7;
    float sA[32], sB[32];
    float lA = 0.f, gA = 0.f, lB = 0.f, gB = 0.f; unsigned qA = 0u, vA = 0u, sgA = 0u, qB = 0u, vB = 0u, sgB = 0u;
#define DEC_PREFETCH(itn_, s, c_l, c_q, c_v, c_sg, c_gn) do { const int itn = (itn_) & (BS * 16 - 1); \
        _Pragma("unroll") for (int q = 0; q < 4; ++q) { const float* sp = state_in + (size_t)itn * 16384 + (size_t)(32 * kg + 8 * q) * 128 + v; \
            _Pragma("unroll") for (int i = 0; i < 8; ++i) s[8 * q + i] = sp[i * 128]; } \
        const int hc_ = (itn & 15) * 128; const size_t off_ = ((size_t)NPROMPT + 4 * (itn >> 4) + kg) * D + hc_ + v; \
        c_l = p.LOGF[off_]; c_q = (unsigned)p.Qs[off_]; c_v = (unsigned)p.Vb[off_]; c_sg = (unsigned)p.SG[off_]; c_gn = p.gnorm[hc_ + v]; } while (0)
#define DEC_BODY(itx_, s, c_l, c_q, c_v, c_sg, c_gn) do { const int it = (itx_) & (BS * 16 - 1); \
        const size_t off = ((size_t)NPROMPT + 4 * (it >> 4) + kg) * D + (it & 15) * 128 + v; \
        const float gate = c_gn * bf2f(c_sg); \
        { const float f = __expf(c_l); \
          *(LAS float*)(lds + DF_OFF + tid * 4) = f; *(LAS float*)(lds + DK_OFF + tid * 4) = 1.0f - f; \
          *(LAS float*)(lds + DQ_OFF + tid * 4) = bf2f(c_q); *(LAS float*)(lds + DV_OFF + tid * 4) = bf2f(c_v); } \
        LDS_BARRIER(); \
        _Pragma("unroll 1") for (int t = 0; t < 4; ++t) { \
            const float vt = *(const LAS float*)(lds + DV_OFF + (t * 128 + v) * 4); \
            float a = 0.f; \
            _Pragma("unroll") for (int i4 = 0; i4 < 8; ++i4) { \
                const f32x4 f4 = *(const LAS f32x4*)(lds + DF_OFF + (t * 128 + 32 * kg + 4 * i4) * 4), k4 = *(const LAS f32x4*)(lds + DK_OFF + (t * 128 + 32 * kg + 4 * i4) * 4), \
                            q4 = *(const LAS f32x4*)(lds + DQ_OFF + (t * 128 + 32 * kg + 4 * i4) * 4); \
                _Pragma("unroll") for (int j = 0; j < 4; ++j) { const float sn = f4[j] * s[4 * i4 + j] + k4[j] * vt; s[4 * i4 + j] = sn; a += q4[j] * sn; } \
            } \
            *(LAS float*)(lds + DR_OFF + ((t * 4 + kg) * 128 + v) * 4) = a; \
        } \
        _Pragma("unroll") for (int q = 0; q < 4; ++q) { \
            float* so = state_out + (size_t)it * 16384 + (size_t)(32 * kg + 8 * q) * 128 + v; \
            _Pragma("unroll") for (int i = 0; i < 8; ++i) so[i * 128] = s[8 * q + i]; \
        } \
        if ((itx_) + 2 * stride < nitems) DEC_PREFETCH((itx_) + 2 * stride, s, c_l, c_q, c_v, c_sg, c_gn); \
        LDS_BARRIER(); \
        const LAS float* rr = (const LAS float*)(lds + DR_OFF + (kg * 4 * 128 + v) * 4); \
        const float o = (rr[0] + rr[128]) + (rr[256] + rr[384]); \
        const float ws = wave_sum(o * o); \
        if (lane == 0) *(LAS float*)(lds + DW_OFF + w * 4) = ws; \
        LDS_BARRIER(); \
        const float ss = *(const LAS float*)(lds + DW_OFF + (2 * kg) * 4) + *(const LAS float*)(lds + DW_OFF + (2 * kg + 1) * 4); \
        const float rstd = rsqrtf(ss * (1.0f / 128.0f) + EPS); \
        p.O2[off] = (bf16_t)(pk2(o * rstd * gate, 0.f) & 0xffffu); } while (0)
    if (first < nitems) DEC_PREFETCH(first, sA, lA, qA, vA, sgA, gA);
    if (first + stride < nitems) DEC_PREFETCH(first + stride, sB, lB, qB, vB, sgB, gB);
    for (int itx = first; itx < nitems; itx += 2 * stride) {
        DEC_BODY(itx, sA, lA, qA, vA, sgA, gA);
        if (itx + stride < nitems) DEC_BODY(itx + stride, sB, lB, qB, vB, sgB, gB);
    }
#undef DEC_BODY
#undef DEC_PREFETCH
}
}

namespace att {
constexpr int KS_OFF = 0, KS_STRIDE = 144;
constexpr int VT_OFF = 256 * 144, VT_STRIDE = 528;
struct P { const bf16_t* Qr; const bf16_t* Kb; const bf16_t* Vkv; const float* ck; const float* cv; const float* sinks; bf16_t* O; };

__device__ __forceinline__ void unit(LAS unsigned char* lds, const P& p, bool prompt, int b, int kvh, int qb) {
    const int tid = threadIdx.x, lane = tid & 63, w = __builtin_amdgcn_readfirstlane(tid >> 6), l16 = lane & 15, g = lane >> 4;
    const int h = kvh * 8 + w;
    bf16x8 qn0, qn1;
    { const size_t qrow0 = prompt ? (size_t)(b * TP + 128 * qb + l16) : (size_t)(NPROMPT + 4 * b + min(l16, 3));
      const bf16_t* qp = p.Qr + qrow0 * D + h * 64 + 8 * g; qn0 = *(const bf16x8*)qp; qn1 = *(const bf16x8*)(qp + 32); }
    __syncthreads();
#pragma unroll
    for (int i = 0; i < 4; ++i) {
        const int e = tid + 512 * i;
        {
            const int key = e >> 3, c8 = e & 7; u32x4 kv = (u32x4){0u, 0u, 0u, 0u};
            if (prompt) { if (qb > 0 || key >= 128) kv = *(const u32x4*)(p.Kb + (size_t)(b * TP + 128 * (qb - 1) + key) * 256 + kvh * 64 + c8 * 8); }
            else if (key < 128) { const f32x4* s = (const f32x4*)(p.ck + ((size_t)(b * 128 + key) * 4 + kvh) * 64 + c8 * 8); const f32x4 a = s[0], c = s[1]; kv = (u32x4){pk2(a.x, a.y), pk2(a.z, a.w), pk2(c.x, c.y), pk2(c.z, c.w)}; }
            else if (key < 132) kv = *(const u32x4*)(p.Kb + (size_t)(NPROMPT + 4 * b + key - 128) * 256 + kvh * 64 + c8 * 8);
            if (prompt || key < 160) *(LAS u32x4*)(lds + KS_OFF + key * KS_STRIDE + c8 * 16) = kv;
        }
        {
            const int key = e & 255, c8 = e >> 8; u32x4 vv = (u32x4){0u, 0u, 0u, 0u};
            if (prompt) { if (qb > 0 || key >= 128) vv = *(const u32x4*)(p.Vkv + (size_t)(b * TP + 128 * (qb - 1) + key) * 256 + kvh * 64 + c8 * 8); }
            else if (key < 128) { const f32x4* s = (const f32x4*)(p.cv + ((size_t)(b * 128 + key) * 4 + kvh) * 64 + c8 * 8); const f32x4 a = s[0], c = s[1]; vv = (u32x4){pk2(a.x, a.y), pk2(a.z, a.w), pk2(c.x, c.y), pk2(c.z, c.w)}; }
            else if (key < 132) vv = *(const u32x4*)(p.Vkv + (size_t)(NPROMPT + 4 * b + key - 128) * 256 + kvh * 64 + c8 * 8);
            if (prompt || key < 160) {
                LAS bf16_t* d = (LAS bf16_t*)(lds + VT_OFF + (c8 * 8) * VT_STRIDE + key * 2);
                d[0 * (VT_STRIDE / 2)] = (bf16_t)(vv.x & 0xffffu); d[1 * (VT_STRIDE / 2)] = (bf16_t)(vv.x >> 16);
                d[2 * (VT_STRIDE / 2)] = (bf16_t)(vv.y & 0xffffu); d[3 * (VT_STRIDE / 2)] = (bf16_t)(vv.y >> 16);
                d[4 * (VT_STRIDE / 2)] = (bf16_t)(vv.z & 0xffffu); d[5 * (VT_STRIDE / 2)] = (bf16_t)(vv.z >> 16);
                d[6 * (VT_STRIDE / 2)] = (bf16_t)(vv.w & 0xffffu); d[7 * (VT_STRIDE / 2)] = (bf16_t)(vv.w >> 16);
            }
        }
    }
    __syncthreads();
    const float sink = p.sinks[h];
    const bool hasprev = !prompt || qb > 0;
    const int nqt = prompt ? 8 : 1;
    for (int qt = 0; qt < nqt; ++qt) {
        const int qi = 16 * qt + l16;
        const size_t qrow = prompt ? (size_t)(b * TP + 128 * qb + qi) : (size_t)(NPROMPT + 4 * b + min(l16, 3));
        const bf16x8 qf[2] = {qn0, qn1};
        if (qt + 1 < nqt) { const bf16_t* qp = p.Qr + (qrow + 16) * D + h * 64 + 8 * g; qn0 = *(const bf16x8*)qp; qn1 = *(const bf16x8*)(qp + 32); }
        const int kt0 = 2 * (qt >> 1);
        f32x4 sc[10];
        float mx = -INFINITY;
#pragma unroll
        for (int ti = 0; ti < 10; ++ti) {
            const LAS unsigned char* kr = lds + KS_OFF + (16 * (kt0 + ti) + l16) * KS_STRIDE + 16 * g;
            f32x4 a4 = (f32x4){0.f, 0.f, 0.f, 0.f};
            a4 = __builtin_amdgcn_mfma_f32_16x16x32_bf16(*(const LAS bf16x8*)kr, qf[0], a4, 0, 0, 0);
            a4 = __builtin_amdgcn_mfma_f32_16x16x32_bf16(*(const LAS bf16x8*)(kr + 64), qf[1], a4, 0, 0, 0);
#pragma unroll
            for (int j = 0; j < 4; ++j) {
                const int jk = 16 * (kt0 + ti) + 4 * g + j;
                const bool valid = jk > qi && jk <= qi + 128 && (hasprev || jk >= 128);
                a4[j] = valid ? a4[j] : -INFINITY; mx = fmaxf(mx, a4[j]);
            }
            sc[ti] = a4;
        }
        mx = fmaxf(mx, __shfl_xor(mx, 16)); mx = fmaxf(mx, __shfl_xor(mx, 32)); mx = fmaxf(mx, sink);
        float sum = 0.f;
#pragma unroll
        for (int ti = 0; ti < 10; ++ti)
#pragma unroll
            for (int j = 0; j < 4; ++j) { const float e = __expf(sc[ti][j] - mx); sc[ti][j] = e; sum += e; }
        sum += __shfl_xor(sum, 16); sum += __shfl_xor(sum, 32);
        const float inv = 1.0f / (sum + __expf(sink - mx));
        f32x4 o[4];
#pragma unroll
        for (int dt = 0; dt < 4; ++dt) o[dt] = (f32x4){0.f, 0.f, 0.f, 0.f};
#pragma unroll
        for (int pp = 0; pp < 5; ++pp) {
            const bf16x8 pb = gla::pk8(sc[2 * pp], sc[2 * pp + 1]);
#pragma unroll
            for (int dt = 0; dt < 4; ++dt) {
                const LAS unsigned char* vr = lds + VT_OFF + (16 * dt + l16) * VT_STRIDE + (16 * (kt0 + 2 * pp) + 4 * g) * 2;
                const bf16x8 va = gla::mk8(*(const LAS u32x2*)vr, *(const LAS u32x2*)(vr + 32));
                o[dt] = __builtin_amdgcn_mfma_f32_16x16x32_bf16(va, pb, o[dt], 0, 0, 0);
            }
        }
        if (prompt || l16 < 4) {
#pragma unroll
            for (int dt = 0; dt < 4; ++dt) {
                const f32x4 v = o[dt] * inv; u32x2 wv; wv.x = pk2(v.x, v.y); wv.y = pk2(v.z, v.w);
                *(u32x2*)(p.O + qrow * D + h * 64 + 16 * dt + 4 * g) = wv;
            }
        }
    }
}
}

#define XB_TMO      128
#define XB_XCNT(j)  (256  + 64 * (j))
#define XB_XSUB(j)  (1280 + 64 * (j))
#define XB_XGEN(j)  (2304 + 64 * (j))
#define XB_TOP      3328
#define XB_TOPGEN   3392
#define XCD_BAR_WORDS 3456
#define XB_SPIN_CAP (1u << 18)
__device__ __forceinline__ unsigned xb_ld(unsigned* p)              { return __hip_atomic_load(p, __ATOMIC_RELAXED, __HIP_MEMORY_SCOPE_AGENT); }
__device__ __forceinline__ unsigned xb_add(unsigned* p, unsigned v) { return __hip_atomic_fetch_add(p, v, __ATOMIC_RELAXED, __HIP_MEMORY_SCOPE_AGENT); }
__device__ __forceinline__ unsigned xb_xcc_id() { return (unsigned)__builtin_amdgcn_s_getreg((3 << 11) | 20) & 0xFu; }
#define XB_SPIN(cond, bar) do { unsigned _sp = 0; while (cond) { __builtin_amdgcn_s_sleep(1); \
    if ((++_sp & 255u) == 0u) { if (xb_ld(&(bar)[XB_TMO])) break; if (_sp > XB_SPIN_CAP) { atomicAdd(&(bar)[XB_TMO], 1u); break; } } } } while (0)
struct XcdBarrier { unsigned* bar; unsigned x; volatile LAS unsigned* st; };
__device__ __forceinline__ XcdBarrier xcd_barrier_post(unsigned* bar, volatile LAS unsigned* st) {
    XcdBarrier b; b.bar = bar; b.x = xb_xcc_id(); b.st = st;
    if (threadIdx.x == 0) (void)xb_add(&bar[XB_XCNT(b.x)], 1u);
    return b;
}
__device__ __forceinline__ void xcd_barrier_complete(unsigned* bar, unsigned x, unsigned& nloc, unsigned& nx) {
    const unsigned G = gridDim.x * gridDim.y * gridDim.z;
    unsigned sum, cnt, mine, sp = 0u;
    for (;;) {
        sum = 0u; cnt = 0u; mine = 0u;
#pragma unroll
        for (unsigned j = 0; j < 16; ++j) { const unsigned c = xb_ld(&bar[XB_XCNT(j)]); sum += c; cnt += (c > 0u) ? 1u : 0u; mine = (j == x) ? c : mine; }
        if (sum == G) break;
        __builtin_amdgcn_s_sleep(1);
        if ((++sp & 255u) == 0u) { if (xb_ld(&bar[XB_TMO])) break; if (sp > XB_SPIN_CAP) { atomicAdd(&bar[XB_TMO], 1u); break; } }
    }
    nloc = mine > 0u ? mine : 1u; nx = cnt > 0u ? cnt : 1u;
}
__device__ __forceinline__ void xcd_barrier(const XcdBarrier& b) {
    asm volatile("s_waitcnt vmcnt(0)" ::: "memory");
    __syncthreads();
    if (threadIdx.x == 0) {
        unsigned* bar = b.bar;
        __builtin_amdgcn_s_waitcnt(0);
        unsigned nloc = b.st[0], nx = b.st[1];
        if (nloc == 0u) { xcd_barrier_complete(bar, b.x, nloc, nx); b.st[0] = nloc; b.st[1] = nx; }
        const unsigned old = xb_add(&bar[XB_XSUB(b.x)], 1u);
        const unsigned gen = old / nloc;
        if (old + 1u == (gen + 1u) * nloc) {
            __builtin_amdgcn_fence(__ATOMIC_RELEASE, "agent");
            asm volatile("s_waitcnt vmcnt(0)" ::: "memory");
            const unsigned og = xb_add(&bar[XB_TOP], 1u);
            const unsigned tg = og / nx;
            if (og + 1u == (tg + 1u) * nx) xb_add(&bar[XB_TOPGEN], 1u);
            else XB_SPIN(xb_ld(&bar[XB_TOPGEN]) == tg, bar);
            __builtin_amdgcn_fence(__ATOMIC_ACQUIRE, "agent");
            xb_add(&bar[XB_XGEN(b.x)], 1u);
            asm volatile("s_waitcnt vmcnt(0)" ::: "memory");
        } else {
            XB_SPIN(xb_ld(&bar[XB_XGEN(b.x)]) == gen, bar);
            __builtin_amdgcn_fence(__ATOMIC_ACQUIRE, "agent");
            asm volatile("s_waitcnt vmcnt(0)" ::: "memory");
        }
    }
    __syncthreads();
}

struct Args { const float* in[20]; float* out; unsigned char* ws; int ph_lo, ph_hi; };
constexpr int N_PHASES = 16;

__global__ void __launch_bounds__(NWAVES * 64, 2) mk_fwd(Args args) {
    extern __shared__ __attribute__((aligned(16))) unsigned char lds_raw[];
    LAS unsigned char* lds = (LAS unsigned char*)lds_raw;
    cg::grid_group grid = cg::this_grid();
    const int tid = threadIdx.x, lane = tid & 63, wave = __builtin_amdgcn_readfirstlane(tid >> 6);
    const int G = gridDim.x, cb = blockIdx.x;
    const int gw = cb * NWAVES + wave, NGW = G * NWAVES;
    unsigned char* ws = args.ws;
    const float* x_prompt = args.in[0]; const float* x_sample = args.in[1]; const float* state_in = args.in[2]; const float* cache_k = args.in[3]; const float* cache_v = args.in[4];
    const float* g_mix_pre = args.in[5]; const float* g_mix_post = args.in[6]; const float* g_ffn_pre = args.in[7]; const float* g_ffn_post = args.in[8];
    const float* w_in = args.in[9]; const float* lbraw = args.in[10]; const float* g_hnorm = args.in[11]; const float* w_hout = args.in[12];
    const float* g_kv = args.in[13]; const float* w_kv = args.in[14]; const float* w_q = args.in[15]; const float* sinks = args.in[16]; const float* w_ao = args.in[17];
    const float* w_gu = args.in[18]; const float* w_dn = args.in[19];
    bf16_t* Win_t = (bf16_t*)(ws + WS_WIN); bf16_t* Wout_t = (bf16_t*)(ws + WS_WOUT); bf16_t* Wkv_t = (bf16_t*)(ws + WS_WKV); bf16_t* Wq_t = (bf16_t*)(ws + WS_WQ); bf16_t* Wao_t = (bf16_t*)(ws + WS_WAO);
    bf16_t* Wgu_t[2] = {(bf16_t*)(ws + WS_WGU0), (bf16_t*)(ws + WS_WGU1)}; bf16_t* Wd_t[2] = {(bf16_t*)(ws + WS_WD0), (bf16_t*)(ws + WS_WD1)};
    f32x2* rope = (f32x2*)(ws + WS_ROPE);
    bf16_t* XN = (bf16_t*)(ws + WS_XN); bf16_t* O2 = (bf16_t*)(ws + WS_O2); bf16_t* Y = (bf16_t*)(ws + WS_Y);
    bf16_t* Qs = (bf16_t*)(ws + WS_QS); float* LOGF = (float*)(ws + WS_LOGF); bf16_t* Vb = (bf16_t*)(ws + WS_VB); bf16_t* SG = (bf16_t*)(ws + WS_SG);
    bf16_t* Hact = (bf16_t*)(ws + WS_HACT);
    bf16_t* XKV = (bf16_t*)(ws + WS_XKV); bf16_t* Qr = (bf16_t*)(ws + WS_QR); bf16_t* Kb = (bf16_t*)(ws + WS_KB); bf16_t* Vkv = (bf16_t*)(ws + WS_VKV);
    float* out = args.out; float* H = out + OUT_Y; bf16_t* Hb = (bf16_t*)(ws + WS_HB);
    float* slab = (float*)(ws + WS_SLAB); unsigned* cntw = (unsigned*)(ws + WS_CNT);
    const int lo = args.ph_lo, hi = args.ph_hi;
    LAS float* scr = (LAS float*)(lds + wave * 16384);
    constexpr int I_IN = 32 * 256, I_SQ = 32 * 64, I_KV = 32 * 16, I_GU = 32 * 352, I_DN = 88 * 64;
#define IN(k) (lo <= (k) && (k) < hi)
#define SEAM(k) do { if (IN(k) && IN((k) + 1)) { if (lo < 0) grid.sync(); else xcd_barrier(bar); } } while (0)
    volatile LAS unsigned* MISC = (volatile LAS unsigned*)(lds + 131072 + 320);
    if (tid < 32) MISC[tid] = 0u;
    __syncthreads();
    XcdBarrier bar; bar.bar = (unsigned*)ws; bar.x = 0; bar.st = nullptr;
    if (hi - lo > 1) bar = xcd_barrier_post((unsigned*)ws, MISC + 8);

    if (IN(0)) {
        cvt_stream<false>(w_in, D, 4 * D, Win_t, scr, gw, NGW, I_IN, lane);
        for (int e = cb * 512 + tid; e < (TP + TS) * 8; e += G * 512) {
            const int idx = e >> 3, f = e & 7; const double pos = idx < TP ? (double)idx : (double)(8192 + idx - TP);
            const double invf[8] = {1.0, 0.19392274474868576, 0.03760603093086393, 0.007292664737217109, 0.001414213562373095, 0.0002742481756762073, 5.318295896944988e-05, 1.031338537721246e-05};
            double iv = invf[0];
#pragma unroll
            for (int q = 1; q < 8; ++q) iv = f == q ? invf[q] : iv;
            const double ang = pos * (double)(float)iv;
            const double TWO_PI = 6.283185307179586476925286766559;
            const double r = ang - TWO_PI * __builtin_rint(ang / TWO_PI);
            const double r2 = r * r;
            double sn = 0.0, cs = 0.0;
#pragma unroll
            for (int k = 14; k >= 1; --k) { sn = (1.0 - sn) * r2 / (double)((2 * k) * (2 * k + 1)); cs = (1.0 - cs) * r2 / (double)((2 * k - 1) * (2 * k)); }
            rope[e] = (f32x2){(float)(1.0 - cs), (float)(r * (1.0 - sn))};
        }
        for (int m = gw; m < M; m += NGW) {
            const float* xr = m < NPROMPT ? x_prompt + (size_t)m * D : x_sample + (size_t)(m - NPROMPT) * D;
            row_pass<false, true, false>(xr, nullptr, nullptr, nullptr, g_mix_pre, XN + (size_t)m * D, nullptr, nullptr, lane);
        }
    }
    SEAM(0);
    if (IN(1)) {
        pg8::Gemm g{XN, Win_t, M, 4 * D, D}; pg8::StaticOrder S; S.init(M, 4 * D, G, cb, D);
        pg8::EpiIn E{Qs, LOGF, Vb, SG, lbraw};
        pg8::gemm_phase<pg8::EpiIn, pg8::StaticOrder, true, true>(lds, g, S, E);
        if (cb >= 64) {
            const int wv_ = (cb - 64) * NWAVES + wave;
            if (wv_ < 256) cvt_stream<false>(w_hout, D, D, Wout_t, scr, wv_, 256, I_SQ, lane);
            else if (wv_ < 512) cvt_stream<false>(w_q, D, D, Wq_t, scr, wv_ - 256, 256, I_SQ, lane);
            else if (wv_ < 768) cvt_stream<false>(w_ao, D, D, Wao_t, scr, wv_ - 512, 256, I_SQ, lane);
            else if (wv_ < 832) cvt_stream<false>(w_kv, D, 512, Wkv_t, scr, wv_ - 768, 64, I_KV, lane);
            else cvt_stream<false>(w_dn, DFF, D, Wd_t[0], scr, wv_ - 832, 704, I_DN, lane);
        }
    }
    SEAM(1);
    gla::P gp{Qs, LOGF, Vb, SG, g_hnorm, O2, ws + WS_GQT, ws + WS_GKH, ws + WS_GVT, ws + WS_GPS, ws + WS_GDEC};
    if (IN(2)) {
        gla::intra_items(lds, gp, cb, G, 2048);
    }
    SEAM(2);
    if (IN(3)) {
        const int nA = 64;
        if (cb < nA) gla::scan_seq(lds, gp, cb, out + OUT_SP + (size_t)cb * 16384, 32);
        else {
            gla::decode_items(lds, gp, state_in, out + OUT_SS, cb - nA, G - nA, BS * 16);
            __syncthreads();
            cvt_stream<true>(w_gu, D, 2 * DFF, Wgu_t[0], scr, (cb - nA) * NWAVES + wave, (G - nA) * NWAVES, I_GU, lane);
        }
    }
    SEAM(3);
    if (IN(4)) {
        pg8::Gemm g{O2, Wout_t, M, D, D}; pg8::SplitOrder S; S.init(D, G, cb, D);
        pg8::EpiF32 E{Y, D, slab, cntw + 0 * 1024};
        pg8::gemm_phase<pg8::EpiF32, pg8::SplitOrder, true, true>(lds, g, S, E);
    }
    SEAM(4);
    if (IN(5)) {
        for (int m = gw; m < M; m += NGW) {
            const float* xr = m < NPROMPT ? x_prompt + (size_t)m * D : x_sample + (size_t)(m - NPROMPT) * D;
            row_pass<true, true, false, false, true>(xr, Y + (size_t)m * D, g_mix_post, Hb + (size_t)m * D, g_ffn_pre, XN + (size_t)m * D, nullptr, nullptr, lane);
        }
    }
    SEAM(5);
    if (IN(6)) {
        pg8::Gemm g{XN, Wgu_t[0], M, 2 * DFF, D}; pg8::StaticOrder S; S.init(M, 2 * DFF, G, cb, D);
        pg8::EpiSwiGLU E{Hact};
        pg8::gemm_phase<pg8::EpiSwiGLU, pg8::StaticOrder, true, true>(lds, g, S, E);
    }
    SEAM(6);
    if (IN(7)) {
        pg8::Gemm g{Hact, Wd_t[0], M, D, DFF}; pg8::SplitOrder S; S.init(D, G, cb, DFF);
        pg8::EpiF32 E{Y, D, slab, cntw + 1 * 1024};
        pg8::gemm_phase<pg8::EpiF32, pg8::SplitOrder, true, true>(lds, g, S, E);
    }
    SEAM(7);
    if (IN(8)) {
        for (int m = gw; m < M; m += NGW)
            row_pass<true, true, true, true, true>(Hb + (size_t)m * D, Y + (size_t)m * D, g_ffn_post, Hb + (size_t)m * D, g_mix_pre + D, XN + (size_t)m * D, g_kv, XKV + (size_t)m * D, lane);
    }
    SEAM(8);
    if (IN(9)) {
        { pg8::Gemm g{XKV, Wkv_t, M, 512, D}; pg8::StaticOrder S; S.init(M, 512, G, cb, D);
          pg8::EpiRope<1> E{Kb, Vkv, rope, out + OUT_KWIN, out + OUT_VWIN, out + OUT_KNEW, out + OUT_VNEW};
          pg8::gemm_phase<pg8::EpiRope<1>, pg8::StaticOrder, true, true>(lds, g, S, E); }
        { pg8::Gemm g{XN, Wq_t, M, D, D}; pg8::StaticOrder S; S.init(M, D, G, (cb + G - (68 % G)) % G, D);
          pg8::EpiRope<0> E{Qr, nullptr, rope, nullptr, nullptr, nullptr, nullptr};
          pg8::gemm_phase<pg8::EpiRope<0>, pg8::StaticOrder, true, true>(lds, g, S, E); }
        if (cb >= 84) {
            const int wv_ = (cb - 84) * NWAVES + wave;
            if (wv_ < 917) cvt_stream<true>(w_gu + (size_t)D * 2 * DFF, D, 2 * DFF, Wgu_t[1], scr, wv_, 917, I_GU, lane);
            else cvt_stream<false>(w_dn + (size_t)DFF * D, DFF, D, Wd_t[1], scr, wv_ - 917, 459, I_DN, lane);
        }
    }
    SEAM(9);
    if (IN(10)) {
        att::P ap{Qr, Kb, Vkv, cache_k, cache_v, sinks, O2};
        for (int u = cb; u < 256 + 512; u += G) {
            if (u < 256) att::unit(lds, ap, true, u >> 6, (u >> 4) & 3, u & 15);
            else { const int v = u - 256; att::unit(lds, ap, false, v >> 2, v & 3, 0); }
        }
    }
    SEAM(10);
    if (IN(11)) {
        pg8::Gemm g{O2, Wao_t, M, D, D}; pg8::SplitOrder S; S.init(D, G, cb, D);
        pg8::EpiF32 E{Y, D, slab, cntw + 2 * 1024};
        pg8::gemm_phase<pg8::EpiF32, pg8::SplitOrder, true, true>(lds, g, S, E);
    }
    SEAM(11);
    if (IN(12)) {
        for (int m = gw; m < M; m += NGW)
            row_pass<true, true, false, true, true>(Hb + (size_t)m * D, Y + (size_t)m * D, g_mix_post + D, Hb + (size_t)m * D, g_ffn_pre + D, XN + (size_t)m * D, nullptr, nullptr, lane);
    }
    SEAM(12);
    if (IN(13)) {
        pg8::Gemm g{XN, Wgu_t[1], M, 2 * DFF, D}; pg8::StaticOrder S; S.init(M, 2 * DFF, G, cb, D);
        pg8::EpiSwiGLU E{Hact};
        pg8::gemm_phase<pg8::EpiSwiGLU, pg8::StaticOrder, true, true>(lds, g, S, E);
    }
    SEAM(13);
    if (IN(14)) {
        pg8::Gemm g{Hact, Wd_t[1], M, D, DFF}; pg8::SplitOrder S; S.init(D, G, cb, DFF);
        pg8::EpiF32 E{Y, D, slab, cntw + 3 * 1024};
        pg8::gemm_phase<pg8::EpiF32, pg8::SplitOrder, true, true>(lds, g, S, E);
    }
    SEAM(14);
    if (IN(15)) {
        for (int m = gw; m < M; m += NGW)
            row_pass<true, false, false, true, false>(Hb + (size_t)m * D, Y + (size_t)m * D, g_ffn_post + D, H + (size_t)m * D, nullptr, nullptr, nullptr, nullptr, lane);
    }
#undef IN
#undef SEAM
}

extern "C" void kernel_launch(void* const* d_in, const int* in_sizes, int n_in, void* d_out, int out_size, void* d_ws, size_t ws_size, hipStream_t stream) {
    static int grid = 0;
    if (grid == 0) {
        if (n_in != 20 || (size_t)out_size != OUT_END || ws_size < WS_END) { fprintf(stderr, "kernel_launch: unexpected shapes: n_in %d out %d ws %zu (need %zu)\n", n_in, out_size, ws_size, (size_t)WS_END); grid = -1; return; }
        int dev = 0, cus = 0, per_cu = 0;
        hipGetDevice(&dev); hipDeviceGetAttribute(&cus, hipDeviceAttributeMultiprocessorCount, dev);
        if (hipFuncSetAttribute((const void*)mk_fwd, hipFuncAttributeMaxDynamicSharedMemorySize, LDS_BYTES) != hipSuccess) { fprintf(stderr, "kernel_launch: hipFuncSetAttribute failed\n"); grid = -1; return; }
        hipOccupancyMaxActiveBlocksPerMultiprocessor(&per_cu, (const void*)mk_fwd, NWAVES * 64, LDS_BYTES);
        (void)hipGetLastError();
        if (per_cu < 1) per_cu = 1;
        if (cus < 256) { fprintf(stderr, "kernel_launch: built for a 256-CU device (got %d)\n", cus); grid = -1; return; }
        grid = 256;
        fprintf(stderr, "kernel_launch: cus %d per_cu %d grid %d\n", cus, per_cu, grid);
    }
    if (grid < 0) return;
    if (hipMemsetAsync(d_ws, 0, 131072, stream) != hipSuccess) { fprintf(stderr, "kernel_launch: memset failed\n"); return; }
    Args a{};
    for (int i = 0; i < 20; ++i) a.in[i] = (const float*)d_in[i];
    a.out = (float*)d_out; a.ws = (unsigned char*)d_ws;
#if MK_ONE_LAUNCH
    void* kargs[] = {&a};
    a.ph_lo = 0; a.ph_hi = N_PHASES;
    hipError_t e = hipLaunchCooperativeKernel((const void*)mk_fwd, dim3(grid), dim3(NWAVES * 64), kargs, LDS_BYTES, stream);
    if (e != hipSuccess) fprintf(stderr, "kernel_launch: cooperative launch failed: %s\n", hipGetErrorString(e));
#else
    for (int ph = 0; ph < N_PHASES; ++ph) {
        a.ph_lo = ph; a.ph_hi = ph + 1;
        hipLaunchKernelGGL(mk_fwd, dim3(grid), dim3(NWAVES * 64), LDS_BYTES, stream, a);
    }
#endif
}
```

```cpp
#include <hip/hip_runtime.h>
#include <hip/hip_cooperative_groups.h>
#include <cstdio>
#include <cstdint>
namespace cg = cooperative_groups;

#ifndef MK_ONE_LAUNCH
#define MK_ONE_LAUNCH 1
#endif

#define LAS __attribute__((address_space(3)))
typedef unsigned short bf16_t;
typedef short bf16x8 __attribute__((ext_vector_type(8)));
typedef float f32x4 __attribute__((ext_vector_type(4)));
typedef float f32x2 __attribute__((ext_vector_type(2)));
typedef unsigned u32x4 __attribute__((ext_vector_type(4)));
typedef unsigned u32x2 __attribute__((ext_vector_type(2)));
typedef __bf16 bf16x2_t __attribute__((ext_vector_type(2)));

constexpr int D = 2048, NPROMPT = 8192, NSAMPLE = 512, M = NPROMPT + NSAMPLE;
constexpr int TP = 2048, TS = 4, BS = 128;
constexpr int DFF = 5632;
constexpr float EPS = 1e-6f;

__device__ __forceinline__ unsigned pk2(float lo, float hi) { f32x2 v = {lo, hi}; bf16x2_t b = __builtin_convertvector(v, bf16x2_t); return __builtin_bit_cast(unsigned, b); }
__device__ __forceinline__ float bf2f(unsigned b) { return __uint_as_float(b << 16); }
__device__ __forceinline__ float silu_f(float x) { return x * __builtin_amdgcn_rcpf(1.0f + __expf(-x)); }
__device__ __forceinline__ float wave_sum(float v) {
#pragma unroll
    for (int o = 1; o < 64; o <<= 1) v += __shfl_xor(v, o);
    return v;
}

namespace pg8 {
constexpr int BM = 256, BK = 64, HALF = 128, HTB = HALF * BK * 2, STAGE_BYTES = 8 * HTB, NXCD = 8, WGM = 8;
__host__ __device__ __forceinline__ int lds_byte(int r, int c) { const int st = (r >> 4) * 2 + (c >> 5), rr = r & 15, cc = c & 31, ob = rr * 64 + cc * 2; return st * 1024 + (ob ^ (((ob >> 9) & 1) << 5)); }
__host__ __device__ __forceinline__ void stage_rc(int b, int& R, int& C) { const int st = b / 1024, sb = b % 1024, swz = sb ^ (((sb >> 9) & 1) << 5); R = (st >> 1) * 16 + swz / 64; C = (st & 1) * 32 + (swz % 64) / 2; }
__host__ __device__ __forceinline__ int perm32(int rho) { const int n = rho >> 4, i = rho & 15; return 8 * (i >> 2) + 4 * n + (i & 3); }

struct Unit { int pm, pn, kt0, nt, split, uid; };
struct Gemm { const bf16_t* A; const bf16_t* Bt; int M, N, K; };

struct StaticOrder {
    int nM, nN, nwg, G, c, ntk;
    __host__ __device__ void init(int M_, int N_, int G_, int c_, int K_) { nM = M_ / BM; nN = N_ / BM; nwg = nM * nN; G = G_; c = c_; ntk = K_ / BK; }
    __host__ __device__ bool next(int i, Unit& u) const {
        const long L = (long)i * G + c; if (L >= nwg) return false;
        u.kt0 = 0; u.nt = ntk; u.split = -1; u.uid = 0;
        int wgid = (int)L; { const int q = nwg / NXCD, r = nwg % NXCD, xcd = wgid % NXCD, off = wgid / NXCD; wgid = (xcd < r ? xcd * (q + 1) : r * (q + 1) + (xcd - r) * q) + off; }
        const int nig = WGM * nN, gid = wgid / nig, fm = gid * WGM, gsz = (nM - fm) < WGM ? (nM - fm) : WGM;
        u.pm = fm + ((wgid % nig) % gsz); u.pn = (wgid % nig) / gsz; return true;
    }
    __device__ __forceinline__ void a_ready(const Unit&) const {}
    __device__ __forceinline__ void done(const Unit&) const {}
};

struct SplitOrder {
    StaticOrder so; int c;
    __host__ __device__ void init(int N_, int G_, int c_, int K_) { so.init(8192, N_, G_, c_, K_); c = c_; }
    __host__ __device__ bool next(int i, Unit& u) const {
        if (i == 0) return so.next(0, u);
        if (i == 1 && c < 128) { const int j = c >> 3, sp = c & 7; u.pm = 32 + (j >> 3); u.pn = j & 7; u.split = sp; u.uid = j;
            if (so.ntk == 32) { u.kt0 = 4 * sp; u.nt = 4; } else { u.kt0 = sp < 4 ? 12 * sp : 48 + 10 * (sp - 4); u.nt = sp < 4 ? 12 : 10; }
            return true; }
        return false;
    }
    __device__ __forceinline__ void a_ready(const Unit&) const {}
    __device__ __forceinline__ void done(const Unit&) const {}
};


struct EpiIn {
    static constexpr bool PERM = true, AFTER_DRAIN = false;
    bf16_t* Qs; float* LOGF; bf16_t* Vb; bf16_t* SG; const float* lbraw;
    __device__ __forceinline__ void operator()(const f32x4 (&acc)[2][2][4][2], const Unit& u, int wr, int wc, int fr, int fq) const {
        const int seg = u.pn >> 3;
        const int row0 = u.pm * BM + wr * 64 + fr;
        const int col0 = (u.pn & 7) * BM + wc * 32 + 8 * fq;
        if (seg == 1) {
#pragma unroll
            for (int bj = 0; bj < 2; ++bj) {
                const int c = col0 + bj * HALF;
                float lb[8];
#pragma unroll
                for (int e = 0; e < 8; ++e) { const float a0 = lbraw[c + e], a1 = lbraw[D + c + e]; lb[e] = __builtin_amdgcn_rcpf(1.0f + __expf(a1 - a0)); }
#pragma unroll
                for (int ai = 0; ai < 2; ++ai)
#pragma unroll
                    for (int m = 0; m < 4; ++m) {
                        float* dst = LOGF + (size_t)(row0 + ai * HALF + m * 16) * D + c;
                        f32x4 o0, o1;
#pragma unroll
                        for (int j = 0; j < 4; ++j) {
                            const float s0 = __builtin_amdgcn_rcpf(1.0f + __expf(-acc[ai][bj][m][0][j])), s1 = __builtin_amdgcn_rcpf(1.0f + __expf(-acc[ai][bj][m][1][j]));
                            o0[j] = __logf(lb[j] + (1.0f - lb[j]) * s0); o1[j] = __logf(lb[4 + j] + (1.0f - lb[4 + j]) * s1);
                        }
                        *(f32x4*)dst = o0; *(f32x4*)(dst + 4) = o1;
                    }
            }
        } else {
            bf16_t* base = Qs + (size_t)seg * ((size_t)M * D);
#pragma unroll
            for (int ai = 0; ai < 2; ++ai)
#pragma unroll
                for (int m = 0; m < 4; ++m)
#pragma unroll
                    for (int bj = 0; bj < 2; ++bj) {
                        f32x4 v0 = acc[ai][bj][m][0], v1 = acc[ai][bj][m][1];
                        if (seg != 2) {
#pragma unroll
                            for (int j = 0; j < 4; ++j) { v0[j] = silu_f(v0[j]); v1[j] = silu_f(v1[j]); }
                        }
                        u32x4 w; w.x = pk2(v0[0], v0[1]); w.y = pk2(v0[2], v0[3]); w.z = pk2(v1[0], v1[1]); w.w = pk2(v1[2], v1[3]);
                        *(u32x4*)(base + (size_t)(row0 + ai * HALF + m * 16) * D + col0 + bj * HALF) = w;
                    }
        }
    }
};
struct EpiF32 {
    static constexpr bool PERM = true, AFTER_DRAIN = false;
    bf16_t* Y; int ldc; float* slab; unsigned* cnt;
    __device__ __forceinline__ void operator()(const f32x4 (&acc)[2][2][4][2], const Unit& u, int wr, int wc, int fr, int fq) const {
        const int row0 = u.pm * BM + wr * 64 + fr, col0 = u.pn * BM + wc * 32 + 8 * fq;
        if (u.split < 0) {
#pragma unroll
            for (int ai = 0; ai < 2; ++ai)
#pragma unroll
                for (int m = 0; m < 4; ++m)
#pragma unroll
                    for (int bj = 0; bj < 2; ++bj) {
                        const f32x4 v0 = acc[ai][bj][m][0], v1 = acc[ai][bj][m][1];
                        u32x4 w4; w4.x = pk2(v0[0], v0[1]); w4.y = pk2(v0[2], v0[3]); w4.z = pk2(v1[0], v1[1]); w4.w = pk2(v1[2], v1[3]);
                        *(u32x4*)(Y + (size_t)(row0 + ai * HALF + m * 16) * ldc + col0 + bj * HALF) = w4;
                    }
            return;
        }
        const int tid = threadIdx.x;
        u32x4* mine = (u32x4*)((unsigned char*)slab + (size_t)(u.uid * 8 + u.split) * 131072) + tid;
#pragma unroll
        for (int ai = 0; ai < 2; ++ai)
#pragma unroll
            for (int m = 0; m < 4; ++m)
#pragma unroll
                for (int bj = 0; bj < 2; ++bj) { const f32x4 v0 = acc[ai][bj][m][0], v1 = acc[ai][bj][m][1];
                    u32x4 w4; w4.x = pk2(v0[0], v0[1]); w4.y = pk2(v0[2], v0[3]); w4.z = pk2(v1[0], v1[1]); w4.w = pk2(v1[2], v1[3]);
                    mine[((ai * 4 + m) * 2 + bj) * 512] = w4; }
        asm volatile("s_waitcnt vmcnt(0)" ::: "memory");
        __syncthreads();
        if (tid == 0) {
            unsigned* cw = cnt + 64 * u.uid;
            __builtin_amdgcn_fence(__ATOMIC_RELEASE, "agent");
            asm volatile("s_waitcnt vmcnt(0)" ::: "memory");
            __hip_atomic_fetch_add(cw, 1u, __ATOMIC_RELAXED, __HIP_MEMORY_SCOPE_AGENT);
            unsigned sp = 0;
            while (__hip_atomic_load(cw, __ATOMIC_RELAXED, __HIP_MEMORY_SCOPE_AGENT) < 8u) { __builtin_amdgcn_s_sleep(2); if (++sp > (1u << 22)) break; }
            __builtin_amdgcn_fence(__ATOMIC_ACQUIRE, "agent");
            asm volatile("s_waitcnt vmcnt(0)" ::: "memory");
        }
        __syncthreads();
        const int ai = u.split >> 2, m = u.split & 3;
        const u32x4* base = (const u32x4*)((const unsigned char*)slab + (size_t)(u.uid * 8) * 131072) + tid + (size_t)(u.split * 2) * 512;
        u32x4 pw[8][2];
#pragma unroll
        for (int sp = 0; sp < 8; ++sp)
#pragma unroll
            for (int bj = 0; bj < 2; ++bj) pw[sp][bj] = base[(size_t)sp * 8192 + bj * 512];
#pragma unroll
        for (int bj = 0; bj < 2; ++bj) {
            f32x4 v0 = (f32x4){0.f, 0.f, 0.f, 0.f}, v1 = v0;
#pragma unroll
            for (int sp = 0; sp < 8; ++sp) { const u32x4 q = pw[sp][bj];
                v0 += (f32x4){bf2f(q.x & 0xffffu), __uint_as_float(q.x & 0xffff0000u), bf2f(q.y & 0xffffu), __uint_as_float(q.y & 0xffff0000u)};
                v1 += (f32x4){bf2f(q.z & 0xffffu), __uint_as_float(q.z & 0xffff0000u), bf2f(q.w & 0xffffu), __uint_as_float(q.w & 0xffff0000u)}; }
            u32x4 w4; w4.x = pk2(v0[0], v0[1]); w4.y = pk2(v0[2], v0[3]); w4.z = pk2(v1[0], v1[1]); w4.w = pk2(v1[2], v1[3]);
            *(u32x4*)(Y + (size_t)(row0 + ai * HALF + m * 16) * ldc + col0 + bj * HALF) = w4;
        }
    }
};
struct EpiSwiGLU {
    static constexpr bool PERM = true, AFTER_DRAIN = false;
    bf16_t* Hact;
    __device__ __forceinline__ void operator()(const f32x4 (&acc)[2][2][4][2], const Unit& u, int wr, int wc, int fr, int fq) const {
        const int row0 = u.pm * BM + wr * 64 + fr, col0 = u.pn * HALF + wc * 32 + 8 * fq;
#pragma unroll
        for (int ai = 0; ai < 2; ++ai)
#pragma unroll
            for (int m = 0; m < 4; ++m) {
                f32x4 v0, v1;
#pragma unroll
                for (int j = 0; j < 4; ++j) { v0[j] = silu_f(acc[ai][0][m][0][j]) * acc[ai][1][m][0][j]; v1[j] = silu_f(acc[ai][0][m][1][j]) * acc[ai][1][m][1][j]; }
                u32x4 w; w.x = pk2(v0[0], v0[1]); w.y = pk2(v0[2], v0[3]); w.z = pk2(v1[0], v1[1]); w.w = pk2(v1[2], v1[3]);
                *(u32x4*)(Hact + (size_t)(row0 + ai * HALF + m * 16) * DFF + col0) = w;
            }
    }
};
template <int MODE> struct EpiRope {
    static constexpr bool PERM = true, AFTER_DRAIN = false;
    bf16_t* O0; bf16_t* O1; const f32x2* rope;
    float* kwin; float* vwin; float* knew; float* vnew;
    __device__ __forceinline__ void operator()(const f32x4 (&accin)[2][2][4][2], const Unit& u, int wr, int wc, int fr, int fq) const {
        const int row0 = u.pm * BM + wr * 64 + fr;
        const bool do_rope = (MODE == 0 || u.pn == 0) && ((wc & 1) == 0);
        const float scale = MODE == 0 ? 0.125f : 1.0f;
#pragma unroll
        for (int ai = 0; ai < 2; ++ai)
#pragma unroll
            for (int m = 0; m < 4; ++m) {
                const int row = row0 + ai * HALF + m * 16;
                f32x4 v[2][2];
#pragma unroll
                for (int bj = 0; bj < 2; ++bj) { v[bj][0] = accin[ai][bj][m][0]; v[bj][1] = accin[ai][bj][m][1]; }
                if (do_rope) {
                    const int idx = row < NPROMPT ? (row & (TP - 1)) : (TP + (row & 3));
                    const f32x4* rp = (const f32x4*)(rope + (size_t)idx * 8);
                    f32x4 cs[4];
#pragma unroll
                    for (int q = 0; q < 4; ++q) cs[q] = rp[q];
#pragma unroll
                    for (int bj = 0; bj < 2; ++bj)
#pragma unroll
                        for (int n = 0; n < 2; ++n)
#pragma unroll
                            for (int j = 0; j < 4; ++j) {
                                const int f = 4 * n + j;
                                const float c = cs[f >> 1][(f & 1) * 2], s = cs[f >> 1][(f & 1) * 2 + 1];
                                const float x = v[bj][n][j];
                                const float px = __shfl_xor(x, 16);
                                const float r = fq == 0 ? x * c - px * s : x * c + px * s;
                                v[bj][n][j] = fq < 2 ? r : x;
                            }
                }
#pragma unroll
                for (int bj = 0; bj < 2; ++bj) {
                    const f32x4 a = v[bj][0] * scale, b = v[bj][1] * scale;
                    u32x4 w; w.x = pk2(a[0], a[1]); w.y = pk2(a[2], a[3]); w.z = pk2(b[0], b[1]); w.w = pk2(b[2], b[3]);
                    const int ct = bj * HALF + wc * 32 + 8 * fq;
                    if (MODE == 0) {
                        *(u32x4*)(O0 + (size_t)row * D + u.pn * BM + ct) = w;
                    } else {
                        bf16_t* ob = u.pn == 0 ? O0 : O1;
                        *(u32x4*)(ob + (size_t)row * 256 + ct) = w;
                        float* fo = nullptr;
                        if (u.pm >= NPROMPT / BM) fo = (u.pn == 0 ? knew : vnew) + (size_t)(row - NPROMPT) * 256 + ct;
                        else if ((u.pm & 7) == 7 && ai == 1) fo = (u.pn == 0 ? kwin : vwin) + (size_t)((u.pm >> 3) * 128 + (row & 127)) * 256 + ct;
                        if (fo) { *(f32x4*)fo = a; *(f32x4*)(fo + 4) = b; }
                    }
                }
            }
    }
};

template <class Epi, class Sched, bool ALIGN_EPI = false, bool SP2 = false>
__device__ __forceinline__ void gemm_phase(LAS unsigned char* lds, const Gemm g, const Sched& S, const Epi& E) {
    const int tid = threadIdx.x, wid = __builtin_amdgcn_readfirstlane(tid >> 6), lane = tid & 63, wr = wid >> 2, wc = wid & 3, fr = lane & 15, fq = lane >> 4;
    const int K = g.K;
    unsigned voffA[2], voffB[2];
#pragma unroll
    for (int i = 0; i < 2; ++i) { int R, C; stage_rc(tid * 16 + i * 8192, R, C); const int Rb = Epi::PERM ? ((R & ~31) + perm32(R & 31)) : R;
        voffA[i] = (unsigned)(R * K + C) * 2u; voffB[i] = (unsigned)(Rb * K + C) * 2u; }
    const size_t kstep = (size_t)(BK * 2);
    const size_t hstep = (size_t)HALF * K * 2;
    const size_t tstep = 2 * hstep;
    const unsigned ldsw = (unsigned)wid * 1024u;
    const int aoff = lds_byte(wr * 64 + fr, fq * 8), boff = lds_byte(wc * 32 + fr, fq * 8);
#define PG8_SA(b, h) (((b) * 2 + (h)) * HTB)
#define PG8_SB(b, h) ((4 + (b) * 2 + (h)) * HTB)
#define PG8_STAGE(bufoff, gbase, voff) do { _Pragma("unroll") for (int _i = 0; _i < 2; ++_i) \
        __builtin_amdgcn_global_load_lds((const unsigned*)((const char*)(gbase) + (voff)[_i]), (LAS unsigned*)(lds + (bufoff) + ldsw + _i * 8192), 16, 0, 0); } while (0)
#define PG8_LDA(dst, b, h) do { _Pragma("unroll") for (int m = 0; m < 4; ++m) _Pragma("unroll") for (int k = 0; k < 2; ++k) dst[m][k] = *(const LAS bf16x8*)(lds + PG8_SA(b, h) + aoff + m * 2048 + k * 1024); } while (0)
#define PG8_LDB(dst, b, h) do { _Pragma("unroll") for (int n = 0; n < 2; ++n) _Pragma("unroll") for (int k = 0; k < 2; ++k) dst[n][k] = *(const LAS bf16x8*)(lds + PG8_SB(b, h) + boff + n * 2048 + k * 1024); } while (0)
#define PG8_MMA(ai, bj, At, Bt) do { __builtin_amdgcn_s_setprio(1); _Pragma("unroll") for (int m = 0; m < 4; ++m) _Pragma("unroll") for (int n = 0; n < 2; ++n) _Pragma("unroll") for (int k = 0; k < 2; ++k) \
        acc[ai][bj][m][n] = __builtin_amdgcn_mfma_f32_16x16x32_bf16(Bt[n][k], At[m][k], acc[ai][bj][m][n], 0, 0, 0); __builtin_amdgcn_s_setprio(0); } while (0)
#define PG8_WAIT_V(n) asm volatile("s_waitcnt vmcnt(" #n ")" ::: "memory")
#define PG8_WAIT_L(n) asm volatile("s_waitcnt lgkmcnt(" #n ")" ::: "memory")
#define PG8_BAR __builtin_amdgcn_s_barrier()
#define PG8_SCHED __builtin_amdgcn_sched_barrier(0)
    Unit cur, nxt; int ui = 0;
    if (!S.next(0, cur)) return;
    f32x4 acc[2][2][4][2];
#pragma unroll
    for (int a = 0; a < 2; ++a)
#pragma unroll
        for (int b = 0; b < 2; ++b)
#pragma unroll
            for (int m = 0; m < 4; ++m)
#pragma unroll
                for (int n = 0; n < 2; ++n) acc[a][b][m][n] = (f32x4){0.f, 0.f, 0.f, 0.f};
    bf16x8 At[4][2], B0[2][2], B1[2][2];
    const char* cA = (const char*)g.A + (size_t)cur.pm * tstep + (size_t)cur.kt0 * kstep; const char* cB = (const char*)g.Bt + (size_t)cur.pn * tstep + (size_t)cur.kt0 * kstep;
    S.a_ready(cur);
    if constexpr (SP2) {
        PG8_STAGE(PG8_SB(0, 0), cB, voffB); PG8_STAGE(PG8_SB(0, 1), cB + hstep, voffB); PG8_STAGE(PG8_SA(0, 0), cA, voffA); PG8_STAGE(PG8_SA(0, 1), cA + hstep, voffA);
        if (wr == 1) PG8_BAR;
        PG8_WAIT_V(2); PG8_BAR;
        PG8_STAGE(PG8_SB(1, 0), cB + kstep, voffB); PG8_STAGE(PG8_SA(1, 0), cA + kstep, voffA); PG8_STAGE(PG8_SB(1, 1), cB + hstep + kstep, voffB);
        PG8_WAIT_V(6); PG8_BAR;
    } else {
        PG8_STAGE(PG8_SB(0, 0), cB, voffB); PG8_STAGE(PG8_SA(0, 0), cA, voffA); PG8_STAGE(PG8_SB(0, 1), cB + hstep, voffB); PG8_STAGE(PG8_SA(0, 1), cA + hstep, voffA);
        if (wr == 1) PG8_BAR;
        PG8_WAIT_V(4); PG8_BAR;
        PG8_STAGE(PG8_SB(1, 0), cB + kstep, voffB); PG8_STAGE(PG8_SA(1, 0), cA + kstep, voffA); PG8_STAGE(PG8_SB(1, 1), cB + hstep + kstep, voffB);
        PG8_WAIT_V(6); PG8_BAR;
    }
    for (;;) {
        const bool has_next = S.next(ui + 1, nxt);
        const char* nA = has_next ? (const char*)g.A + (size_t)nxt.pm * tstep + (size_t)nxt.kt0 * kstep : cA; const char* nB = has_next ? (const char*)g.Bt + (size_t)nxt.pn * tstep + (size_t)nxt.kt0 * kstep : cB;
        const int nt = cur.nt;
        for (int t = 0; t < nt; t += 2) {
            const bool last = (t == nt - 2);
            const char* a1 = cA + (size_t)(t + 1) * kstep;
            const char* a2 = last ? nA : cA + (size_t)(t + 2) * kstep; const char* b2 = last ? nB : cB + (size_t)(t + 2) * kstep;
            const char* a3 = a2 + kstep; const char* b3 = b2 + kstep;
            if (last && has_next) S.a_ready(nxt);
            if constexpr (SP2) {
            PG8_LDB(B0, 0, 0); PG8_LDB(B1, 0, 1); PG8_SCHED; PG8_LDA(At, 0, 0); PG8_STAGE(PG8_SA(1, 1), a1 + hstep, voffA);
            PG8_WAIT_V(8); PG8_WAIT_L(0); PG8_BAR; PG8_MMA(0, 0, At, B0); PG8_MMA(0, 1, At, B1); PG8_BAR; PG8_SCHED;
            PG8_LDA(At, 0, 1); PG8_STAGE(PG8_SB(0, 0), b2, voffB); PG8_STAGE(PG8_SB(0, 1), b2 + hstep, voffB); PG8_STAGE(PG8_SA(0, 0), a2, voffA);
            PG8_WAIT_V(8); PG8_WAIT_L(0); PG8_BAR; PG8_MMA(1, 0, At, B0); PG8_MMA(1, 1, At, B1); PG8_BAR; PG8_SCHED;
            PG8_LDB(B0, 1, 0); PG8_LDB(B1, 1, 1); PG8_SCHED; PG8_LDA(At, 1, 0); PG8_STAGE(PG8_SA(0, 1), a2 + hstep, voffA);
            PG8_WAIT_V(8); PG8_WAIT_L(0); PG8_BAR; PG8_MMA(0, 0, At, B0); PG8_MMA(0, 1, At, B1); PG8_BAR; PG8_SCHED;
            PG8_LDA(At, 1, 1); PG8_STAGE(PG8_SB(1, 0), b3, voffB); PG8_STAGE(PG8_SB(1, 1), b3 + hstep, voffB); PG8_STAGE(PG8_SA(1, 0), a3, voffA);
            PG8_WAIT_V(8); PG8_WAIT_L(0); PG8_BAR; PG8_MMA(1, 0, At, B0); PG8_MMA(1, 1, At, B1); PG8_BAR; PG8_SCHED;
            } else {
            PG8_LDB(B0, 0, 0); PG8_SCHED; PG8_LDA(At, 0, 0); PG8_STAGE(PG8_SA(1, 1), a1 + hstep, voffA);
            PG8_WAIT_L(8); PG8_BAR; PG8_WAIT_L(0); PG8_MMA(0, 0, At, B0); PG8_BAR; PG8_SCHED;
            PG8_LDB(B1, 0, 1); PG8_STAGE(PG8_SB(0, 0), b2, voffB);
            PG8_BAR; PG8_WAIT_L(0); PG8_MMA(0, 1, At, B1); PG8_BAR;
            PG8_LDA(At, 0, 1); PG8_STAGE(PG8_SA(0, 0), a2, voffA);
            PG8_BAR; PG8_WAIT_L(0); PG8_MMA(1, 0, At, B0); PG8_BAR; PG8_SCHED;
            PG8_STAGE(PG8_SB(0, 1), b2 + hstep, voffB);
            PG8_WAIT_V(6); PG8_BAR; PG8_MMA(1, 1, At, B1); PG8_BAR;
            PG8_LDB(B0, 1, 0); PG8_SCHED; PG8_LDA(At, 1, 0); PG8_STAGE(PG8_SA(0, 1), a2 + hstep, voffA);
            PG8_WAIT_L(8); PG8_BAR; PG8_WAIT_L(0); PG8_MMA(0, 0, At, B0); PG8_BAR; PG8_SCHED;
            PG8_LDB(B1, 1, 1); PG8_STAGE(PG8_SB(1, 0), b3, voffB);
            PG8_BAR; PG8_WAIT_L(0); PG8_MMA(0, 1, At, B1); PG8_BAR;
            PG8_LDA(At, 1, 1); PG8_STAGE(PG8_SA(1, 0), a3, voffA);
            PG8_BAR; PG8_WAIT_L(0); PG8_MMA(1, 0, At, B0); PG8_BAR; PG8_SCHED;
            PG8_STAGE(PG8_SB(1, 1), b3 + hstep, voffB);
            PG8_WAIT_V(6); PG8_BAR; PG8_MMA(1, 1, At, B1); PG8_BAR;
            }
        }
        if constexpr (ALIGN_EPI) { if (wr == 0) PG8_BAR; }
        if constexpr (!Epi::AFTER_DRAIN) { E(acc, cur, wr, wc, fr, fq); S.done(cur); }
        if (!has_next) break;
#pragma unroll
        for (int a = 0; a < 2; ++a)
#pragma unroll
            for (int b = 0; b < 2; ++b)
#pragma unroll
                for (int m = 0; m < 4; ++m)
#pragma unroll
                    for (int n = 0; n < 2; ++n) acc[a][b][m][n] = (f32x4){0.f, 0.f, 0.f, 0.f};
        cur = nxt; cA = nA; cB = nB; ++ui;
        if constexpr (ALIGN_EPI) { if (wr == 1) PG8_BAR; }
    }
    PG8_WAIT_V(0);
    if constexpr (!ALIGN_EPI) { if (wr == 0) PG8_BAR; }
    PG8_BAR;
#undef PG8_SA
#undef PG8_SB
#undef PG8_STAGE
#undef PG8_LDA
#undef PG8_LDB
#undef PG8_MMA
#undef PG8_WAIT_V
#undef PG8_WAIT_L
#undef PG8_BAR
#undef PG8_SCHED
}
}

constexpr size_t MiB = 1u << 20;
constexpr size_t WS_WIN = 1 * MiB, WS_WOUT = 33 * MiB, WS_WKV = 41 * MiB, WS_WQ = 43 * MiB, WS_WAO = 51 * MiB, WS_WGU0 = 59 * MiB, WS_WGU1 = 103 * MiB,
                 WS_WD0 = 147 * MiB, WS_WD1 = 169 * MiB, WS_ROPE = 191 * MiB, WS_XN = 192 * MiB, WS_Y = 226 * MiB, WS_O2 = 294 * MiB, WS_R1 = 328 * MiB;
constexpr size_t WS_GQT = 192 * MiB, WS_GKH = 224 * MiB, WS_GVT = 256 * MiB;
constexpr size_t WS_GPS = WS_R1 + 34 * MiB, WS_GDEC = WS_R1 + 42 * MiB;
constexpr size_t WS_QS = WS_R1, WS_VB = WS_R1 + 68 * MiB, WS_SG = WS_R1 + 102 * MiB, WS_LOGF = WS_R1 + 136 * MiB;
constexpr size_t WS_HACT = WS_R1;
constexpr size_t WS_XKV = WS_R1, WS_QR = WS_R1 + 34 * MiB, WS_KB = WS_R1 + 68 * MiB, WS_VKV = WS_R1 + 73 * MiB;
constexpr size_t WS_SLAB = WS_R1 + 204 * MiB;
constexpr size_t WS_END = WS_SLAB + 32 * MiB;
constexpr size_t WS_HB = WS_LOGF;
constexpr size_t WS_CNT = 65536;
constexpr size_t OUT_Y = 0, OUT_SP = (size_t)M * D, OUT_SS = OUT_SP + 4 * 16 * 16384, OUT_KWIN = OUT_SS + (size_t)128 * 16 * 16384, OUT_VWIN = OUT_KWIN + 131072,
                 OUT_KNEW = OUT_VWIN + 131072, OUT_VNEW = OUT_KNEW + 131072, OUT_END = OUT_VNEW + 131072;

constexpr int LDS_BYTES = 147456;
constexpr int NWAVES = 8;

template <bool GU> __device__ __forceinline__ void p0_transpose_item(const float* W, int K, int N, bf16_t* WT, LAS float* scr, int item, int lane) {
    const int nblk = N / 32, kb = item / nblk, nb = item % nblk, k0 = 64 * kb, n0 = 32 * nb;
    f32x4 wv[8];
#pragma unroll
    for (int i = 0; i < 8; ++i) wv[i] = *(const f32x4*)(W + (size_t)(k0 + 8 * i + (lane >> 3)) * N + n0 + 4 * (lane & 7));
#pragma unroll
    for (int i = 0; i < 8; ++i) { LAS float* d = scr + (8 * i + (lane >> 3)) * 33 + 4 * (lane & 7); d[0] = wv[i][0]; d[1] = wv[i][1]; d[2] = wv[i][2]; d[3] = wv[i][3]; }
    asm volatile("s_waitcnt lgkmcnt(0)" ::: "memory");
    int r0 = n0;
    if (GU) { const int half = n0 >= DFF ? 1 : 0, rem = n0 - half * DFF; r0 = (rem >> 7) * 256 + half * 128 + (rem & 127); }
    const int c = lane & 7;
#pragma unroll
    for (int j = 0; j < 4; ++j) { const int n = (lane >> 3) + 8 * j; const LAS float* s = scr + (8 * c) * 33 + n;
        u32x4 o; o.x = pk2(s[0 * 33], s[1 * 33]); o.y = pk2(s[2 * 33], s[3 * 33]); o.z = pk2(s[4 * 33], s[5 * 33]); o.w = pk2(s[6 * 33], s[7 * 33]);
        *(u32x4*)(WT + (size_t)(r0 + n) * K + k0 + 8 * c) = o; }
    asm volatile("s_waitcnt lgkmcnt(0)" ::: "memory");
}

template <bool HASY, bool HASA, bool HASB, bool XIN, bool HOUT16>
__device__ __forceinline__ void row_phase(const float* xp, const float* xs, const bf16_t* Hin, const bf16_t* Y, const float* gpost, bf16_t* Hout16, float* Hout32,
                                          const float* gA, bf16_t* outA, const float* gB, bf16_t* outB, int gw, int NGW, int lane) {
    f32x4 gp[8], ga[8], gb[8];
#pragma unroll
    for (int j = 0; j < 8; ++j) { if (HASY) gp[j] = ((const f32x4*)gpost + lane)[64 * j]; if (HASA) ga[j] = ((const f32x4*)gA + lane)[64 * j]; if (HASB) gb[j] = ((const f32x4*)gB + lane)[64 * j]; }
    f32x4 hf[8]; u32x2 hh[8], yw[8];
#define ROW_LOAD(m_) do { const int mm = (m_); \
        if (XIN) { const f32x4* hr = (const f32x4*)(mm < NPROMPT ? xp + (size_t)mm * D : xs + (size_t)(mm - NPROMPT) * D) + lane; _Pragma("unroll") for (int j = 0; j < 8; ++j) hf[j] = hr[64 * j]; } \
        else { const u32x2* hr = (const u32x2*)(Hin + (size_t)mm * D) + lane; _Pragma("unroll") for (int j = 0; j < 8; ++j) hh[j] = hr[64 * j]; } \
        if (HASY) { const u32x2* yr = (const u32x2*)(Y + (size_t)mm * D) + lane; _Pragma("unroll") for (int j = 0; j < 8; ++j) yw[j] = yr[64 * j]; } } while (0)
    if (gw < M) ROW_LOAD(gw);
    for (int m = gw; m < M; m += NGW) {
        f32x4 h[8], y[8];
#pragma unroll
        for (int j = 0; j < 8; ++j) {
            h[j] = XIN ? hf[j] : (f32x4){bf2f(hh[j].x & 0xffffu), __uint_as_float(hh[j].x & 0xffff0000u), bf2f(hh[j].y & 0xffffu), __uint_as_float(hh[j].y & 0xffff0000u)};
            if (HASY) y[j] = (f32x4){bf2f(yw[j].x & 0xffffu), __uint_as_float(yw[j].x & 0xffff0000u), bf2f(yw[j].y & 0xffffu), __uint_as_float(yw[j].y & 0xffff0000u)};
        }
        if (m + NGW < M) ROW_LOAD(m + NGW);
        if (HASY) {
            float ss = 0.f;
#pragma unroll
            for (int j = 0; j < 8; ++j) ss += (y[j].x * y[j].x + y[j].y * y[j].y) + (y[j].z * y[j].z + y[j].w * y[j].w);
            const float rstd = rsqrtf(wave_sum(ss) * (1.0f / D) + EPS);
#pragma unroll
            for (int j = 0; j < 8; ++j) { h[j] = h[j] + y[j] * rstd * gp[j];
                if (HOUT16) { u32x2 w; w.x = pk2(h[j].x, h[j].y); w.y = pk2(h[j].z, h[j].w); ((u32x2*)(Hout16 + (size_t)m * D) + lane)[64 * j] = w; } else ((f32x4*)(Hout32 + (size_t)m * D) + lane)[64 * j] = h[j]; }
        }
        if (HASA || HASB) {
            float ss = 0.f;
#pragma unroll
            for (int j = 0; j < 8; ++j) ss += (h[j].x * h[j].x + h[j].y * h[j].y) + (h[j].z * h[j].z + h[j].w * h[j].w);
            const float rstd = rsqrtf(wave_sum(ss) * (1.0f / D) + EPS);
            if (HASA) { u32x2* oa = (u32x2*)(outA + (size_t)m * D) + lane;
#pragma unroll
                for (int j = 0; j < 8; ++j) { const f32x4 v = h[j] * rstd * ga[j]; u32x2 w; w.x = pk2(v.x, v.y); w.y = pk2(v.z, v.w); oa[64 * j] = w; } }
            if (HASB) { u32x2* ob = (u32x2*)(outB + (size_t)m * D) + lane;
#pragma unroll
                for (int j = 0; j < 8; ++j) { const f32x4 v = h[j] * rstd * gb[j]; u32x2 w; w.x = pk2(v.x, v.y); w.y = pk2(v.z, v.w); ob[64 * j] = w; } }
        }
    }
#undef ROW_LOAD
}

template <bool GU> __device__ __forceinline__ void cvt_stream(const float* W, int K, int N, bf16_t* WT, LAS float* scr, int first, int stride, int nitems, int lane) {
    if (first >= nitems) return;
    const int nblk = N / 32, lr = lane >> 3, lc = 4 * (lane & 7);
    f32x4 wv[8];
    { const int k0 = 64 * (first / nblk), n0 = 32 * (first % nblk);
#pragma unroll
      for (int i = 0; i < 8; ++i) wv[i] = *(const f32x4*)(W + (size_t)(k0 + 8 * i + lr) * N + n0 + lc); }
    for (int it = first; it < nitems; it += stride) {
        const int k0 = 64 * (it / nblk), n0 = 32 * (it % nblk);
#pragma unroll
        for (int i = 0; i < 8; ++i) { LAS float* d = scr + (8 * i + lr) * 33 + lc; d[0] = wv[i][0]; d[1] = wv[i][1]; d[2] = wv[i][2]; d[3] = wv[i][3]; }
        const int itn = it + stride;
        if (itn < nitems) { const int k1 = 64 * (itn / nblk), n1 = 32 * (itn % nblk);
#pragma unroll
            for (int i = 0; i < 8; ++i) wv[i] = *(const f32x4*)(W + (size_t)(k1 + 8 * i + lr) * N + n1 + lc); }
        asm volatile("s_waitcnt lgkmcnt(0)" ::: "memory");
        int r0 = n0;
        if (GU) { const int half = n0 >= DFF ? 1 : 0, rem = n0 - half * DFF; r0 = (rem >> 7) * 256 + half * 128 + (rem & 127); }
        const int c = lane & 7;
#pragma unroll
        for (int j = 0; j < 4; ++j) { const int n = (lane >> 3) + 8 * j; const LAS float* sp = scr + (8 * c) * 33 + n;
            u32x4 o; o.x = pk2(sp[0 * 33], sp[1 * 33]); o.y = pk2(sp[2 * 33], sp[3 * 33]); o.z = pk2(sp[4 * 33], sp[5 * 33]); o.w = pk2(sp[6 * 33], sp[7 * 33]);
            *(u32x4*)(WT + (size_t)(r0 + n) * K + k0 + 8 * c) = o; }
        asm volatile("s_waitcnt lgkmcnt(0)" ::: "memory");
    }
}

template <bool HASY, bool HASA, bool HASB, bool HIN16 = false, bool HOUT16 = false>
__device__ __forceinline__ void row_pass(const void* hin, const bf16_t* Yrow, const float* gpost, void* hout, const float* gA, bf16_t* outA, const float* gB, bf16_t* outB, int lane) {
    f32x4 h[8], gp[8], ga[8], gb[8]; u32x2 yw[8];
    if (HIN16) { const u32x2* hr = (const u32x2*)hin + lane;
#pragma unroll
        for (int j = 0; j < 8; ++j) { const u32x2 hw = hr[64 * j]; h[j] = (f32x4){bf2f(hw.x & 0xffffu), __uint_as_float(hw.x & 0xffff0000u), bf2f(hw.y & 0xffffu), __uint_as_float(hw.y & 0xffff0000u)}; }
    } else { const f32x4* hr = (const f32x4*)hin + lane;
#pragma unroll
        for (int j = 0; j < 8; ++j) h[j] = hr[64 * j];
    }
    if (HASY) {
#pragma unroll
        for (int j = 0; j < 8; ++j) { yw[j] = ((const u32x2*)Yrow + lane)[64 * j]; gp[j] = ((const f32x4*)gpost + lane)[64 * j]; }
    }
    if (HASA) {
#pragma unroll
        for (int j = 0; j < 8; ++j) ga[j] = ((const f32x4*)gA + lane)[64 * j];
    }
    if (HASB) {
#pragma unroll
        for (int j = 0; j < 8; ++j) gb[j] = ((const f32x4*)gB + lane)[64 * j];
    }
    if (HASY) {
        f32x4 y[8]; float ss = 0.f;
#pragma unroll
        for (int j = 0; j < 8; ++j) { y[j] = (f32x4){bf2f(yw[j].x & 0xffffu), __uint_as_float(yw[j].x & 0xffff0000u), bf2f(yw[j].y & 0xffffu), __uint_as_float(yw[j].y & 0xffff0000u)}; ss += (y[j].x * y[j].x + y[j].y * y[j].y) + (y[j].z * y[j].z + y[j].w * y[j].w); }
        const float rstd = rsqrtf(wave_sum(ss) * (1.0f / D) + EPS);
#pragma unroll
        for (int j = 0; j < 8; ++j) { h[j] = h[j] + y[j] * rstd * gp[j];
            if (HOUT16) { u32x2 w; w.x = pk2(h[j].x, h[j].y); w.y = pk2(h[j].z, h[j].w); ((u32x2*)hout + lane)[64 * j] = w; } else ((f32x4*)hout + lane)[64 * j] = h[j]; }
    }
    if (HASA || HASB) {
        float ss = 0.f;
#pragma unroll
        for (int j = 0; j < 8; ++j) ss += (h[j].x * h[j].x + h[j].y * h[j].y) + (h[j].z * h[j].z + h[j].w * h[j].w);
        const float rstd = rsqrtf(wave_sum(ss) * (1.0f / D) + EPS);
        if (HASA) { u32x2* oa = (u32x2*)outA + lane;
#pragma unroll
            for (int j = 0; j < 8; ++j) { const f32x4 v = h[j] * rstd * ga[j]; u32x2 w; w.x = pk2(v.x, v.y); w.y = pk2(v.z, v.w); oa[64 * j] = w; } }
        if (HASB) { u32x2* ob = (u32x2*)outB + lane;
#pragma unroll
            for (int j = 0; j < 8; ++j) { const f32x4 v = h[j] * rstd * gb[j]; u32x2 w; w.x = pk2(v.x, v.y); w.y = pk2(v.z, v.w); ob[64 * j] = w; } }
    }
}

#define LDS_BARRIER() do { asm volatile("s_waitcnt lgkmcnt(0)" ::: "memory"); __builtin_amdgcn_s_barrier(); asm volatile("" ::: "memory"); } while (0)
namespace gla {
constexpr int QT_OFF = 0, TOK_STRIDE = 272;
constexpr int KT_OFF = 64 * 272;
constexpr int KH_OFF = 2 * 64 * 272, CH_STRIDE = 144;
constexpr int VT_OFF = KH_OFF + 128 * 144;
constexpr int DEC_OFF = VT_OFF + 128 * 144;
constexpr int OS_OFF = DEC_OFF + 1024, OS_STRIDE = 528;
constexpr int END = OS_OFF + 64 * 528;
static_assert(END <= 131072, "gla lds");
struct P { const bf16_t* Qs; const float* LOGF; const bf16_t* Vb; const bf16_t* SG; const float* gnorm; bf16_t* O2;
           unsigned char* G_QT; unsigned char* G_KH; unsigned char* G_VT; unsigned char* G_PS; unsigned char* G_DEC; };

__device__ __forceinline__ bf16x8 mk8(u32x2 lo, u32x2 hi) { u32x4 t; t.x = lo.x; t.y = lo.y; t.z = hi.x; t.w = hi.y; return __builtin_bit_cast(bf16x8, t); }
__device__ __forceinline__ bf16x8 pk8(f32x4 a, f32x4 b) { u32x4 t; t.x = pk2(a[0], a[1]); t.y = pk2(a[2], a[3]); t.z = pk2(b[0], b[1]); t.w = pk2(b[2], b[3]); return __builtin_bit_cast(bf16x8, t); }

__device__ __forceinline__ void intra_items(LAS unsigned char* lds, const P& p, int first, int stride, int nitems) {
    const int tid = threadIdx.x, lane = tid & 63, w = __builtin_amdgcn_readfirstlane(tid >> 6), l16 = lane & 15, g = lane >> 4;
    const int pk = tid & 127, grp = tid >> 7, pc = grp >> 1, hf = grp & 1;
    float lfo[16]; unsigned qv[16], vv[16];
#define GLA_LOAD_RAW(id) do { const int bh_ = (id) >> 5; const size_t R_ = (size_t)(bh_ >> 4) * TP + (size_t)((id) & 31) * 64; const int hc_ = (bh_ & 15) * 128; \
        _Pragma("unroll") for (int i = 0; i < 16; ++i) { const int tok = 16 * grp + i; lfo[i] = p.LOGF[(R_ + tok) * D + hc_ + pk]; \
            qv[i] = (unsigned)p.Qs[(R_ + tok) * D + hc_ + pk]; vv[i] = (unsigned)p.Vb[(R_ + tok) * D + hc_ + pk]; } } while (0)
    if (first < nitems) GLA_LOAD_RAW(first);
    for (int id = first; id < nitems; id += stride) {
        {
            float so = 0.f;
#pragma unroll
            for (int i = 0; i < 16; ++i) so += lfo[i];
            *(LAS float*)(lds + OS_OFF + tid * 4) = so;
            LDS_BARRIER();
            const float sx = *(const LAS float*)(lds + OS_OFF + (tid ^ 128) * 4);
            const float tot = so + sx;
            float b = hf ? sx : 0.f;
            unsigned khp[8], vtp[8]; float khprev = 0.f;
#pragma unroll
            for (int i = 0; i < 16; ++i) {
                const float l = lfo[i];
                b += l;
                const float kk = 1.0f - __expf(l);
                const float bc = fmaxf(b, -80.f);
                const float qq = bf2f(qv[i]) * __expf(bc);
                const float kt = kk * __expf(-bc);
                const float kh = kk * __expf(tot - b);
                const int t = 16 * grp + i;
                *(LAS bf16_t*)(lds + QT_OFF + t * TOK_STRIDE + pk * 2) = (bf16_t)(pk2(qq, 0.f) & 0xffffu);
                *(LAS bf16_t*)(lds + KT_OFF + t * TOK_STRIDE + pk * 2) = (bf16_t)(pk2(kt, 0.f) & 0xffffu);
                if (i & 1) { khp[i >> 1] = pk2(khprev, kh); vtp[i >> 1] = vv[i - 1] | (vv[i] << 16); } else khprev = kh;
            }
            LAS u32x4* khd = (LAS u32x4*)(lds + KH_OFF + pk * CH_STRIDE + grp * 32); LAS u32x4* vtd = (LAS u32x4*)(lds + VT_OFF + pk * CH_STRIDE + grp * 32);
            khd[0] = (u32x4){khp[0], khp[1], khp[2], khp[3]}; khd[1] = (u32x4){khp[4], khp[5], khp[6], khp[7]};
            vtd[0] = (u32x4){vtp[0], vtp[1], vtp[2], vtp[3]}; vtd[1] = (u32x4){vtp[4], vtp[5], vtp[6], vtp[7]};
            if (hf == 0) *(LAS float*)(lds + DEC_OFF + pc * 512 + pk * 4) = __expf(tot);
        }
        LDS_BARRIER();
        if (id + stride < nitems) GLA_LOAD_RAW(id + stride);
        {
            const int c = w >> 2, st = (w >> 1) & 1, tt = w & 1, tb = 32 * c;
            f32x4 a4 = (f32x4){0.f, 0.f, 0.f, 0.f};
#pragma unroll
            for (int ks = 0; ks < 4; ++ks) {
                const bf16x8 a = *(const LAS bf16x8*)(lds + KT_OFF + (tb + 16 * st + l16) * TOK_STRIDE + (32 * ks + 8 * g) * 2);
                const bf16x8 bq = *(const LAS bf16x8*)(lds + QT_OFF + (tb + 16 * tt + l16) * TOK_STRIDE + (32 * ks + 8 * g) * 2);
                a4 = __builtin_amdgcn_mfma_f32_16x16x32_bf16(a, bq, a4, 0, 0, 0);
            }
#pragma unroll
            for (int j = 0; j < 4; ++j) { const int s_ = 16 * st + 4 * g + j, t_ = 16 * tt + l16; a4[j] = s_ <= t_ ? a4[j] : 0.f; }
            u32x2 pw; pw.x = pk2(a4[0], a4[1]); pw.y = pk2(a4[2], a4[3]);
            *(u32x2*)(p.G_PS + (size_t)id * 4096 + w * 512 + lane * 8) = pw;
        }
#pragma unroll
        for (int i = 0; i < 2; ++i) { const int pi = tid + 512 * i;
            *(u32x4*)(p.G_QT + (size_t)id * 16384 + pi * 16) = *(const LAS u32x4*)(lds + QT_OFF + (pi >> 4) * TOK_STRIDE + (pi & 15) * 16);
            *(u32x4*)(p.G_KH + (size_t)id * 16384 + pi * 16) = *(const LAS u32x4*)(lds + KH_OFF + (pi >> 3) * CH_STRIDE + (pi & 7) * 16);
            *(u32x4*)(p.G_VT + (size_t)id * 16384 + pi * 16) = *(const LAS u32x4*)(lds + VT_OFF + (pi >> 3) * CH_STRIDE + (pi & 7) * 16); }
        if (tid < 64) *(u32x4*)(p.G_DEC + (size_t)id * 1024 + tid * 16) = *(const LAS u32x4*)(lds + DEC_OFF + tid * 16);
        LDS_BARRIER();
    }
#undef GLA_LOAD_RAW
}

__device__ __forceinline__ void scan_seq(LAS unsigned char* lds, const P& p, int bh, float* Sout, int nsc) {
    const int tid = threadIdx.x, lane = tid & 63, w = __builtin_amdgcn_readfirstlane(tid >> 6), l16 = lane & 15, g = lane >> 4;
    const int pt = tid >> 3, pp = tid & 7;
    const int hc = (bh & 15) * 128; const size_t row0 = (size_t)(bh >> 4) * TP;
    if (tid < 128) *(LAS float*)(lds + END + tid * 4) = p.gnorm[hc + tid];
    f32x4 S[8];
#pragma unroll
    for (int i = 0; i < 8; ++i) S[i] = (f32x4){0.f, 0.f, 0.f, 0.f};
    u32x4 rq[2], rk[2], rv[2], rd, rp;
    u32x4 sg0, sg1, sg0n = (u32x4){0u, 0u, 0u, 0u}, sg1n = sg0n;
#define SCAN_LOAD(sc) do { const size_t id_ = (size_t)bh * 32 + ((sc) & 31); \
        _Pragma("unroll") for (int i = 0; i < 2; ++i) { const int pi = tid + 512 * i; rq[i] = *(const u32x4*)(p.G_QT + id_ * 16384 + pi * 16); rk[i] = *(const u32x4*)(p.G_KH + id_ * 16384 + pi * 16); rv[i] = *(const u32x4*)(p.G_VT + id_ * 16384 + pi * 16); } \
        rd = *(const u32x4*)(p.G_DEC + id_ * 1024 + (tid & 63) * 16); rp = *(const u32x4*)(p.G_PS + id_ * 4096 + (tid & 255) * 16); } while (0)
    { const u32x4* sgp = (const u32x4*)(p.SG + (row0 + pt) * D + hc + 16 * pp); sg0 = sgp[0]; sg1 = sgp[1]; }
    SCAN_LOAD(0);
    for (int scx = 0; scx < nsc; ++scx) {
        const int sc = scx & 31;
        const size_t R = row0 + (size_t)sc * 64;
#pragma unroll
        for (int i = 0; i < 2; ++i) { const int pi = tid + 512 * i;
            *(LAS u32x4*)(lds + QT_OFF + (pi >> 4) * TOK_STRIDE + (pi & 15) * 16) = rq[i];
            *(LAS u32x4*)(lds + KH_OFF + (pi >> 3) * CH_STRIDE + (pi & 7) * 16) = rk[i];
            *(LAS u32x4*)(lds + VT_OFF + (pi >> 3) * CH_STRIDE + (pi & 7) * 16) = rv[i]; }
        if (tid < 64) *(LAS u32x4*)(lds + DEC_OFF + tid * 16) = rd;
        if (tid < 256) *(LAS u32x4*)(lds + KT_OFF + tid * 16) = rp;
        LDS_BARRIER();
        if (scx + 1 < nsc) { const u32x4* sgp = (const u32x4*)(p.SG + (row0 + (size_t)((scx + 1) & 31) * 64 + pt) * D + hc + 16 * pp); sg0n = sgp[0]; sg1n = sgp[1]; SCAN_LOAD(scx + 1); }
#pragma unroll
        for (int c = 0; c < 2; ++c) {
            const int tb = 32 * c;
            const LAS unsigned char* vrow = lds + VT_OFF + (16 * w + l16) * CH_STRIDE + (tb + 4 * g) * 2;
            const bf16x8 vfrag = mk8(*(const LAS u32x2*)vrow, *(const LAS u32x2*)(vrow + 32));
            bf16x8 pf[2], bq[2][4], ka[8]; f32x4 d4[8];
#pragma unroll
            for (int tt = 0; tt < 2; ++tt) {
                pf[tt] = mk8(*(const LAS u32x2*)(lds + KT_OFF + ((c * 4 + tt) * 64 + lane) * 8), *(const LAS u32x2*)(lds + KT_OFF + ((c * 4 + 2 + tt) * 64 + lane) * 8));
#pragma unroll
                for (int j2 = 0; j2 < 4; ++j2) { const LAS unsigned char* qrow = lds + QT_OFF + (tb + 16 * tt + l16) * TOK_STRIDE + (32 * j2 + 4 * g) * 2;
                    bq[tt][j2] = mk8(*(const LAS u32x2*)qrow, *(const LAS u32x2*)(qrow + 32)); }
            }
#pragma unroll
            for (int i = 0; i < 8; ++i) { d4[i] = *(const LAS f32x4*)(lds + DEC_OFF + c * 512 + (16 * i + 4 * g) * 4);
                const LAS unsigned char* krow = lds + KH_OFF + (16 * i + l16) * CH_STRIDE + (tb + 4 * g) * 2; ka[i] = mk8(*(const LAS u32x2*)krow, *(const LAS u32x2*)(krow + 32)); }
            bf16x8 sa[4];
#pragma unroll
            for (int j2 = 0; j2 < 4; ++j2) sa[j2] = pk8(S[2 * j2], S[2 * j2 + 1]);
            const f32x4 z4 = (f32x4){0.f, 0.f, 0.f, 0.f};
            f32x4 oa0 = __builtin_amdgcn_mfma_f32_16x16x32_bf16(vfrag, pf[0], z4, 0, 0, 0);
            f32x4 oa1 = __builtin_amdgcn_mfma_f32_16x16x32_bf16(vfrag, pf[1], z4, 0, 0, 0);
            f32x4 ob0 = __builtin_amdgcn_mfma_f32_16x16x32_bf16(sa[1], bq[0][1], z4, 0, 0, 0);
            f32x4 ob1 = __builtin_amdgcn_mfma_f32_16x16x32_bf16(sa[1], bq[1][1], z4, 0, 0, 0);
            oa0 = __builtin_amdgcn_mfma_f32_16x16x32_bf16(sa[0], bq[0][0], oa0, 0, 0, 0);
            oa1 = __builtin_amdgcn_mfma_f32_16x16x32_bf16(sa[0], bq[1][0], oa1, 0, 0, 0);
            ob0 = __builtin_amdgcn_mfma_f32_16x16x32_bf16(sa[3], bq[0][3], ob0, 0, 0, 0);
            ob1 = __builtin_amdgcn_mfma_f32_16x16x32_bf16(sa[3], bq[1][3], ob1, 0, 0, 0);
            oa0 = __builtin_amdgcn_mfma_f32_16x16x32_bf16(sa[2], bq[0][2], oa0, 0, 0, 0);
            oa1 = __builtin_amdgcn_mfma_f32_16x16x32_bf16(sa[2], bq[1][2], oa1, 0, 0, 0);
#pragma unroll
            for (int i = 0; i < 8; ++i) S[i] = __builtin_amdgcn_mfma_f32_16x16x32_bf16(ka[i], vfrag, S[i] * d4[i], 0, 0, 0);
            *(LAS f32x4*)(lds + OS_OFF + (tb + l16) * OS_STRIDE + (16 * w + 4 * g) * 4) = oa0 + ob0;
            *(LAS f32x4*)(lds + OS_OFF + (tb + 16 + l16) * OS_STRIDE + (16 * w + 4 * g) * 4) = oa1 + ob1;
        }
        LDS_BARRIER();
        {
            const LAS f32x4* op = (const LAS f32x4*)(lds + OS_OFF + pt * OS_STRIDE + pp * 64);
            f32x4 o[4]; float ss = 0.f;
#pragma unroll
            for (int q = 0; q < 4; ++q) { o[q] = op[q]; ss += (o[q].x * o[q].x + o[q].y * o[q].y) + (o[q].z * o[q].z + o[q].w * o[q].w); }
            ss += __shfl_xor(ss, 1); ss += __shfl_xor(ss, 2); ss += __shfl_xor(ss, 4);
            const float rstd = rsqrtf(ss * (1.0f / 128.0f) + EPS);
            const unsigned sgw[8] = {sg0.x, sg0.y, sg0.z, sg0.w, sg1.x, sg1.y, sg1.z, sg1.w};
            unsigned ow[8];
#pragma unroll
            for (int q = 0; q < 4; ++q) {
                const f32x4 v = o[q] * rstd * *(const LAS f32x4*)(lds + END + (16 * pp + 4 * q) * 4);
                ow[2 * q] = pk2(v.x * bf2f(sgw[2 * q] & 0xffffu), v.y * bf2f(sgw[2 * q] >> 16));
                ow[2 * q + 1] = pk2(v.z * bf2f(sgw[2 * q + 1] & 0xffffu), v.w * bf2f(sgw[2 * q + 1] >> 16));
            }
            u32x4* od = (u32x4*)(p.O2 + (R + pt) * D + hc + 16 * pp);
            od[0] = (u32x4){ow[0], ow[1], ow[2], ow[3]}; od[1] = (u32x4){ow[4], ow[5], ow[6], ow[7]};
        }
        sg0 = sg0n; sg1 = sg1n;
    }
#undef SCAN_LOAD
#pragma unroll
    for (int i = 0; i < 8; ++i)
#pragma unroll
        for (int j = 0; j < 4; ++j) Sout[(size_t)(16 * i + 4 * g + j) * 128 + 16 * w + l16] = S[i][j];
}

constexpr int DF_OFF = 0, DK_OFF = 2048, DQ_OFF = 4096, DV_OFF = 6144, DR_OFF = 8192, DW_OFF = 16384;
__device__ __forceinline__ void decode_items(LAS unsigned char* lds, const P& p, const float* state_in, float* state_out, int first, int stride, int nitems) {
    const int tid = threadIdx.x, lane = tid & 63, w = __builtin_amdgcn_readfirstlane(tid >> 6);
    const int v = tid & 127, kg = tid >> 7;
    float sA[32], sB[32];
    float lA = 0.f, gA = 0.f, lB = 0.f, gB = 0.f; unsigned qA = 0u, vA = 0u, sgA = 0u, qB = 0u, vB = 0u, sgB = 0u;
#define DEC_PREFETCH(itn_, s, c_l, c_q, c_v, c_sg, c_gn) do { const int itn = (itn_) & (BS * 16 - 1); \
        _Pragma("unroll") for (int q = 0; q < 4; ++q) { const float* sp = state_in + (size_t)itn * 16384 + (size_t)(32 * kg + 8 * q) * 128 + v; \
            _Pragma("unroll") for (int i = 0; i < 8; ++i) s[8 * q + i] = sp[i * 128]; } \
        const int hc_ = (itn & 15) * 128; const size_t off_ = ((size_t)NPROMPT + 4 * (itn >> 4) + kg) * D + hc_ + v; \
        c_l = p.LOGF[off_]; c_q = (unsigned)p.Qs[off_]; c_v = (unsigned)p.Vb[off_]; c_sg = (unsigned)p.SG[off_]; c_gn = p.gnorm[hc_ + v]; } while (0)
#define DEC_BODY(itx_, s, c_l, c_q, c_v, c_sg, c_gn) do { const int it = (itx_) & (BS * 16 - 1); \
        const size_t off = ((size_t)NPROMPT + 4 * (it >> 4) + kg) * D + (it & 15) * 128 + v; \
        const float gate = c_gn * bf2f(c_sg); \
        { const float f = __expf(c_l); \
          *(LAS float*)(lds + DF_OFF + tid * 4) = f; *(LAS float*)(lds + DK_OFF + tid * 4) = 1.0f - f; \
          *(LAS float*)(lds + DQ_OFF + tid * 4) = bf2f(c_q); *(LAS float*)(lds + DV_OFF + tid * 4) = bf2f(c_v); } \
        LDS_BARRIER(); \
        _Pragma("unroll 1") for (int t = 0; t < 4; ++t) { \
            const float vt = *(const LAS float*)(lds + DV_OFF + (t * 128 + v) * 4); \
            float a = 0.f; \
            _Pragma("unroll") for (int i4 = 0; i4 < 8; ++i4) { \
                const f32x4 f4 = *(const LAS f32x4*)(lds + DF_OFF + (t * 128 + 32 * kg + 4 * i4) * 4), k4 = *(const LAS f32x4*)(lds + DK_OFF + (t * 128 + 32 * kg + 4 * i4) * 4), \
                            q4 = *(const LAS f32x4*)(lds + DQ_OFF + (t * 128 + 32 * kg + 4 * i4) * 4); \
                _Pragma("unroll") for (int j = 0; j < 4; ++j) { const float sn = f4[j] * s[4 * i4 + j] + k4[j] * vt; s[4 * i4 + j] = sn; a += q4[j] * sn; } \
            } \
            *(LAS float*)(lds + DR_OFF + ((t * 4 + kg) * 128 + v) * 4) = a; \
        } \
        _Pragma("unroll") for (int q = 0; q < 4; ++q) { \
            float* so = state_out + (size_t)it * 16384 + (size_t)(32 * kg + 8 * q) * 128 + v; \
            _Pragma("unroll") for (int i = 0; i < 8; ++i) so[i * 128] = s[8 * q + i]; \
        } \
        if ((itx_) + 2 * stride < nitems) DEC_PREFETCH((itx_) + 2 * stride, s, c_l, c_q, c_v, c_sg, c_gn); \
        LDS_BARRIER(); \
        const LAS float* rr = (const LAS float*)(lds + DR_OFF + (kg * 4 * 128 + v) * 4); \
        const float o = (rr[0] + rr[128]) + (rr[256] + rr[384]); \
        const float ws = wave_sum(o * o); \
        if (lane == 0) *(LAS float*)(lds + DW_OFF + w * 4) = ws; \
        LDS_BARRIER(); \
        const float ss = *(const LAS float*)(lds + DW_OFF + (2 * kg) * 4) + *(const LAS float*)(lds + DW_OFF + (2 * kg + 1) * 4); \
        const float rstd = rsqrtf(ss * (1.0f / 128.0f) + EPS); \
        p.O2[off] = (bf16_t)(pk2(o * rstd * gate, 0.f) & 0xffffu); } while (0)
    if (first < nitems) DEC_PREFETCH(first, sA, lA, qA, vA, sgA, gA);
    if (first + stride < nitems) DEC_PREFETCH(first + stride, sB, lB, qB, vB, sgB, gB);
    for (int itx = first; itx < nitems; itx += 2 * stride) {
        DEC_BODY(itx, sA, lA, qA, vA, sgA, gA);
        if (itx + stride < nitems) DEC_BODY(itx + stride, sB, lB, qB, vB, sgB, gB);
    }
#undef DEC_BODY
#undef DEC_PREFETCH
}
}

namespace att {
constexpr int KS_OFF = 0, KS_STRIDE = 144;
constexpr int VT_OFF = 256 * 144, VT_STRIDE = 528;
struct P { const bf16_t* Qr; const bf16_t* Kb; const bf16_t* Vkv; const float* ck; const float* cv; const float* sinks; bf16_t* O; };

__device__ __forceinline__ void unit(LAS unsigned char* lds, const P& p, bool prompt, int b, int kvh, int qb) {
    const int tid = threadIdx.x, lane = tid & 63, w = __builtin_amdgcn_readfirstlane(tid >> 6), l16 = lane & 15, g = lane >> 4;
    const int h = kvh * 8 + w;
    bf16x8 qn0, qn1;
    { const size_t qrow0 = prompt ? (size_t)(b * TP + 128 * qb + l16) : (size_t)(NPROMPT + 4 * b + min(l16, 3));
      const bf16_t* qp = p.Qr + qrow0 * D + h * 64 + 8 * g; qn0 = *(const bf16x8*)qp; qn1 = *(const bf16x8*)(qp + 32); }
    __syncthreads();
#pragma unroll
    for (int i = 0; i < 4; ++i) {
        const int e = tid + 512 * i;
        {
            const int key = e >> 3, c8 = e & 7; u32x4 kv = (u32x4){0u, 0u, 0u, 0u};
            if (prompt) { if (qb > 0 || key >= 128) kv = *(const u32x4*)(p.Kb + (size_t)(b * TP + 128 * (qb - 1) + key) * 256 + kvh * 64 + c8 * 8); }
            else if (key < 128) { const f32x4* s = (const f32x4*)(p.ck + ((size_t)(b * 128 + key) * 4 + kvh) * 64 + c8 * 8); const f32x4 a = s[0], c = s[1]; kv = (u32x4){pk2(a.x, a.y), pk2(a.z, a.w), pk2(c.x, c.y), pk2(c.z, c.w)}; }
            else if (key < 132) kv = *(const u32x4*)(p.Kb + (size_t)(NPROMPT + 4 * b + key - 128) * 256 + kvh * 64 + c8 * 8);
            if (prompt || key < 160) *(LAS u32x4*)(lds + KS_OFF + key * KS_STRIDE + c8 * 16) = kv;
        }
        {
            const int key = e & 255, c8 = e >> 8; u32x4 vv = (u32x4){0u, 0u, 0u, 0u};
            if (prompt) { if (qb > 0 || key >= 128) vv = *(const u32x4*)(p.Vkv + (size_t)(b * TP + 128 * (qb - 1) + key) * 256 + kvh * 64 + c8 * 8); }
            else if (key < 128) { const f32x4* s = (const f32x4*)(p.cv + ((size_t)(b * 128 + key) * 4 + kvh) * 64 + c8 * 8); const f32x4 a = s[0], c = s[1]; vv = (u32x4){pk2(a.x, a.y), pk2(a.z, a.w), pk2(c.x, c.y), pk2(c.z, c.w)}; }
            else if (key < 132) vv = *(const u32x4*)(p.Vkv + (size_t)(NPROMPT + 4 * b + key - 128) * 256 + kvh * 64 + c8 * 8);
            if (prompt || key < 160) {
                LAS bf16_t* d = (LAS bf16_t*)(lds + VT_OFF + (c8 * 8) * VT_STRIDE + key * 2);
                d[0 * (VT_STRIDE / 2)] = (bf16_t)(vv.x & 0xffffu); d[1 * (VT_STRIDE / 2)] = (bf16_t)(vv.x >> 16);
                d[2 * (VT_STRIDE / 2)] = (bf16_t)(vv.y & 0xffffu); d[3 * (VT_STRIDE / 2)] = (bf16_t)(vv.y >> 16);
                d[4 * (VT_STRIDE / 2)] = (bf16_t)(vv.z & 0xffffu); d[5 * (VT_STRIDE / 2)] = (bf16_t)(vv.z >> 16);
                d[6 * (VT_STRIDE / 2)] = (bf16_t)(vv.w & 0xffffu); d[7 * (VT_STRIDE / 2)] = (bf16_t)(vv.w >> 16);
            }
        }
    }
    __syncthreads();
    const float sink = p.sinks[h];
    const bool hasprev = !prompt || qb > 0;
    const int nqt = prompt ? 8 : 1;
    for (int qt = 0; qt < nqt; ++qt) {
        const int qi = 16 * qt + l16;
        const size_t qrow = prompt ? (size_t)(b * TP + 128 * qb + qi) : (size_t)(NPROMPT + 4 * b + min(l16, 3));
        const bf16x8 qf[2] = {qn0, qn1};
        if (qt + 1 < nqt) { const bf16_t* qp = p.Qr + (qrow + 16) * D + h * 64 + 8 * g; qn0 = *(const bf16x8*)qp; qn1 = *(const bf16x8*)(qp + 32); }
        const int kt0 = 2 * (qt >> 1);
        f32x4 sc[10];
        float mx = -INFINITY;
#pragma unroll
        for (int ti = 0; ti < 10; ++ti) {
            const LAS unsigned char* kr = lds + KS_OFF + (16 * (kt0 + ti) + l16) * KS_STRIDE + 16 * g;
            f32x4 a4 = (f32x4){0.f, 0.f, 0.f, 0.f};
            a4 = __builtin_amdgcn_mfma_f32_16x16x32_bf16(*(const LAS bf16x8*)kr, qf[0], a4, 0, 0, 0);
            a4 = __builtin_amdgcn_mfma_f32_16x16x32_bf16(*(const LAS bf16x8*)(kr + 64), qf[1], a4, 0, 0, 0);
#pragma unroll
            for (int j = 0; j < 4; ++j) {
                const int jk = 16 * (kt0 + ti) + 4 * g + j;
                const bool valid = jk > qi && jk <= qi + 128 && (hasprev || jk >= 128);
                a4[j] = valid ? a4[j] : -INFINITY; mx = fmaxf(mx, a4[j]);
            }
            sc[ti] = a4;
        }
        mx = fmaxf(mx, __shfl_xor(mx, 16)); mx = fmaxf(mx, __shfl_xor(mx, 32)); mx = fmaxf(mx, sink);
        float sum = 0.f;
#pragma unroll
        for (int ti = 0; ti < 10; ++ti)
#pragma unroll
            for (int j = 0; j < 4; ++j) { const float e = __expf(sc[ti][j] - mx); sc[ti][j] = e; sum += e; }
        sum += __shfl_xor(sum, 16); sum += __shfl_xor(sum, 32);
        const float inv = 1.0f / (sum + __expf(sink - mx));
        f32x4 o[4];
#pragma unroll
        for (int dt = 0; dt < 4; ++dt) o[dt] = (f32x4){0.f, 0.f, 0.f, 0.f};
#pragma unroll
        for (int pp = 0; pp < 5; ++pp) {
            const bf16x8 pb = gla::pk8(sc[2 * pp], sc[2 * pp + 1]);
#pragma unroll
            for (int dt = 0; dt < 4; ++dt) {
                const LAS unsigned char* vr = lds + VT_OFF + (16 * dt + l16) * VT_STRIDE + (16 * (kt0 + 2 * pp) + 4 * g) * 2;
                const bf16x8 va = gla::mk8(*(const LAS u32x2*)vr, *(const LAS u32x2*)(vr + 32));
                o[dt] = __builtin_amdgcn_mfma_f32_16x16x32_bf16(va, pb, o[dt], 0, 0, 0);
            }
        }
        if (prompt || l16 < 4) {
#pragma unroll
            for (int dt = 0; dt < 4; ++dt) {
                const f32x4 v = o[dt] * inv; u32x2 wv; wv.x = pk2(v.x, v.y); wv.y = pk2(v.z, v.w);
                *(u32x2*)(p.O + qrow * D + h * 64 + 16 * dt + 4 * g) = wv;
            }
        }
    }
}
}

#define XB_TMO      128
#define XB_XCNT(j)  (256  + 64 * (j))
#define XB_XSUB(j)  (1280 + 64 * (j))
#define XB_XGEN(j)  (2304 + 64 * (j))
#define XB_TOP      3328
#define XB_TOPGEN   3392
#define XCD_BAR_WORDS 3456
#define XB_SPIN_CAP (1u << 18)
__device__ __forceinline__ unsigned xb_ld(unsigned* p)              { return __hip_atomic_load(p, __ATOMIC_RELAXED, __HIP_MEMORY_SCOPE_AGENT); }
__device__ __forceinline__ unsigned xb_add(unsigned* p, unsigned v) { return __hip_atomic_fetch_add(p, v, __ATOMIC_RELAXED, __HIP_MEMORY_SCOPE_AGENT); }
__device__ __forceinline__ unsigned xb_xcc_id() { return (unsigned)__builtin_amdgcn_s_getreg((3 << 11) | 20) & 0xFu; }
#define XB_SPIN(cond, bar) do { unsigned _sp = 0; while (cond) { __builtin_amdgcn_s_sleep(1); \
    if ((++_sp & 255u) == 0u) { if (xb_ld(&(bar)[XB_TMO])) break; if (_sp > XB_SPIN_CAP) { atomicAdd(&(bar)[XB_TMO], 1u); break; } } } } while (0)
struct XcdBarrier { unsigned* bar; unsigned x; volatile LAS unsigned* st; };
__device__ __forceinline__ XcdBarrier xcd_barrier_post(unsigned* bar, volatile LAS unsigned* st) {
    XcdBarrier b; b.bar = bar; b.x = xb_xcc_id(); b.st = st;
    if (threadIdx.x == 0) (void)xb_add(&bar[XB_XCNT(b.x)], 1u);
    return b;
}
__device__ __forceinline__ void xcd_barrier_complete(unsigned* bar, unsigned x, unsigned& nloc, unsigned& nx) {
    const unsigned G = gridDim.x * gridDim.y * gridDim.z;
    unsigned sum, cnt, mine, sp = 0u;
    for (;;) {
        sum = 0u; cnt = 0u; mine = 0u;
#pragma unroll
        for (unsigned j = 0; j < 16; ++j) { const unsigned c = xb_ld(&bar[XB_XCNT(j)]); sum += c; cnt += (c > 0u) ? 1u : 0u; mine = (j == x) ? c : mine; }
        if (sum == G) break;
        __builtin_amdgcn_s_sleep(1);
        if ((++sp & 255u) == 0u) { if (xb_ld(&bar[XB_TMO])) break; if (sp > XB_SPIN_CAP) { atomicAdd(&bar[XB_TMO], 1u); break; } }
    }
    nloc = mine > 0u ? mine : 1u; nx = cnt > 0u ? cnt : 1u;
}
__device__ __forceinline__ void xcd_barrier(const XcdBarrier& b) {
    asm volatile("s_waitcnt vmcnt(0)" ::: "memory");
    __syncthreads();
    if (threadIdx.x == 0) {
        unsigned* bar = b.bar;
        __builtin_amdgcn_s_waitcnt(0);
        unsigned nloc = b.st[0], nx = b.st[1];
        if (nloc == 0u) { xcd_barrier_complete(bar, b.x, nloc, nx); b.st[0] = nloc; b.st[1] = nx; }
        const unsigned old = xb_add(&bar[XB_XSUB(b.x)], 1u);
        const unsigned gen = old / nloc;
        if (old + 1u == (gen + 1u) * nloc) {
            __builtin_amdgcn_fence(__ATOMIC_RELEASE, "agent");
            asm volatile("s_waitcnt vmcnt(0)" ::: "memory");
            const unsigned og = xb_add(&bar[XB_TOP], 1u);
            const unsigned tg = og / nx;
            if (og + 1u == (tg + 1u) * nx) xb_add(&bar[XB_TOPGEN], 1u);
            else XB_SPIN(xb_ld(&bar[XB_TOPGEN]) == tg, bar);
            __builtin_amdgcn_fence(__ATOMIC_ACQUIRE, "agent");
            xb_add(&bar[XB_XGEN(b.x)], 1u);
            asm volatile("s_waitcnt vmcnt(0)" ::: "memory");
        } else {
            XB_SPIN(xb_ld(&bar[XB_XGEN(b.x)]) == gen, bar);
            __builtin_amdgcn_fence(__ATOMIC_ACQUIRE, "agent");
            asm volatile("s_waitcnt vmcnt(0)" ::: "memory");
        }
    }
    __syncthreads();
}

struct Args { const float* in[20]; float* out; unsigned char* ws; int ph_lo, ph_hi; };
constexpr int N_PHASES = 16;

__global__ void __launch_bounds__(NWAVES * 64, 2) mk_fwd(Args args) {
    extern __shared__ __attribute__((aligned(16))) unsigned char lds_raw[];
    LAS unsigned char* lds = (LAS unsigned char*)lds_raw;
    cg::grid_group grid = cg::this_grid();
    const int tid = threadIdx.x, lane = tid & 63, wave = __builtin_amdgcn_readfirstlane(tid >> 6);
    const int G = gridDim.x, cb = blockIdx.x;
    const int gw = cb * NWAVES + wave, NGW = G * NWAVES;
    unsigned char* ws = args.ws;
    const float* x_prompt = args.in[0]; const float* x_sample = args.in[1]; const float* state_in = args.in[2]; const float* cache_k = args.in[3]; const float* cache_v = args.in[4];
    const float* g_mix_pre = args.in[5]; const float* g_mix_post = args.in[6]; const float* g_ffn_pre = args.in[7]; const float* g_ffn_post = args.in[8];
    const float* w_in = args.in[9]; const float* lbraw = args.in[10]; const float* g_hnorm = args.in[11]; const float* w_hout = args.in[12];
    const float* g_kv = args.in[13]; const float* w_kv = args.in[14]; const float* w_q = args.in[15]; const float* sinks = args.in[16]; const float* w_ao = args.in[17];
    const float* w_gu = args.in[18]; const float* w_dn = args.in[19];
    bf16_t* Win_t = (bf16_t*)(ws + WS_WIN); bf16_t* Wout_t = (bf16_t*)(ws + WS_WOUT); bf16_t* Wkv_t = (bf16_t*)(ws + WS_WKV); bf16_t* Wq_t = (bf16_t*)(ws + WS_WQ); bf16_t* Wao_t = (bf16_t*)(ws + WS_WAO);
    bf16_t* Wgu_t[2] = {(bf16_t*)(ws + WS_WGU0), (bf16_t*)(ws + WS_WGU1)}; bf16_t* Wd_t[2] = {(bf16_t*)(ws + WS_WD0), (bf16_t*)(ws + WS_WD1)};
    f32x2* rope = (f32x2*)(ws + WS_ROPE);
    bf16_t* XN = (bf16_t*)(ws + WS_XN); bf16_t* O2 = (bf16_t*)(ws + WS_O2); bf16_t* Y = (bf16_t*)(ws + WS_Y);
    bf16_t* Qs = (bf16_t*)(ws + WS_QS); float* LOGF = (float*)(ws + WS_LOGF); bf16_t* Vb = (bf16_t*)(ws + WS_VB); bf16_t* SG = (bf16_t*)(ws + WS_SG);
    bf16_t* Hact = (bf16_t*)(ws + WS_HACT);
    bf16_t* XKV = (bf16_t*)(ws + WS_XKV); bf16_t* Qr = (bf16_t*)(ws + WS_QR); bf16_t* Kb = (bf16_t*)(ws + WS_KB); bf16_t* Vkv = (bf16_t*)(ws + WS_VKV);
    float* out = args.out; float* H = out + OUT_Y; bf16_t* Hb = (bf16_t*)(ws + WS_HB);
    float* slab = (float*)(ws + WS_SLAB); unsigned* cntw = (unsigned*)(ws + WS_CNT);
    const int lo = args.ph_lo, hi = args.ph_hi;
    LAS float* scr = (LAS float*)(lds + wave * 16384);
    constexpr int I_IN = 32 * 256, I_SQ = 32 * 64, I_KV = 32 * 16, I_GU = 32 * 352, I_DN = 88 * 64;
#define IN(k) (lo <= (k) && (k) < hi)
#define SEAM(k) do { if (IN(k) && IN((k) + 1)) { if (lo < 0) grid.sync(); else xcd_barrier(bar); } } while (0)
    volatile LAS unsigned* MISC = (volatile LAS unsigned*)(lds + 131072 + 320);
    if (tid < 32) MISC[tid] = 0u;
    __syncthreads();
    XcdBarrier bar; bar.bar = (unsigned*)ws; bar.x = 0; bar.st = nullptr;
    if (hi - lo > 1) bar = xcd_barrier_post((unsigned*)ws, MISC + 8);

    if (IN(0)) {
        cvt_stream<false>(w_in, D, 4 * D, Win_t, scr, gw, NGW, I_IN, lane);
        for (int e = cb * 512 + tid; e < (TP + TS) * 8; e += G * 512) {
            const int idx = e >> 3, f = e & 7; const double pos = idx < TP ? (double)idx : (double)(8192 + idx - TP);
            const double invf[8] = {1.0, 0.19392274474868576, 0.03760603093086393, 0.007292664737217109, 0.001414213562373095, 0.0002742481756762073, 5.318295896944988e-05, 1.031338537721246e-05};
            double iv = invf[0];
#pragma unroll
            for (int q = 1; q < 8; ++q) iv = f == q ? invf[q] : iv;
            const double ang = pos * (double)(float)iv;
            const double TWO_PI = 6.283185307179586476925286766559;
            const double r = ang - TWO_PI * __builtin_rint(ang / TWO_PI);
            const double r2 = r * r;
            double sn = 0.0, cs = 0.0;
#pragma unroll
            for (int k = 14; k >= 1; --k) { sn = (1.0 - sn) * r2 / (double)((2 * k) * (2 * k + 1)); cs = (1.0 - cs) * r2 / (double)((2 * k - 1) * (2 * k)); }
            rope[e] = (f32x2){(float)(1.0 - cs), (float)(r * (1.0 - sn))};
        }
        row_phase<false, true, false, true, false>(x_prompt, x_sample, nullptr, nullptr, nullptr, nullptr, nullptr, g_mix_pre, XN, nullptr, nullptr, gw, NGW, lane);
    }
    SEAM(0);
    if (IN(1)) {
        pg8::Gemm g{XN, Win_t, M, 4 * D, D}; pg8::StaticOrder S; S.init(M, 4 * D, G, cb, D);
        pg8::EpiIn E{Qs, LOGF, Vb, SG, lbraw};
        pg8::gemm_phase<pg8::EpiIn, pg8::StaticOrder, true, true>(lds, g, S, E);
        if (cb >= 64) {
            const int wv_ = (cb - 64) * NWAVES + wave;
            if (wv_ < 256) cvt_stream<false>(w_hout, D, D, Wout_t, scr, wv_, 256, I_SQ, lane);
            else if (wv_ < 512) cvt_stream<false>(w_q, D, D, Wq_t, scr, wv_ - 256, 256, I_SQ, lane);
            else if (wv_ < 768) cvt_stream<false>(w_ao, D, D, Wao_t, scr, wv_ - 512, 256, I_SQ, lane);
            else if (wv_ < 832) cvt_stream<false>(w_kv, D, 512, Wkv_t, scr, wv_ - 768, 64, I_KV, lane);
            else cvt_stream<false>(w_dn, DFF, D, Wd_t[0], scr, wv_ - 832, 704, I_DN, lane);
        }
    }
    SEAM(1);
    gla::P gp{Qs, LOGF, Vb, SG, g_hnorm, O2, ws + WS_GQT, ws + WS_GKH, ws + WS_GVT, ws + WS_GPS, ws + WS_GDEC};
    if (IN(2)) {
        gla::intra_items(lds, gp, cb, G, 2048);
    }
    SEAM(2);
    if (IN(3)) {
        const int nA = 64;
        if (cb < nA) gla::scan_seq(lds, gp, cb, out + OUT_SP + (size_t)cb * 16384, 32);
        else {
            gla::decode_items(lds, gp, state_in, out + OUT_SS, cb - nA, G - nA, BS * 16);
            __syncthreads();
            cvt_stream<true>(w_gu, D, 2 * DFF, Wgu_t[0], scr, (cb - nA) * NWAVES + wave, (G - nA) * NWAVES, I_GU, lane);
        }
    }
    SEAM(3);
    if (IN(4)) {
        pg8::Gemm g{O2, Wout_t, M, D, D}; pg8::SplitOrder S; S.init(D, G, cb, D);
        pg8::EpiF32 E{Y, D, slab, cntw + 0 * 1024};
        pg8::gemm_phase<pg8::EpiF32, pg8::SplitOrder, true, true>(lds, g, S, E);
    }
    SEAM(4);
    if (IN(5)) {
        row_phase<true, true, false, true, true>(x_prompt, x_sample, nullptr, Y, g_mix_post, Hb, nullptr, g_ffn_pre, XN, nullptr, nullptr, gw, NGW, lane);
    }
    SEAM(5);
    if (IN(6)) {
        pg8::Gemm g{XN, Wgu_t[0], M, 2 * DFF, D}; pg8::StaticOrder S; S.init(M, 2 * DFF, G, cb, D);
        pg8::EpiSwiGLU E{Hact};
        pg8::gemm_phase<pg8::EpiSwiGLU, pg8::StaticOrder, true, true>(lds, g, S, E);
    }
    SEAM(6);
    if (IN(7)) {
        pg8::Gemm g{Hact, Wd_t[0], M, D, DFF}; pg8::SplitOrder S; S.init(D, G, cb, DFF);
        pg8::EpiF32 E{Y, D, slab, cntw + 1 * 1024};
        pg8::gemm_phase<pg8::EpiF32, pg8::SplitOrder, true, true>(lds, g, S, E);
    }
    SEAM(7);
    if (IN(8)) {
        row_phase<true, true, true, false, true>(nullptr, nullptr, Hb, Y, g_ffn_post, Hb, nullptr, g_mix_pre + D, XN, g_kv, XKV, gw, NGW, lane);
    }
    SEAM(8);
    if (IN(9)) {
        { pg8::Gemm g{XKV, Wkv_t, M, 512, D}; pg8::StaticOrder S; S.init(M, 512, G, cb, D);
          pg8::EpiRope<1> E{Kb, Vkv, rope, out + OUT_KWIN, out + OUT_VWIN, out + OUT_KNEW, out + OUT_VNEW};
          pg8::gemm_phase<pg8::EpiRope<1>, pg8::StaticOrder, true, true>(lds, g, S, E); }
        { pg8::Gemm g{XN, Wq_t, M, D, D}; pg8::StaticOrder S; S.init(M, D, G, (cb + G - (68 % G)) % G, D);
          pg8::EpiRope<0> E{Qr, nullptr, rope, nullptr, nullptr, nullptr, nullptr};
          pg8::gemm_phase<pg8::EpiRope<0>, pg8::StaticOrder, true, true>(lds, g, S, E); }
        if (cb >= 84) {
            const int wv_ = (cb - 84) * NWAVES + wave;
            if (wv_ < 917) cvt_stream<true>(w_gu + (size_t)D * 2 * DFF, D, 2 * DFF, Wgu_t[1], scr, wv_, 917, I_GU, lane);
            else cvt_stream<false>(w_dn + (size_t)DFF * D, DFF, D, Wd_t[1], scr, wv_ - 917, 459, I_DN, lane);
        }
    }
    SEAM(9);
    if (IN(10)) {
        att::P ap{Qr, Kb, Vkv, cache_k, cache_v, sinks, O2};
        for (int u = cb; u < 256 + 512; u += G) {
            if (u < 256) att::unit(lds, ap, true, u >> 6, (u >> 4) & 3, u & 15);
            else { const int v = u - 256; att::unit(lds, ap, false, v >> 2, v & 3, 0); }
        }
    }
    SEAM(10);
    if (IN(11)) {
        pg8::Gemm g{O2, Wao_t, M, D, D}; pg8::SplitOrder S; S.init(D, G, cb, D);
        pg8::EpiF32 E{Y, D, slab, cntw + 2 * 1024};
        pg8::gemm_phase<pg8::EpiF32, pg8::SplitOrder, true, true>(lds, g, S, E);
    }
    SEAM(11);
    if (IN(12)) {
        row_phase<true, true, false, false, true>(nullptr, nullptr, Hb, Y, g_mix_post + D, Hb, nullptr, g_ffn_pre + D, XN, nullptr, nullptr, gw, NGW, lane);
    }
    SEAM(12);
    if (IN(13)) {
        pg8::Gemm g{XN, Wgu_t[1], M, 2 * DFF, D}; pg8::StaticOrder S; S.init(M, 2 * DFF, G, cb, D);
        pg8::EpiSwiGLU E{Hact};
        pg8::gemm_phase<pg8::EpiSwiGLU, pg8::StaticOrder, true, true>(lds, g, S, E);
    }
    SEAM(13);
    if (IN(14)) {
        pg8::Gemm g{Hact, Wd_t[1], M, D, DFF}; pg8::SplitOrder S; S.init(D, G, cb, DFF);
        pg8::EpiF32 E{Y, D, slab, cntw + 3 * 1024};
        pg8::gemm_phase<pg8::EpiF32, pg8::SplitOrder, true, true>(lds, g, S, E);
    }
    SEAM(14);
    if (IN(15)) {
        row_phase<true, false, false, false, false>(nullptr, nullptr, Hb, Y, g_ffn_post + D, nullptr, H, nullptr, nullptr, nullptr, nullptr, gw, NGW, lane);
    }
#undef IN
#undef SEAM
}

extern "C" void kernel_launch(void* const* d_in, const int* in_sizes, int n_in, void* d_out, int out_size, void* d_ws, size_t ws_size, hipStream_t stream) {
    static int grid = 0;
    if (grid == 0) {
        if (n_in != 20 || (size_t)out_size != OUT_END || ws_size < WS_END) { fprintf(stderr, "kernel_launch: unexpected shapes: n_in %d out %d ws %zu (need %zu)\n", n_in, out_size, ws_size, (size_t)WS_END); grid = -1; return; }
        int dev = 0, cus = 0, per_cu = 0;
        hipGetDevice(&dev); hipDeviceGetAttribute(&cus, hipDeviceAttributeMultiprocessorCount, dev);
        if (hipFuncSetAttribute((const void*)mk_fwd, hipFuncAttributeMaxDynamicSharedMemorySize, LDS_BYTES) != hipSuccess) { fprintf(stderr, "kernel_launch: hipFuncSetAttribute failed\n"); grid = -1; return; }
        hipOccupancyMaxActiveBlocksPerMultiprocessor(&per_cu, (const void*)mk_fwd, NWAVES * 64, LDS_BYTES);
        (void)hipGetLastError();
        if (per_cu < 1) per_cu = 1;
        if (cus < 256) { fprintf(stderr, "kernel_launch: built for a 256-CU device (got %d)\n", cus); grid = -1; return; }
        grid = 256;
        fprintf(stderr, "kernel_launch: cus %d per_cu %d grid %d\n", cus, per_cu, grid);
    }
    if (grid < 0) return;
    if (hipMemsetAsync(d_ws, 0, 131072, stream) != hipSuccess) { fprintf(stderr, "kernel_launch: memset failed\n"); return; }
    Args a{};
    for (int i = 0; i < 20; ++i) a.in[i] = (const float*)d_in[i];
    a.out = (float*)d_out; a.ws = (unsigned char*)d_ws;
#if MK_ONE_LAUNCH
    void* kargs[] = {&a};
    a.ph_lo = 0; a.ph_hi = N_PHASES;
    hipError_t e = hipLaunchCooperativeKernel((const void*)mk_fwd, dim3(grid), dim3(NWAVES * 64), kargs, LDS_BYTES, stream);
    if (e != hipSuccess) fprintf(stderr, "kernel_launch: cooperative launch failed: %s\n", hipGetErrorString(e));
#else
    for (int ph = 0; ph < N_PHASES; ++ph) {
        a.ph_lo = ph; a.ph_hi = ph + 1;
        hipLaunchKernelGGL(mk_fwd, dim3(grid), dim3(NWAVES * 64), LDS_BYTES, stream, a);
    }
#endif
}
```

```cpp
#include <hip/hip_runtime.h>
#include <hip/hip_cooperative_groups.h>
#include <cstdio>
#include <cstdint>
namespace cg = cooperative_groups;

#ifndef MK_ONE_LAUNCH
#define MK_ONE_LAUNCH 1
#endif

#define LAS __attribute__((address_space(3)))
typedef unsigned short bf16_t;
typedef short bf16x8 __attribute__((ext_vector_type(8)));
typedef float f32x4 __attribute__((ext_vector_type(4)));
typedef float f32x2 __attribute__((ext_vector_type(2)));
typedef unsigned u32x4 __attribute__((ext_vector_type(4)));
typedef unsigned u32x2 __attribute__((ext_vector_type(2)));
typedef __bf16 bf16x2_t __attribute__((ext_vector_type(2)));

constexpr int D = 2048, NPROMPT = 8192, NSAMPLE = 512, M = NPROMPT + NSAMPLE;
constexpr int TP = 2048, TS = 4, BS = 128;
constexpr int DFF = 5632;
constexpr float EPS = 1e-6f;

__device__ __forceinline__ unsigned pk2(float lo, float hi) { f32x2 v = {lo, hi}; bf16x2_t b = __builtin_convertvector(v, bf16x2_t); return __builtin_bit_cast(unsigned, b); }
__device__ __forceinline__ float bf2f(unsigned b) { return __uint_as_float(b << 16); }
__device__ __forceinline__ float silu_f(float x) { return x * __builtin_amdgcn_rcpf(1.0f + __expf(-x)); }
__device__ __forceinline__ float wave_sum(float v) {
#pragma unroll
    for (int o = 1; o < 64; o <<= 1) v += __shfl_xor(v, o);
    return v;
}

namespace pg8 {
constexpr int BM = 256, BK = 64, HALF = 128, HTB = HALF * BK * 2, STAGE_BYTES = 8 * HTB, NXCD = 8, WGM = 8;
__host__ __device__ __forceinline__ int lds_byte(int r, int c) { const int st = (r >> 4) * 2 + (c >> 5), rr = r & 15, cc = c & 31, ob = rr * 64 + cc * 2; return st * 1024 + (ob ^ (((ob >> 9) & 1) << 5)); }
__host__ __device__ __forceinline__ void stage_rc(int b, int& R, int& C) { const int st = b / 1024, sb = b % 1024, swz = sb ^ (((sb >> 9) & 1) << 5); R = (st >> 1) * 16 + swz / 64; C = (st & 1) * 32 + (swz % 64) / 2; }
__host__ __device__ __forceinline__ int perm32(int rho) { const int n = rho >> 4, i = rho & 15; return 8 * (i >> 2) + 4 * n + (i & 3); }

struct Unit { int pm, pn, kt0, nt, split, uid; };
struct Gemm { const bf16_t* A; const bf16_t* Bt; int M, N, K; };

struct StaticOrder {
    int nM, nN, nwg, G, c, ntk;
    __host__ __device__ void init(int M_, int N_, int G_, int c_, int K_) { nM = M_ / BM; nN = N_ / BM; nwg = nM * nN; G = G_; c = c_; ntk = K_ / BK; }
    __host__ __device__ bool next(int i, Unit& u) const {
        const long L = (long)i * G + c; if (L >= nwg) return false;
        u.kt0 = 0; u.nt = ntk; u.split = -1; u.uid = 0;
        int wgid = (int)L; { const int q = nwg / NXCD, r = nwg % NXCD, xcd = wgid % NXCD, off = wgid / NXCD; wgid = (xcd < r ? xcd * (q + 1) : r * (q + 1) + (xcd - r) * q) + off; }
        const int nig = WGM * nN, gid = wgid / nig, fm = gid * WGM, gsz = (nM - fm) < WGM ? (nM - fm) : WGM;
        u.pm = fm + ((wgid % nig) % gsz); u.pn = (wgid % nig) / gsz; return true;
    }
    __device__ __forceinline__ void a_ready(const Unit&) const {}
    __device__ __forceinline__ void done(const Unit&) const {}
};

struct SplitOrder {
    StaticOrder so; int c;
    __host__ __device__ void init(int N_, int G_, int c_, int K_) { so.init(8192, N_, G_, c_, K_); c = c_; }
    __host__ __device__ bool next(int i, Unit& u) const {
        if (i == 0) return so.next(0, u);
        if (i == 1 && c < 128) { const int j = c >> 3, sp = c & 7; u.pm = 32 + (j >> 3); u.pn = j & 7; u.split = sp; u.uid = j;
            if (so.ntk == 32) { u.kt0 = 4 * sp; u.nt = 4; } else { u.kt0 = sp < 4 ? 12 * sp : 48 + 10 * (sp - 4); u.nt = sp < 4 ? 12 : 10; }
            return true; }
        return false;
    }
    __device__ __forceinline__ void a_ready(const Unit&) const {}
    __device__ __forceinline__ void done(const Unit&) const {}
};


struct EpiIn {
    static constexpr bool PERM = true, AFTER_DRAIN = false;
    bf16_t* Qs; float* LOGF; bf16_t* Vb; bf16_t* SG; const float* lbraw;
    __device__ __forceinline__ void operator()(const f32x4 (&acc)[2][2][4][2], const Unit& u, int wr, int wc, int fr, int fq) const {
        const int seg = u.pn >> 3;
        const int row0 = u.pm * BM + wr * 64 + fr;
        const int col0 = (u.pn & 7) * BM + wc * 32 + 8 * fq;
        if (seg == 1) {
#pragma unroll
            for (int bj = 0; bj < 2; ++bj) {
                const int c = col0 + bj * HALF;
                float lb[8];
#pragma unroll
                for (int e = 0; e < 8; ++e) { const float a0 = lbraw[c + e], a1 = lbraw[D + c + e]; lb[e] = __builtin_amdgcn_rcpf(1.0f + __expf(a1 - a0)); }
#pragma unroll
                for (int ai = 0; ai < 2; ++ai)
#pragma unroll
                    for (int m = 0; m < 4; ++m) {
                        float* dst = LOGF + (size_t)(row0 + ai * HALF + m * 16) * D + c;
                        f32x4 o0, o1;
#pragma unroll
                        for (int j = 0; j < 4; ++j) {
                            const float s0 = __builtin_amdgcn_rcpf(1.0f + __expf(-acc[ai][bj][m][0][j])), s1 = __builtin_amdgcn_rcpf(1.0f + __expf(-acc[ai][bj][m][1][j]));
                            o0[j] = __logf(lb[j] + (1.0f - lb[j]) * s0); o1[j] = __logf(lb[4 + j] + (1.0f - lb[4 + j]) * s1);
                        }
                        *(f32x4*)dst = o0; *(f32x4*)(dst + 4) = o1;
                    }
            }
        } else {
            bf16_t* base = Qs + (size_t)seg * ((size_t)M * D);
#pragma unroll
            for (int ai = 0; ai < 2; ++ai)
#pragma unroll
                for (int m = 0; m < 4; ++m)
#pragma unroll
                    for (int bj = 0; bj < 2; ++bj) {
                        f32x4 v0 = acc[ai][bj][m][0], v1 = acc[ai][bj][m][1];
                        if (seg != 2) {
#pragma unroll
                            for (int j = 0; j < 4; ++j) { v0[j] = silu_f(v0[j]); v1[j] = silu_f(v1[j]); }
                        }
                        u32x4 w; w.x = pk2(v0[0], v0[1]); w.y = pk2(v0[2], v0[3]); w.z = pk2(v1[0], v1[1]); w.w = pk2(v1[2], v1[3]);
                        *(u32x4*)(base + (size_t)(row0 + ai * HALF + m * 16) * D + col0 + bj * HALF) = w;
                    }
        }
    }
};
struct EpiF32 {
    static constexpr bool PERM = true, AFTER_DRAIN = false;
    bf16_t* Y; int ldc; float* slab; unsigned* cnt;
    __device__ __forceinline__ void operator()(const f32x4 (&acc)[2][2][4][2], const Unit& u, int wr, int wc, int fr, int fq) const {
        const int row0 = u.pm * BM + wr * 64 + fr, col0 = u.pn * BM + wc * 32 + 8 * fq;
        if (u.split < 0) {
#pragma unroll
            for (int ai = 0; ai < 2; ++ai)
#pragma unroll
                for (int m = 0; m < 4; ++m)
#pragma unroll
                    for (int bj = 0; bj < 2; ++bj) {
                        const f32x4 v0 = acc[ai][bj][m][0], v1 = acc[ai][bj][m][1];
                        u32x4 w4; w4.x = pk2(v0[0], v0[1]); w4.y = pk2(v0[2], v0[3]); w4.z = pk2(v1[0], v1[1]); w4.w = pk2(v1[2], v1[3]);
                        *(u32x4*)(Y + (size_t)(row0 + ai * HALF + m * 16) * ldc + col0 + bj * HALF) = w4;
                    }
            return;
        }
        const int tid = threadIdx.x;
        u32x4* mine = (u32x4*)((unsigned char*)slab + (size_t)(u.uid * 8 + u.split) * 131072) + tid;
#pragma unroll
        for (int ai = 0; ai < 2; ++ai)
#pragma unroll
            for (int m = 0; m < 4; ++m)
#pragma unroll
                for (int bj = 0; bj < 2; ++bj) { const f32x4 v0 = acc[ai][bj][m][0], v1 = acc[ai][bj][m][1];
                    u32x4 w4; w4.x = pk2(v0[0], v0[1]); w4.y = pk2(v0[2], v0[3]); w4.z = pk2(v1[0], v1[1]); w4.w = pk2(v1[2], v1[3]);
                    mine[((ai * 4 + m) * 2 + bj) * 512] = w4; }
        asm volatile("s_waitcnt vmcnt(0)" ::: "memory");
        __syncthreads();
        if (tid == 0) {
            unsigned* cw = cnt + 64 * u.uid;
            __builtin_amdgcn_fence(__ATOMIC_RELEASE, "agent");
            asm volatile("s_waitcnt vmcnt(0)" ::: "memory");
            __hip_atomic_fetch_add(cw, 1u, __ATOMIC_RELAXED, __HIP_MEMORY_SCOPE_AGENT);
            unsigned sp = 0;
            while (__hip_atomic_load(cw, __ATOMIC_RELAXED, __HIP_MEMORY_SCOPE_AGENT) < 8u) { __builtin_amdgcn_s_sleep(2); if (++sp > (1u << 22)) break; }
            __builtin_amdgcn_fence(__ATOMIC_ACQUIRE, "agent");
            asm volatile("s_waitcnt vmcnt(0)" ::: "memory");
        }
        __syncthreads();
        const int ai = u.split >> 2, m = u.split & 3;
        const u32x4* base = (const u32x4*)((const unsigned char*)slab + (size_t)(u.uid * 8) * 131072) + tid + (size_t)(u.split * 2) * 512;
        u32x4 pw[8][2];
#pragma unroll
        for (int sp = 0; sp < 8; ++sp)
#pragma unroll
            for (int bj = 0; bj < 2; ++bj) pw[sp][bj] = base[(size_t)sp * 8192 + bj * 512];
#pragma unroll
        for (int bj = 0; bj < 2; ++bj) {
            f32x4 v0 = (f32x4){0.f, 0.f, 0.f, 0.f}, v1 = v0;
#pragma unroll
            for (int sp = 0; sp < 8; ++sp) { const u32x4 q = pw[sp][bj];
                v0 += (f32x4){bf2f(q.x & 0xffffu), __uint_as_float(q.x & 0xffff0000u), bf2f(q.y & 0xffffu), __uint_as_float(q.y & 0xffff0000u)};
                v1 += (f32x4){bf2f(q.z & 0xffffu), __uint_as_float(q.z & 0xffff0000u), bf2f(q.w & 0xffffu), __uint_as_float(q.w & 0xffff0000u)}; }
            u32x4 w4; w4.x = pk2(v0[0], v0[1]); w4.y = pk2(v0[2], v0[3]); w4.z = pk2(v1[0], v1[1]); w4.w = pk2(v1[2], v1[3]);
            *(u32x4*)(Y + (size_t)(row0 + ai * HALF + m * 16) * ldc + col0 + bj * HALF) = w4;
        }
    }
};
struct EpiSwiGLU {
    static constexpr bool PERM = true, AFTER_DRAIN = false;
    bf16_t* Hact;
    __device__ __forceinline__ void operator()(const f32x4 (&acc)[2][2][4][2], const Unit& u, int wr, int wc, int fr, int fq) const {
        const int row0 = u.pm * BM + wr * 64 + fr, col0 = u.pn * HALF + wc * 32 + 8 * fq;
#pragma unroll
        for (int ai = 0; ai < 2; ++ai)
#pragma unroll
            for (int m = 0; m < 4; ++m) {
                f32x4 v0, v1;
#pragma unroll
                for (int j = 0; j < 4; ++j) { v0[j] = silu_f(acc[ai][0][m][0][j]) * acc[ai][1][m][0][j]; v1[j] = silu_f(acc[ai][0][m][1][j]) * acc[ai][1][m][1][j]; }
                u32x4 w; w.x = pk2(v0[0], v0[1]); w.y = pk2(v0[2], v0[3]); w.z = pk2(v1[0], v1[1]); w.w = pk2(v1[2], v1[3]);
                *(u32x4*)(Hact + (size_t)(row0 + ai * HALF + m * 16) * DFF + col0) = w;
            }
    }
};
template <int MODE> struct EpiRope {
    static constexpr bool PERM = true, AFTER_DRAIN = false;
    bf16_t* O0; bf16_t* O1; const f32x2* rope;
    float* kwin; float* vwin; float* knew; float* vnew;
    __device__ __forceinline__ void operator()(const f32x4 (&accin)[2][2][4][2], const Unit& u, int wr, int wc, int fr, int fq) const {
        const int row0 = u.pm * BM + wr * 64 + fr;
        const bool do_rope = (MODE == 0 || u.pn == 0) && ((wc & 1) == 0);
        const float scale = MODE == 0 ? 0.125f : 1.0f;
#pragma unroll
        for (int ai = 0; ai < 2; ++ai)
#pragma unroll
            for (int m = 0; m < 4; ++m) {
                const int row = row0 + ai * HALF + m * 16;
                f32x4 v[2][2];
#pragma unroll
                for (int bj = 0; bj < 2; ++bj) { v[bj][0] = accin[ai][bj][m][0]; v[bj][1] = accin[ai][bj][m][1]; }
                if (do_rope) {
                    const int idx = row < NPROMPT ? (row & (TP - 1)) : (TP + (row & 3));
                    const f32x4* rp = (const f32x4*)(rope + (size_t)idx * 8);
                    f32x4 cs[4];
#pragma unroll
                    for (int q = 0; q < 4; ++q) cs[q] = rp[q];
#pragma unroll
                    for (int bj = 0; bj < 2; ++bj)
#pragma unroll
                        for (int n = 0; n < 2; ++n)
#pragma unroll
                            for (int j = 0; j < 4; ++j) {
                                const int f = 4 * n + j;
                                const float c = cs[f >> 1][(f & 1) * 2], s = cs[f >> 1][(f & 1) * 2 + 1];
                                const float x = v[bj][n][j];
                                const float px = __shfl_xor(x, 16);
                                const float r = fq == 0 ? x * c - px * s : x * c + px * s;
                                v[bj][n][j] = fq < 2 ? r : x;
                            }
                }
#pragma unroll
                for (int bj = 0; bj < 2; ++bj) {
                    const f32x4 a = v[bj][0] * scale, b = v[bj][1] * scale;
                    u32x4 w; w.x = pk2(a[0], a[1]); w.y = pk2(a[2], a[3]); w.z = pk2(b[0], b[1]); w.w = pk2(b[2], b[3]);
                    const int ct = bj * HALF + wc * 32 + 8 * fq;
                    if (MODE == 0) {
                        *(u32x4*)(O0 + (size_t)row * D + u.pn * BM + ct) = w;
                    } else {
                        bf16_t* ob = u.pn == 0 ? O0 : O1;
                        *(u32x4*)(ob + (size_t)row * 256 + ct) = w;
                        float* fo = nullptr;
                        if (u.pm >= NPROMPT / BM) fo = (u.pn == 0 ? knew : vnew) + (size_t)(row - NPROMPT) * 256 + ct;
                        else if ((u.pm & 7) == 7 && ai == 1) fo = (u.pn == 0 ? kwin : vwin) + (size_t)((u.pm >> 3) * 128 + (row & 127)) * 256 + ct;
                        if (fo) { *(f32x4*)fo = a; *(f32x4*)(fo + 4) = b; }
                    }
                }
            }
    }
};

template <class Epi, class Sched, bool ALIGN_EPI = false, bool SP2 = false>
__device__ __forceinline__ void gemm_phase(LAS unsigned char* lds, const Gemm g, const Sched& S, const Epi& E) {
    const int tid = threadIdx.x, wid = __builtin_amdgcn_readfirstlane(tid >> 6), lane = tid & 63, wr = wid >> 2, wc = wid & 3, fr = lane & 15, fq = lane >> 4;
    const int K = g.K;
    unsigned voffA[2], voffB[2];
#pragma unroll
    for (int i = 0; i < 2; ++i) { int R, C; stage_rc(tid * 16 + i * 8192, R, C); const int Rb = Epi::PERM ? ((R & ~31) + perm32(R & 31)) : R;
        voffA[i] = (unsigned)(R * K + C) * 2u; voffB[i] = (unsigned)(Rb * K + C) * 2u; }
    const size_t kstep = (size_t)(BK * 2);
    const size_t hstep = (size_t)HALF * K * 2;
    const size_t tstep = 2 * hstep;
    const unsigned ldsw = (unsigned)wid * 1024u;
    const int aoff = lds_byte(wr * 64 + fr, fq * 8), boff = lds_byte(wc * 32 + fr, fq * 8);
#define PG8_SA(b, h) (((b) * 2 + (h)) * HTB)
#define PG8_SB(b, h) ((4 + (b) * 2 + (h)) * HTB)
#define PG8_STAGE(bufoff, gbase, voff) do { _Pragma("unroll") for (int _i = 0; _i < 2; ++_i) \
        __builtin_amdgcn_global_load_lds((const unsigned*)((const char*)(gbase) + (voff)[_i]), (LAS unsigned*)(lds + (bufoff) + ldsw + _i * 8192), 16, 0, 0); } while (0)
#define PG8_LDA(dst, b, h) do { _Pragma("unroll") for (int m = 0; m < 4; ++m) _Pragma("unroll") for (int k = 0; k < 2; ++k) dst[m][k] = *(const LAS bf16x8*)(lds + PG8_SA(b, h) + aoff + m * 2048 + k * 1024); } while (0)
#define PG8_LDB(dst, b, h) do { _Pragma("unroll") for (int n = 0; n < 2; ++n) _Pragma("unroll") for (int k = 0; k < 2; ++k) dst[n][k] = *(const LAS bf16x8*)(lds + PG8_SB(b, h) + boff + n * 2048 + k * 1024); } while (0)
#define PG8_MMA(ai, bj, At, Bt) do { __builtin_amdgcn_s_setprio(1); _Pragma("unroll") for (int m = 0; m < 4; ++m) _Pragma("unroll") for (int n = 0; n < 2; ++n) _Pragma("unroll") for (int k = 0; k < 2; ++k) \
        acc[ai][bj][m][n] = __builtin_amdgcn_mfma_f32_16x16x32_bf16(Bt[n][k], At[m][k], acc[ai][bj][m][n], 0, 0, 0); __builtin_amdgcn_s_setprio(0); } while (0)
#define PG8_WAIT_V(n) asm volatile("s_waitcnt vmcnt(" #n ")" ::: "memory")
#define PG8_WAIT_L(n) asm volatile("s_waitcnt lgkmcnt(" #n ")" ::: "memory")
#define PG8_BAR __builtin_amdgcn_s_barrier()
#define PG8_SCHED __builtin_amdgcn_sched_barrier(0)
    Unit cur, nxt; int ui = 0;
    if (!S.next(0, cur)) return;
    f32x4 acc[2][2][4][2];
#pragma unroll
    for (int a = 0; a < 2; ++a)
#pragma unroll
        for (int b = 0; b < 2; ++b)
#pragma unroll
            for (int m = 0; m < 4; ++m)
#pragma unroll
                for (int n = 0; n < 2; ++n) acc[a][b][m][n] = (f32x4){0.f, 0.f, 0.f, 0.f};
    bf16x8 At[4][2], B0[2][2], B1[2][2];
    const char* cA = (const char*)g.A + (size_t)cur.pm * tstep + (size_t)cur.kt0 * kstep; const char* cB = (const char*)g.Bt + (size_t)cur.pn * tstep + (size_t)cur.kt0 * kstep;
    S.a_ready(cur);
    if constexpr (SP2) {
        PG8_STAGE(PG8_SB(0, 0), cB, voffB); PG8_STAGE(PG8_SB(0, 1), cB + hstep, voffB); PG8_STAGE(PG8_SA(0, 0), cA, voffA); PG8_STAGE(PG8_SA(0, 1), cA + hstep, voffA);
        if (wr == 1) PG8_BAR;
        PG8_WAIT_V(2); PG8_BAR;
        PG8_STAGE(PG8_SB(1, 0), cB + kstep, voffB); PG8_STAGE(PG8_SA(1, 0), cA + kstep, voffA); PG8_STAGE(PG8_SB(1, 1), cB + hstep + kstep, voffB);
        PG8_WAIT_V(6); PG8_BAR;
    } else {
        PG8_STAGE(PG8_SB(0, 0), cB, voffB); PG8_STAGE(PG8_SA(0, 0), cA, voffA); PG8_STAGE(PG8_SB(0, 1), cB + hstep, voffB); PG8_STAGE(PG8_SA(0, 1), cA + hstep, voffA);
        if (wr == 1) PG8_BAR;
        PG8_WAIT_V(4); PG8_BAR;
        PG8_STAGE(PG8_SB(1, 0), cB + kstep, voffB); PG8_STAGE(PG8_SA(1, 0), cA + kstep, voffA); PG8_STAGE(PG8_SB(1, 1), cB + hstep + kstep, voffB);
        PG8_WAIT_V(6); PG8_BAR;
    }
    for (;;) {
        const bool has_next = S.next(ui + 1, nxt);
        const char* nA = has_next ? (const char*)g.A + (size_t)nxt.pm * tstep + (size_t)nxt.kt0 * kstep : cA; const char* nB = has_next ? (const char*)g.Bt + (size_t)nxt.pn * tstep + (size_t)nxt.kt0 * kstep : cB;
        const int nt = cur.nt;
        for (int t = 0; t < nt; t += 2) {
            const bool last = (t == nt - 2);
            const char* a1 = cA + (size_t)(t + 1) * kstep;
            const char* a2 = last ? nA : cA + (size_t)(t + 2) * kstep; const char* b2 = last ? nB : cB + (size_t)(t + 2) * kstep;
            const char* a3 = a2 + kstep; const char* b3 = b2 + kstep;
            if (last && has_next) S.a_ready(nxt);
            if constexpr (SP2) {
            PG8_LDB(B0, 0, 0); PG8_LDB(B1, 0, 1); PG8_SCHED; PG8_LDA(At, 0, 0); PG8_STAGE(PG8_SA(1, 1), a1 + hstep, voffA);
            PG8_WAIT_V(8); PG8_WAIT_L(0); PG8_BAR; PG8_MMA(0, 0, At, B0); PG8_MMA(0, 1, At, B1); PG8_BAR; PG8_SCHED;
            PG8_LDA(At, 0, 1); PG8_STAGE(PG8_SB(0, 0), b2, voffB); PG8_STAGE(PG8_SB(0, 1), b2 + hstep, voffB); PG8_STAGE(PG8_SA(0, 0), a2, voffA);
            PG8_WAIT_V(8); PG8_WAIT_L(0); PG8_BAR; PG8_MMA(1, 0, At, B0); PG8_MMA(1, 1, At, B1); PG8_BAR; PG8_SCHED;
            PG8_LDB(B0, 1, 0); PG8_LDB(B1, 1, 1); PG8_SCHED; PG8_LDA(At, 1, 0); PG8_STAGE(PG8_SA(0, 1), a2 + hstep, voffA);
            PG8_WAIT_V(8); PG8_WAIT_L(0); PG8_BAR; PG8_MMA(0, 0, At, B0); PG8_MMA(0, 1, At, B1); PG8_BAR; PG8_SCHED;
            PG8_LDA(At, 1, 1); PG8_STAGE(PG8_SB(1, 0), b3, voffB); PG8_STAGE(PG8_SB(1, 1), b3 + hstep, voffB); PG8_STAGE(PG8_SA(1, 0), a3, voffA);
            PG8_WAIT_V(8); PG8_WAIT_L(0); PG8_BAR; PG8_MMA(1, 0, At, B0); PG8_MMA(1, 1, At, B1); PG8_BAR; PG8_SCHED;
            } else {
            PG8_LDB(B0, 0, 0); PG8_SCHED; PG8_LDA(At, 0, 0); PG8_STAGE(PG8_SA(1, 1), a1 + hstep, voffA);
            PG8_WAIT_L(8); PG8_BAR; PG8_WAIT_L(0); PG8_MMA(0, 0, At, B0); PG8_BAR; PG8_SCHED;
            PG8_LDB(B1, 0, 1); PG8_STAGE(PG8_SB(0, 0), b2, voffB);
            PG8_BAR; PG8_WAIT_L(0); PG8_MMA(0, 1, At, B1); PG8_BAR;
            PG8_LDA(At, 0, 1); PG8_STAGE(PG8_SA(0, 0), a2, voffA);
            PG8_BAR; PG8_WAIT_L(0); PG8_MMA(1, 0, At, B0); PG8_BAR; PG8_SCHED;
            PG8_STAGE(PG8_SB(0, 1), b2 + hstep, voffB);
            PG8_WAIT_V(6); PG8_BAR; PG8_MMA(1, 1, At, B1); PG8_BAR;
            PG8_LDB(B0, 1, 0); PG8_SCHED; PG8_LDA(At, 1, 0); PG8_STAGE(PG8_SA(0, 1), a2 + hstep, voffA);
            PG8_WAIT_L(8); PG8_BAR; PG8_WAIT_L(0); PG8_MMA(0, 0, At, B0); PG8_BAR; PG8_SCHED;
            PG8_LDB(B1, 1, 1); PG8_STAGE(PG8_SB(1, 0), b3, voffB);
            PG8_BAR; PG8_WAIT_L(0); PG8_MMA(0, 1, At, B1); PG8_BAR;
            PG8_LDA(At, 1, 1); PG8_STAGE(PG8_SA(1, 0), a3, voffA);
            PG8_BAR; PG8_WAIT_L(0); PG8_MMA(1, 0, At, B0); PG8_BAR; PG8_SCHED;
            PG8_STAGE(PG8_SB(1, 1), b3 + hstep, voffB);
            PG8_WAIT_V(6); PG8_BAR; PG8_MMA(1, 1, At, B1); PG8_BAR;
            }
        }
        if constexpr (ALIGN_EPI) { if (wr == 0) PG8_BAR; }
        if constexpr (!Epi::AFTER_DRAIN) { E(acc, cur, wr, wc, fr, fq); S.done(cur); }
        if (!has_next) break;
#pragma unroll
        for (int a = 0; a < 2; ++a)
#pragma unroll
            for (int b = 0; b < 2; ++b)
#pragma unroll
                for (int m = 0; m < 4; ++m)
#pragma unroll
                    for (int n = 0; n < 2; ++n) acc[a][b][m][n] = (f32x4){0.f, 0.f, 0.f, 0.f};
        cur = nxt; cA = nA; cB = nB; ++ui;
        if constexpr (ALIGN_EPI) { if (wr == 1) PG8_BAR; }
    }
    PG8_WAIT_V(0);
    if constexpr (!ALIGN_EPI) { if (wr == 0) PG8_BAR; }
    PG8_BAR;
#undef PG8_SA
#undef PG8_SB
#undef PG8_STAGE
#undef PG8_LDA
#undef PG8_LDB
#undef PG8_MMA
#undef PG8_WAIT_V
#undef PG8_WAIT_L
#undef PG8_BAR
#undef PG8_SCHED
}
}

constexpr size_t MiB = 1u << 20;
constexpr size_t WS_WIN = 1 * MiB, WS_WOUT = 33 * MiB, WS_WKV = 41 * MiB, WS_WQ = 43 * MiB, WS_WAO = 51 * MiB, WS_WGU0 = 59 * MiB, WS_WGU1 = 103 * MiB,
                 WS_WD0 = 147 * MiB, WS_WD1 = 169 * MiB, WS_ROPE = 191 * MiB, WS_XN = 192 * MiB, WS_Y = 226 * MiB, WS_O2 = 294 * MiB, WS_R1 = 328 * MiB;
constexpr size_t WS_GQT = 192 * MiB, WS_GKH = 224 * MiB, WS_GVT = 256 * MiB;
constexpr size_t WS_GPS = WS_R1 + 34 * MiB, WS_GDEC = WS_R1 + 42 * MiB;
constexpr size_t WS_QS = WS_R1, WS_VB = WS_R1 + 68 * MiB, WS_SG = WS_R1 + 102 * MiB, WS_LOGF = WS_R1 + 136 * MiB;
constexpr size_t WS_HACT = WS_R1;
constexpr size_t WS_XKV = WS_R1, WS_QR = WS_R1 + 34 * MiB, WS_KB = WS_R1 + 68 * MiB, WS_VKV = WS_R1 + 73 * MiB;
constexpr size_t WS_SLAB = WS_R1 + 204 * MiB;
constexpr size_t WS_END = WS_SLAB + 32 * MiB;
constexpr size_t WS_HB = WS_LOGF;
constexpr size_t WS_CNT = 65536;
constexpr size_t OUT_Y = 0, OUT_SP = (size_t)M * D, OUT_SS = OUT_SP + 4 * 16 * 16384, OUT_KWIN = OUT_SS + (size_t)128 * 16 * 16384, OUT_VWIN = OUT_KWIN + 131072,
                 OUT_KNEW = OUT_VWIN + 131072, OUT_VNEW = OUT_KNEW + 131072, OUT_END = OUT_VNEW + 131072;

constexpr int LDS_BYTES = 147456;
constexpr int NWAVES = 8;

template <bool GU> __device__ __forceinline__ void p0_transpose_item(const float* W, int K, int N, bf16_t* WT, LAS float* scr, int item, int lane) {
    const int nblk = N / 32, kb = item / nblk, nb = item % nblk, k0 = 64 * kb, n0 = 32 * nb;
    f32x4 wv[8];
#pragma unroll
    for (int i = 0; i < 8; ++i) wv[i] = *(const f32x4*)(W + (size_t)(k0 + 8 * i + (lane >> 3)) * N + n0 + 4 * (lane & 7));
#pragma unroll
    for (int i = 0; i < 8; ++i) { LAS float* d = scr + (8 * i + (lane >> 3)) * 33 + 4 * (lane & 7); d[0] = wv[i][0]; d[1] = wv[i][1]; d[2] = wv[i][2]; d[3] = wv[i][3]; }
    asm volatile("s_waitcnt lgkmcnt(0)" ::: "memory");
    int r0 = n0;
    if (GU) { const int half = n0 >= DFF ? 1 : 0, rem = n0 - half * DFF; r0 = (rem >> 7) * 256 + half * 128 + (rem & 127); }
    const int c = lane & 7;
#pragma unroll
    for (int j = 0; j < 4; ++j) { const int n = (lane >> 3) + 8 * j; const LAS float* s = scr + (8 * c) * 33 + n;
        u32x4 o; o.x = pk2(s[0 * 33], s[1 * 33]); o.y = pk2(s[2 * 33], s[3 * 33]); o.z = pk2(s[4 * 33], s[5 * 33]); o.w = pk2(s[6 * 33], s[7 * 33]);
        *(u32x4*)(WT + (size_t)(r0 + n) * K + k0 + 8 * c) = o; }
    asm volatile("s_waitcnt lgkmcnt(0)" ::: "memory");
}

template <bool HASY, bool HASA, bool HASB, bool XIN, bool HOUT16>
__device__ __forceinline__ void row_phase(const float* xp, const float* xs, const bf16_t* Hin, const bf16_t* Y, const float* gpost, bf16_t* Hout16, float* Hout32,
                                          const float* gA, bf16_t* outA, const float* gB, bf16_t* outB, int gw, int NGW, int lane) {
    f32x4 gp[8], ga[8], gb[8];
#pragma unroll
    for (int j = 0; j < 8; ++j) { if (HASY) gp[j] = ((const f32x4*)gpost + lane)[64 * j]; if (HASA) ga[j] = ((const f32x4*)gA + lane)[64 * j]; if (HASB) gb[j] = ((const f32x4*)gB + lane)[64 * j]; }
    f32x4 hf[8]; u32x2 hh[8], yw[8];
#define ROW_LOAD(m_) do { const int mm = (m_); \
        if (XIN) { const f32x4* hr = (const f32x4*)(mm < NPROMPT ? xp + (size_t)mm * D : xs + (size_t)(mm - NPROMPT) * D) + lane; _Pragma("unroll") for (int j = 0; j < 8; ++j) hf[j] = hr[64 * j]; } \
        else { const u32x2* hr = (const u32x2*)(Hin + (size_t)mm * D) + lane; _Pragma("unroll") for (int j = 0; j < 8; ++j) hh[j] = hr[64 * j]; } \
        if (HASY) { const u32x2* yr = (const u32x2*)(Y + (size_t)mm * D) + lane; _Pragma("unroll") for (int j = 0; j < 8; ++j) yw[j] = yr[64 * j]; } } while (0)
    if (gw < M) ROW_LOAD(gw);
    for (int m = gw; m < M; m += NGW) {
        f32x4 h[8], y[8];
#pragma unroll
        for (int j = 0; j < 8; ++j) {
            h[j] = XIN ? hf[j] : (f32x4){bf2f(hh[j].x & 0xffffu), __uint_as_float(hh[j].x & 0xffff0000u), bf2f(hh[j].y & 0xffffu), __uint_as_float(hh[j].y & 0xffff0000u)};
            if (HASY) y[j] = (f32x4){bf2f(yw[j].x & 0xffffu), __uint_as_float(yw[j].x & 0xffff0000u), bf2f(yw[j].y & 0xffffu), __uint_as_float(yw[j].y & 0xffff0000u)};
        }
        if (m + NGW < M) ROW_LOAD(m + NGW);
        if (HASY) {
            float ss = 0.f;
#pragma unroll
            for (int j = 0; j < 8; ++j) ss += (y[j].x * y[j].x + y[j].y * y[j].y) + (y[j].z * y[j].z + y[j].w * y[j].w);
            const float rstd = rsqrtf(wave_sum(ss) * (1.0f / D) + EPS);
#pragma unroll
            for (int j = 0; j < 8; ++j) { h[j] = h[j] + y[j] * rstd * gp[j];
                if (HOUT16) { u32x2 w; w.x = pk2(h[j].x, h[j].y); w.y = pk2(h[j].z, h[j].w); ((u32x2*)(Hout16 + (size_t)m * D) + lane)[64 * j] = w; } else ((f32x4*)(Hout32 + (size_t)m * D) + lane)[64 * j] = h[j]; }
        }
        if (HASA || HASB) {
            float ss = 0.f;
#pragma unroll
            for (int j = 0; j < 8; ++j) ss += (h[j].x * h[j].x + h[j].y * h[j].y) + (h[j].z * h[j].z + h[j].w * h[j].w);
            const float rstd = rsqrtf(wave_sum(ss) * (1.0f / D) + EPS);
            if (HASA) { u32x2* oa = (u32x2*)(outA + (size_t)m * D) + lane;
#pragma unroll
                for (int j = 0; j < 8; ++j) { const f32x4 v = h[j] * rstd * ga[j]; u32x2 w; w.x = pk2(v.x, v.y); w.y = pk2(v.z, v.w); oa[64 * j] = w; } }
            if (HASB) { u32x2* ob = (u32x2*)(outB + (size_t)m * D) + lane;
#pragma unroll
                for (int j = 0; j < 8; ++j) { const f32x4 v = h[j] * rstd * gb[j]; u32x2 w; w.x = pk2(v.x, v.y); w.y = pk2(v.z, v.w); ob[64 * j] = w; } }
        }
    }
#undef ROW_LOAD
}

template <bool GU> __device__ __forceinline__ void cvt_stream(const float* W, int K, int N, bf16_t* WT, LAS float* scr, int first, int stride, int nitems, int lane) {
    if (first >= nitems) return;
    const int nblk = N / 32, lr = lane >> 3, lc = 4 * (lane & 7);
    f32x4 wv[8];
    { const int k0 = 64 * (first / nblk), n0 = 32 * (first % nblk);
#pragma unroll
      for (int i = 0; i < 8; ++i) wv[i] = *(const f32x4*)(W + (size_t)(k0 + 8 * i + lr) * N + n0 + lc); }
    for (int it = first; it < nitems; it += stride) {
        const int k0 = 64 * (it / nblk), n0 = 32 * (it % nblk);
#pragma unroll
        for (int i = 0; i < 8; ++i) { LAS float* d = scr + (8 * i + lr) * 33 + lc; d[0] = wv[i][0]; d[1] = wv[i][1]; d[2] = wv[i][2]; d[3] = wv[i][3]; }
        const int itn = it + stride;
        if (itn < nitems) { const int k1 = 64 * (itn / nblk), n1 = 32 * (itn % nblk);
#pragma unroll
            for (int i = 0; i < 8; ++i) wv[i] = *(const f32x4*)(W + (size_t)(k1 + 8 * i + lr) * N + n1 + lc); }
        asm volatile("s_waitcnt lgkmcnt(0)" ::: "memory");
        int r0 = n0;
        if (GU) { const int half = n0 >= DFF ? 1 : 0, rem = n0 - half * DFF; r0 = (rem >> 7) * 256 + half * 128 + (rem & 127); }
        const int c = lane & 7;
#pragma unroll
        for (int j = 0; j < 4; ++j) { const int n = (lane >> 3) + 8 * j; const LAS float* sp = scr + (8 * c) * 33 + n;
            u32x4 o; o.x = pk2(sp[0 * 33], sp[1 * 33]); o.y = pk2(sp[2 * 33], sp[3 * 33]); o.z = pk2(sp[4 * 33], sp[5 * 33]); o.w = pk2(sp[6 * 33], sp[7 * 33]);
            *(u32x4*)(WT + (size_t)(r0 + n) * K + k0 + 8 * c) = o; }
        asm volatile("s_waitcnt lgkmcnt(0)" ::: "memory");
    }
}

template <bool HASY, bool HASA, bool HASB, bool HIN16 = false, bool HOUT16 = false>
__device__ __forceinline__ void row_pass(const void* hin, const bf16_t* Yrow, const float* gpost, void* hout, const float* gA, bf16_t* outA, const float* gB, bf16_t* outB, int lane) {
    f32x4 h[8], gp[8], ga[8], gb[8]; u32x2 yw[8];
    if (HIN16) { const u32x2* hr = (const u32x2*)hin + lane;
#pragma unroll
        for (int j = 0; j < 8; ++j) { const u32x2 hw = hr[64 * j]; h[j] = (f32x4){bf2f(hw.x & 0xffffu), __uint_as_float(hw.x & 0xffff0000u), bf2f(hw.y & 0xffffu), __uint_as_float(hw.y & 0xffff0000u)}; }
    } else { const f32x4* hr = (const f32x4*)hin + lane;
#pragma unroll
        for (int j = 0; j < 8; ++j) h[j] = hr[64 * j];
    }
    if (HASY) {
#pragma unroll
        for (int j = 0; j < 8; ++j) { yw[j] = ((const u32x2*)Yrow + lane)[64 * j]; gp[j] = ((const f32x4*)gpost + lane)[64 * j]; }
    }
    if (HASA) {
#pragma unroll
        for (int j = 0; j < 8; ++j) ga[j] = ((const f32x4*)gA + lane)[64 * j];
    }
    if (HASB) {
#pragma unroll
        for (int j = 0; j < 8; ++j) gb[j] = ((const f32x4*)gB + lane)[64 * j];
    }
    if (HASY) {
        f32x4 y[8]; float ss = 0.f;
#pragma unroll
        for (int j = 0; j < 8; ++j) { y[j] = (f32x4){bf2f(yw[j].x & 0xffffu), __uint_as_float(yw[j].x & 0xffff0000u), bf2f(yw[j].y & 0xffffu), __uint_as_float(yw[j].y & 0xffff0000u)}; ss += (y[j].x * y[j].x + y[j].y * y[j].y) + (y[j].z * y[j].z + y[j].w * y[j].w); }
        const float rstd = rsqrtf(wave_sum(ss) * (1.0f / D) + EPS);
#pragma unroll
        for (int j = 0; j < 8; ++j) { h[j] = h[j] + y[j] * rstd * gp[j];
            if (HOUT16) { u32x2 w; w.x = pk2(h[j].x, h[j].y); w.y = pk2(h[j].z, h[j].w); ((u32x2*)hout + lane)[64 * j] = w; } else ((f32x4*)hout + lane)[64 * j] = h[j]; }
    }
    if (HASA || HASB) {
        float ss = 0.f;
#pragma unroll
        for (int j = 0; j < 8; ++j) ss += (h[j].x * h[j].x + h[j].y * h[j].y) + (h[j].z * h[j].z + h[j].w * h[j].w);
        const float rstd = rsqrtf(wave_sum(ss) * (1.0f / D) + EPS);
        if (HASA) { u32x2* oa = (u32x2*)outA + lane;
#pragma unroll
            for (int j = 0; j < 8; ++j) { const f32x4 v = h[j] * rstd * ga[j]; u32x2 w; w.x = pk2(v.x, v.y); w.y = pk2(v.z, v.w); oa[64 * j] = w; } }
        if (HASB) { u32x2* ob = (u32x2*)outB + lane;
#pragma unroll
            for (int j = 0; j < 8; ++j) { const f32x4 v = h[j] * rstd * gb[j]; u32x2 w; w.x = pk2(v.x, v.y); w.y = pk2(v.z, v.w); ob[64 * j] = w; } }
    }
}

#define LDS_BARRIER() do { asm volatile("s_waitcnt lgkmcnt(0)" ::: "memory"); __builtin_amdgcn_s_barrier(); asm volatile("" ::: "memory"); } while (0)
namespace gla {
constexpr int QT_OFF = 0, TOK_STRIDE = 272;
constexpr int KT_OFF = 64 * 272;
constexpr int KH_OFF = 2 * 64 * 272, CH_STRIDE = 144;
constexpr int VT_OFF = KH_OFF + 128 * 144;
constexpr int DEC_OFF = VT_OFF + 128 * 144;
constexpr int OS_OFF = DEC_OFF + 1024, OS_STRIDE = 528;
constexpr int END = OS_OFF + 64 * 528;
static_assert(END <= 131072, "gla lds");
struct P { const bf16_t* Qs; const float* LOGF; const bf16_t* Vb; const bf16_t* SG; const float* gnorm; bf16_t* O2;
           unsigned char* G_QT; unsigned char* G_KH; unsigned char* G_VT; unsigned char* G_PS; unsigned char* G_DEC; };

__device__ __forceinline__ bf16x8 mk8(u32x2 lo, u32x2 hi) { u32x4 t; t.x = lo.x; t.y = lo.y; t.z = hi.x; t.w = hi.y; return __builtin_bit_cast(bf16x8, t); }
__device__ __forceinline__ bf16x8 pk8(f32x4 a, f32x4 b) { u32x4 t; t.x = pk2(a[0], a[1]); t.y = pk2(a[2], a[3]); t.z = pk2(b[0], b[1]); t.w = pk2(b[2], b[3]); return __builtin_bit_cast(bf16x8, t); }

__device__ __forceinline__ void intra_items(LAS unsigned char* lds, const P& p, int first, int stride, int nitems) {
    const int tid = threadIdx.x, lane = tid & 63, w = __builtin_amdgcn_readfirstlane(tid >> 6), l16 = lane & 15, g = lane >> 4;
    const int pk = tid & 127, grp = tid >> 7, pc = grp >> 1, hf = grp & 1;
    float lfo[16]; unsigned qv[16], vv[16];
#define GLA_LOAD_RAW(id) do { const int bh_ = (id) >> 5; const size_t R_ = (size_t)(bh_ >> 4) * TP + (size_t)((id) & 31) * 64; const int hc_ = (bh_ & 15) * 128; \
        _Pragma("unroll") for (int i = 0; i < 16; ++i) { const int tok = 16 * grp + i; lfo[i] = p.LOGF[(R_ + tok) * D + hc_ + pk]; \
            qv[i] = (unsigned)p.Qs[(R_ + tok) * D + hc_ + pk]; vv[i] = (unsigned)p.Vb[(R_ + tok) * D + hc_ + pk]; } } while (0)
    if (first < nitems) GLA_LOAD_RAW(first);
    for (int id = first; id < nitems; id += stride) {
        {
            float so = 0.f;
#pragma unroll
            for (int i = 0; i < 16; ++i) so += lfo[i];
            *(LAS float*)(lds + OS_OFF + tid * 4) = so;
            LDS_BARRIER();
            const float sx = *(const LAS float*)(lds + OS_OFF + (tid ^ 128) * 4);
            const float tot = so + sx;
            float b = hf ? sx : 0.f;
            unsigned khp[8], vtp[8]; float khprev = 0.f;
#pragma unroll
            for (int i = 0; i < 16; ++i) {
                const float l = lfo[i];
                b += l;
                const float kk = 1.0f - __expf(l);
                const float bc = fmaxf(b, -80.f);
                const float qq = bf2f(qv[i]) * __expf(bc);
                const float kt = kk * __expf(-bc);
                const float kh = kk * __expf(tot - b);
                const int t = 16 * grp + i;
                *(LAS bf16_t*)(lds + QT_OFF + t * TOK_STRIDE + pk * 2) = (bf16_t)(pk2(qq, 0.f) & 0xffffu);
                *(LAS bf16_t*)(lds + KT_OFF + t * TOK_STRIDE + pk * 2) = (bf16_t)(pk2(kt, 0.f) & 0xffffu);
                if (i & 1) { khp[i >> 1] = pk2(khprev, kh); vtp[i >> 1] = vv[i - 1] | (vv[i] << 16); } else khprev = kh;
            }
            LAS u32x4* khd = (LAS u32x4*)(lds + KH_OFF + pk * CH_STRIDE + grp * 32); LAS u32x4* vtd = (LAS u32x4*)(lds + VT_OFF + pk * CH_STRIDE + grp * 32);
            khd[0] = (u32x4){khp[0], khp[1], khp[2], khp[3]}; khd[1] = (u32x4){khp[4], khp[5], khp[6], khp[7]};
            vtd[0] = (u32x4){vtp[0], vtp[1], vtp[2], vtp[3]}; vtd[1] = (u32x4){vtp[4], vtp[5], vtp[6], vtp[7]};
            if (hf == 0) *(LAS float*)(lds + DEC_OFF + pc * 512 + pk * 4) = __expf(tot);
        }
        LDS_BARRIER();
        if (id + stride < nitems) GLA_LOAD_RAW(id + stride);
        {
            const int c = w >> 2, st = (w >> 1) & 1, tt = w & 1, tb = 32 * c;
            f32x4 a4 = (f32x4){0.f, 0.f, 0.f, 0.f};
#pragma unroll
            for (int ks = 0; ks < 4; ++ks) {
                const bf16x8 a = *(const LAS bf16x8*)(lds + KT_OFF + (tb + 16 * st + l16) * TOK_STRIDE + (32 * ks + 8 * g) * 2);
                const bf16x8 bq = *(const LAS bf16x8*)(lds + QT_OFF + (tb + 16 * tt + l16) * TOK_STRIDE + (32 * ks + 8 * g) * 2);
                a4 = __builtin_amdgcn_mfma_f32_16x16x32_bf16(a, bq, a4, 0, 0, 0);
            }
#pragma unroll
            for (int j = 0; j < 4; ++j) { const int s_ = 16 * st + 4 * g + j, t_ = 16 * tt + l16; a4[j] = s_ <= t_ ? a4[j] : 0.f; }
            u32x2 pw; pw.x = pk2(a4[0], a4[1]); pw.y = pk2(a4[2], a4[3]);
            *(u32x2*)(p.G_PS + (size_t)id * 4096 + w * 512 + lane * 8) = pw;
        }
#pragma unroll
        for (int i = 0; i < 2; ++i) { const int pi = tid + 512 * i;
            *(u32x4*)(p.G_QT + (size_t)id * 16384 + pi * 16) = *(const LAS u32x4*)(lds + QT_OFF + (pi >> 4) * TOK_STRIDE + (pi & 15) * 16);
            *(u32x4*)(p.G_KH + (size_t)id * 16384 + pi * 16) = *(const LAS u32x4*)(lds + KH_OFF + (pi >> 3) * CH_STRIDE + (pi & 7) * 16);
            *(u32x4*)(p.G_VT + (size_t)id * 16384 + pi * 16) = *(const LAS u32x4*)(lds + VT_OFF + (pi >> 3) * CH_STRIDE + (pi & 7) * 16); }
        if (tid < 64) *(u32x4*)(p.G_DEC + (size_t)id * 1024 + tid * 16) = *(const LAS u32x4*)(lds + DEC_OFF + tid * 16);
        LDS_BARRIER();
    }
#undef GLA_LOAD_RAW
}

__device__ __forceinline__ void scan_seq(LAS unsigned char* lds, const P& p, int bh, float* Sout, int nsc) {
    const int tid = threadIdx.x, lane = tid & 63, w = __builtin_amdgcn_readfirstlane(tid >> 6), l16 = lane & 15, g = lane >> 4;
    const int pt = tid >> 3, pp = tid & 7;
    const int hc = (bh & 15) * 128; const size_t row0 = (size_t)(bh >> 4) * TP;
    if (tid < 128) *(LAS float*)(lds + END + tid * 4) = p.gnorm[hc + tid];
    f32x4 S[8];
#pragma unroll
    for (int i = 0; i < 8; ++i) S[i] = (f32x4){0.f, 0.f, 0.f, 0.f};
    u32x4 rq[2], rk[2], rv[2], rd, rp;
    u32x4 sg0, sg1, sg0n = (u32x4){0u, 0u, 0u, 0u}, sg1n = sg0n;
#define SCAN_LOAD(sc) do { const size_t id_ = (size_t)bh * 32 + ((sc) & 31); \
        _Pragma("unroll") for (int i = 0; i < 2; ++i) { const int pi = tid + 512 * i; rq[i] = *(const u32x4*)(p.G_QT + id_ * 16384 + pi * 16); rk[i] = *(const u32x4*)(p.G_KH + id_ * 16384 + pi * 16); rv[i] = *(const u32x4*)(p.G_VT + id_ * 16384 + pi * 16); } \
        rd = *(const u32x4*)(p.G_DEC + id_ * 1024 + (tid & 63) * 16); rp = *(const u32x4*)(p.G_PS + id_ * 4096 + (tid & 255) * 16); } while (0)
    { const u32x4* sgp = (const u32x4*)(p.SG + (row0 + pt) * D + hc + 16 * pp); sg0 = sgp[0]; sg1 = sgp[1]; }
    SCAN_LOAD(0);
    for (int scx = 0; scx < nsc; ++scx) {
        const int sc = scx & 31;
        const size_t R = row0 + (size_t)sc * 64;
#pragma unroll
        for (int i = 0; i < 2; ++i) { const int pi = tid + 512 * i;
            *(LAS u32x4*)(lds + QT_OFF + (pi >> 4) * TOK_STRIDE + (pi & 15) * 16) = rq[i];
            *(LAS u32x4*)(lds + KH_OFF + (pi >> 3) * CH_STRIDE + (pi & 7) * 16) = rk[i];
            *(LAS u32x4*)(lds + VT_OFF + (pi >> 3) * CH_STRIDE + (pi & 7) * 16) = rv[i]; }
        if (tid < 64) *(LAS u32x4*)(lds + DEC_OFF + tid * 16) = rd;
        if (tid < 256) *(LAS u32x4*)(lds + KT_OFF + tid * 16) = rp;
        LDS_BARRIER();
        if (scx + 1 < nsc) { const u32x4* sgp = (const u32x4*)(p.SG + (row0 + (size_t)((scx + 1) & 31) * 64 + pt) * D + hc + 16 * pp); sg0n = sgp[0]; sg1n = sgp[1]; SCAN_LOAD(scx + 1); }
#pragma unroll
        for (int c = 0; c < 2; ++c) {
            const int tb = 32 * c;
            const LAS unsigned char* vrow = lds + VT_OFF + (16 * w + l16) * CH_STRIDE + (tb + 4 * g) * 2;
            const bf16x8 vfrag = mk8(*(const LAS u32x2*)vrow, *(const LAS u32x2*)(vrow + 32));
            bf16x8 pf[2], bq[2][4], ka[8]; f32x4 d4[8];
#pragma unroll
            for (int tt = 0; tt < 2; ++tt) {
                pf[tt] = mk8(*(const LAS u32x2*)(lds + KT_OFF + ((c * 4 + tt) * 64 + lane) * 8), *(const LAS u32x2*)(lds + KT_OFF + ((c * 4 + 2 + tt) * 64 + lane) * 8));
#pragma unroll
                for (int j2 = 0; j2 < 4; ++j2) { const LAS unsigned char* qrow = lds + QT_OFF + (tb + 16 * tt + l16) * TOK_STRIDE + (32 * j2 + 4 * g) * 2;
                    bq[tt][j2] = mk8(*(const LAS u32x2*)qrow, *(const LAS u32x2*)(qrow + 32)); }
            }
#pragma unroll
            for (int i = 0; i < 8; ++i) { d4[i] = *(const LAS f32x4*)(lds + DEC_OFF + c * 512 + (16 * i + 4 * g) * 4);
                const LAS unsigned char* krow = lds + KH_OFF + (16 * i + l16) * CH_STRIDE + (tb + 4 * g) * 2; ka[i] = mk8(*(const LAS u32x2*)krow, *(const LAS u32x2*)(krow + 32)); }
            bf16x8 sa[4];
#pragma unroll
            for (int j2 = 0; j2 < 4; ++j2) sa[j2] = pk8(S[2 * j2], S[2 * j2 + 1]);
            const f32x4 z4 = (f32x4){0.f, 0.f, 0.f, 0.f};
            f32x4 oa0 = __builtin_amdgcn_mfma_f32_16x16x32_bf16(vfrag, pf[0], z4, 0, 0, 0);
            f32x4 oa1 = __builtin_amdgcn_mfma_f32_16x16x32_bf16(vfrag, pf[1], z4, 0, 0, 0);
            f32x4 ob0 = __builtin_amdgcn_mfma_f32_16x16x32_bf16(sa[1], bq[0][1], z4, 0, 0, 0);
            f32x4 ob1 = __builtin_amdgcn_mfma_f32_16x16x32_bf16(sa[1], bq[1][1], z4, 0, 0, 0);
            oa0 = __builtin_amdgcn_mfma_f32_16x16x32_bf16(sa[0], bq[0][0], oa0, 0, 0, 0);
            oa1 = __builtin_amdgcn_mfma_f32_16x16x32_bf16(sa[0], bq[1][0], oa1, 0, 0, 0);
            ob0 = __builtin_amdgcn_mfma_f32_16x16x32_bf16(sa[3], bq[0][3], ob0, 0, 0, 0);
            ob1 = __builtin_amdgcn_mfma_f32_16x16x32_bf16(sa[3], bq[1][3], ob1, 0, 0, 0);
            oa0 = __builtin_amdgcn_mfma_f32_16x16x32_bf16(sa[2], bq[0][2], oa0, 0, 0, 0);
            oa1 = __builtin_amdgcn_mfma_f32_16x16x32_bf16(sa[2], bq[1][2], oa1, 0, 0, 0);
#pragma unroll
            for (int i = 0; i < 8; ++i) S[i] = __builtin_amdgcn_mfma_f32_16x16x32_bf16(ka[i], vfrag, S[i] * d4[i], 0, 0, 0);
            *(LAS f32x4*)(lds + OS_OFF + (tb + l16) * OS_STRIDE + (16 * w + 4 * g) * 4) = oa0 + ob0;
            *(LAS f32x4*)(lds + OS_OFF + (tb + 16 + l16) * OS_STRIDE + (16 * w + 4 * g) * 4) = oa1 + ob1;
        }
        LDS_BARRIER();
        {
            const LAS f32x4* op = (const LAS f32x4*)(lds + OS_OFF + pt * OS_STRIDE + pp * 64);
            f32x4 o[4]; float ss = 0.f;
#pragma unroll
            for (int q = 0; q < 4; ++q) { o[q] = op[q]; ss += (o[q].x * o[q].x + o[q].y * o[q].y) + (o[q].z * o[q].z + o[q].w * o[q].w); }
            ss += __shfl_xor(ss, 1); ss += __shfl_xor(ss, 2); ss += __shfl_xor(ss, 4);
            const float rstd = rsqrtf(ss * (1.0f / 128.0f) + EPS);
            const unsigned sgw[8] = {sg0.x, sg0.y, sg0.z, sg0.w, sg1.x, sg1.y, sg1.z, sg1.w};
            unsigned ow[8];
#pragma unroll
            for (int q = 0; q < 4; ++q) {
                const f32x4 v = o[q] * rstd * *(const LAS f32x4*)(lds + END + (16 * pp + 4 * q) * 4);
                ow[2 * q] = pk2(v.x * bf2f(sgw[2 * q] & 0xffffu), v.y * bf2f(sgw[2 * q] >> 16));
                ow[2 * q + 1] = pk2(v.z * bf2f(sgw[2 * q + 1] & 0xffffu), v.w * bf2f(sgw[2 * q + 1] >> 16));
            }
            u32x4* od = (u32x4*)(p.O2 + (R + pt) * D + hc + 16 * pp);
            od[0] = (u32x4){ow[0], ow[1], ow[2], ow[3]}; od[1] = (u32x4){ow[4], ow[5], ow[6], ow[7]};
        }
        sg0 = sg0n; sg1 = sg1n;
    }
#undef SCAN_LOAD
#pragma unroll
    for (int i = 0; i < 8; ++i)
#pragma unroll
        for (int j = 0; j < 4; ++j) Sout[(size_t)(16 * i + 4 * g + j) * 128 + 16 * w + l16] = S[i][j];
}

constexpr int DF_OFF = 0, DK_OFF = 2048, DQ_OFF = 4096, DV_OFF = 6144, DR_OFF = 8192, DW_OFF = 16384;
__device__ __forceinline__ void decode_items(LAS unsigned char* lds, const P& p, const float* state_in, float* state_out, int first, int stride, int nitems) {
    const int tid = threadIdx.x, lane = tid & 63, w = __builtin_amdgcn_readfirstlane(tid >> 6);
    const int v = tid & 127, kg = tid >> 7;
    float sA[32], sB[32];
    float lA = 0.f, gA = 0.f, lB = 0.f, gB = 0.f; unsigned qA = 0u, vA = 0u, sgA = 0u, qB = 0u, vB = 0u, sgB = 0u;
#define DEC_PREFETCH(itn_, s, c_l, c_q, c_v, c_sg, c_gn) do { const int itn = (itn_) & (BS * 16 - 1); \
        _Pragma("unroll") for (int q = 0; q < 4; ++q) { const float* sp = state_in + (size_t)itn * 16384 + (size_t)(32 * kg + 8 * q) * 128 + v; \
            _Pragma("unroll") for (int i = 0; i < 8; ++i) s[8 * q + i] = sp[i * 128]; } \
        const int hc_ = (itn & 15) * 128; const size_t off_ = ((size_t)NPROMPT + 4 * (itn >> 4) + kg) * D + hc_ + v; \
        c_l = p.LOGF[off_]; c_q = (unsigned)p.Qs[off_]; c_v = (unsigned)p.Vb[off_]; c_sg = (unsigned)p.SG[off_]; c_gn = p.gnorm[hc_ + v]; } while (0)
#define DEC_BODY(itx_, s, c_l, c_q, c_v, c_sg, c_gn) do { const int it = (itx_) & (BS * 16 - 1); \
        const size_t off = ((size_t)NPROMPT + 4 * (it >> 4) + kg) * D + (it & 15) * 128 + v; \
        const float gate = c_gn * bf2f(c_sg); \
        { const float f = __expf(c_l); \
          *(LAS float*)(lds + DF_OFF + tid * 4) = f; *(LAS float*)(lds + DK_OFF + tid * 4) = 1.0f - f; \
          *(LAS float*)(lds + DQ_OFF + tid * 4) = bf2f(c_q); *(LAS float*)(lds + DV_OFF + tid * 4) = bf2f(c_v); } \
        LDS_BARRIER(); \
        _Pragma("unroll 1") for (int t = 0; t < 4; ++t) { \
            const float vt = *(const LAS float*)(lds + DV_OFF + (t * 128 + v) * 4); \
            float a = 0.f; \
            _Pragma("unroll") for (int i4 = 0; i4 < 8; ++i4) { \
                const f32x4 f4 = *(const LAS f32x4*)(lds + DF_OFF + (t * 128 + 32 * kg + 4 * i4) * 4), k4 = *(const LAS f32x4*)(lds + DK_OFF + (t * 128 + 32 * kg + 4 * i4) * 4), \
                            q4 = *(const LAS f32x4*)(lds + DQ_OFF + (t * 128 + 32 * kg + 4 * i4) * 4); \
                _Pragma("unroll") for (int j = 0; j < 4; ++j) { const float sn = f4[j] * s[4 * i4 + j] + k4[j] * vt; s[4 * i4 + j] = sn; a += q4[j] * sn; } \
            } \
            *(LAS float*)(lds + DR_OFF + ((t * 4 + kg) * 128 + v) * 4) = a; \
        } \
        _Pragma("unroll") for (int q = 0; q < 4; ++q) { \
            float* so = state_out + (size_t)it * 16384 + (size_t)(32 * kg + 8 * q) * 128 + v; \
            _Pragma("unroll") for (int i = 0; i < 8; ++i) so[i * 128] = s[8 * q + i]; \
        } \
        if ((itx_) + 2 * stride < nitems) DEC_PREFETCH((itx_) + 2 * stride, s, c_l, c_q, c_v, c_sg, c_gn); \
        LDS_BARRIER(); \
        const LAS float* rr = (const LAS float*)(lds + DR_OFF + (kg * 4 * 128 + v) * 4); \
        const float o = (rr[0] + rr[128]) + (rr[256] + rr[384]); \
        const float ws = wave_sum(o * o); \
        if (lane == 0) *(LAS float*)(lds + DW_OFF + w * 4) = ws; \
        LDS_BARRIER(); \
        const float ss = *(const LAS float*)(lds + DW_OFF + (2 * kg) * 4) + *(const LAS float*)(lds + DW_OFF + (2 * kg + 1) * 4); \
        const float rstd = rsqrtf(ss * (1.0f / 128.0f) + EPS); \
        p.O2[off] = (bf16_t)(pk2(o * rstd * gate, 0.f) & 0xffffu); } while (0)
    if (first < nitems) DEC_PREFETCH(first, sA, lA, qA, vA, sgA, gA);
    if (first + stride < nitems) DEC_PREFETCH(first + stride, sB, lB, qB, vB, sgB, gB);
    for (int itx = first; itx < nitems; itx += 2 * stride) {
        DEC_BODY(itx, sA, lA, qA, vA, sgA, gA);
        if (itx + stride < nitems) DEC_BODY(itx + stride, sB, lB, qB, vB, sgB, gB);
    }
#undef DEC_BODY
#undef DEC_PREFETCH
}
}

namespace att {
constexpr int KS_OFF = 0, KS_STRIDE = 144;
constexpr int VT_OFF = 256 * 144, VT_STRIDE = 528;
struct P { const bf16_t* Qr; const bf16_t* Kb; const bf16_t* Vkv; const float* ck; const float* cv; const float* sinks; bf16_t* O; };

__device__ __forceinline__ void unit(LAS unsigned char* lds, const P& p, bool prompt, int b, int kvh, int qb) {
    const int tid = threadIdx.x, lane = tid & 63, w = __builtin_amdgcn_readfirstlane(tid >> 6), l16 = lane & 15, g = lane >> 4;
    const int h = kvh * 8 + w;
    bf16x8 qn0, qn1;
    { const size_t qrow0 = prompt ? (size_t)(b * TP + 128 * qb + l16) : (size_t)(NPROMPT + 4 * b + min(l16, 3));
      const bf16_t* qp = p.Qr + qrow0 * D + h * 64 + 8 * g; qn0 = *(const bf16x8*)qp; qn1 = *(const bf16x8*)(qp + 32); }
    __syncthreads();
#pragma unroll
    for (int i = 0; i < 4; ++i) {
        const int e = tid + 512 * i;
        {
            const int key = e >> 3, c8 = e & 7; u32x4 kv = (u32x4){0u, 0u, 0u, 0u};
            if (prompt) { if (qb > 0 || key >= 128) kv = *(const u32x4*)(p.Kb + (size_t)(b * TP + 128 * (qb - 1) + key) * 256 + kvh * 64 + c8 * 8); }
            else if (key < 128) { const f32x4* s = (const f32x4*)(p.ck + ((size_t)(b * 128 + key) * 4 + kvh) * 64 + c8 * 8); const f32x4 a = s[0], c = s[1]; kv = (u32x4){pk2(a.x, a.y), pk2(a.z, a.w), pk2(c.x, c.y), pk2(c.z, c.w)}; }
            else if (key < 132) kv = *(const u32x4*)(p.Kb + (size_t)(NPROMPT + 4 * b + key - 128) * 256 + kvh * 64 + c8 * 8);
            if (prompt || key < 160) *(LAS u32x4*)(lds + KS_OFF + key * KS_STRIDE + c8 * 16) = kv;
        }
        {
            const int key = e & 255, c8 = e >> 8; u32x4 vv = (u32x4){0u, 0u, 0u, 0u};
            if (prompt) { if (qb > 0 || key >= 128) vv = *(const u32x4*)(p.Vkv + (size_t)(b * TP + 128 * (qb - 1) + key) * 256 + kvh * 64 + c8 * 8); }
            else if (key < 128) { const f32x4* s = (const f32x4*)(p.cv + ((size_t)(b * 128 + key) * 4 + kvh) * 64 + c8 * 8); const f32x4 a = s[0], c = s[1]; vv = (u32x4){pk2(a.x, a.y), pk2(a.z, a.w), pk2(c.x, c.y), pk2(c.z, c.w)}; }
            else if (key < 132) vv = *(const u32x4*)(p.Vkv + (size_t)(NPROMPT + 4 * b + key - 128) * 256 + kvh * 64 + c8 * 8);
            if (prompt || key < 160) {
                LAS bf16_t* d = (LAS bf16_t*)(lds + VT_OFF + (c8 * 8) * VT_STRIDE + key * 2);
                d[0 * (VT_STRIDE / 2)] = (bf16_t)(vv.x & 0xffffu); d[1 * (VT_STRIDE / 2)] = (bf16_t)(vv.x >> 16);
                d[2 * (VT_STRIDE / 2)] = (bf16_t)(vv.y & 0xffffu); d[3 * (VT_STRIDE / 2)] = (bf16_t)(vv.y >> 16);
                d[4 * (VT_STRIDE / 2)] = (bf16_t)(vv.z & 0xffffu); d[5 * (VT_STRIDE / 2)] = (bf16_t)(vv.z >> 16);
                d[6 * (VT_STRIDE / 2)] = (bf16_t)(vv.w & 0xffffu); d[7 * (VT_STRIDE / 2)] = (bf16_t)(vv.w >> 16);
            }
        }
    }
    __syncthreads();
    const float sink = p.sinks[h];
    const bool hasprev = !prompt || qb > 0;
    const int nqt = prompt ? 8 : 1;
    for (int qt = 0; qt < nqt; ++qt) {
        const int qi = 16 * qt + l16;
        const size_t qrow = prompt ? (size_t)(b * TP + 128 * qb + qi) : (size_t)(NPROMPT + 4 * b + min(l16, 3));
        const bf16x8 qf[2] = {qn0, qn1};
        if (qt + 1 < nqt) { const bf16_t* qp = p.Qr + (qrow + 16) * D + h * 64 + 8 * g; qn0 = *(const bf16x8*)qp; qn1 = *(const bf16x8*)(qp + 32); }
        const int kt0 = 2 * (qt >> 1);
        f32x4 sc[10];
        float mx = -INFINITY;
#pragma unroll
        for (int ti = 0; ti < 10; ++ti) {
            const LAS unsigned char* kr = lds + KS_OFF + (16 * (kt0 + ti) + l16) * KS_STRIDE + 16 * g;
            f32x4 a4 = (f32x4){0.f, 0.f, 0.f, 0.f};
            a4 = __builtin_amdgcn_mfma_f32_16x16x32_bf16(*(const LAS bf16x8*)kr, qf[0], a4, 0, 0, 0);
            a4 = __builtin_amdgcn_mfma_f32_16x16x32_bf16(*(const LAS bf16x8*)(kr + 64), qf[1], a4, 0, 0, 0);
#pragma unroll
            for (int j = 0; j < 4; ++j) {
                const int jk = 16 * (kt0 + ti) + 4 * g + j;
                const bool valid = jk > qi && jk <= qi + 128 && (hasprev || jk >= 128);
                a4[j] = valid ? a4[j] : -INFINITY; mx = fmaxf(mx, a4[j]);
            }
            sc[ti] = a4;
        }
        mx = fmaxf(mx, __shfl_xor(mx, 16)); mx = fmaxf(mx, __shfl_xor(mx, 32)); mx = fmaxf(mx, sink);
        float sum = 0.f;
#pragma unroll
        for (int ti = 0; ti < 10; ++ti)
#pragma unroll
            for (int j = 0; j < 4; ++j) { const float e = __expf(sc[ti][j] - mx); sc[ti][j] = e; sum += e; }
        sum += __shfl_xor(sum, 16); sum += __shfl_xor(sum, 32);
        const float inv = 1.0f / (sum + __expf(sink - mx));
        f32x4 o[4];
#pragma unroll
        for (int dt = 0; dt < 4; ++dt) o[dt] = (f32x4){0.f, 0.f, 0.f, 0.f};
#pragma unroll
        for (int pp = 0; pp < 5; ++pp) {
            const bf16x8 pb = gla::pk8(sc[2 * pp], sc[2 * pp + 1]);
#pragma unroll
            for (int dt = 0; dt < 4; ++dt) {
                const LAS unsigned char* vr = lds + VT_OFF + (16 * dt + l16) * VT_STRIDE + (16 * (kt0 + 2 * pp) + 4 * g) * 2;
                const bf16x8 va = gla::mk8(*(const LAS u32x2*)vr, *(const LAS u32x2*)(vr + 32));
                o[dt] = __builtin_amdgcn_mfma_f32_16x16x32_bf16(va, pb, o[dt], 0, 0, 0);
            }
        }
        if (prompt || l16 < 4) {
#pragma unroll
            for (int dt = 0; dt < 4; ++dt) {
                const f32x4 v = o[dt] * inv; u32x2 wv; wv.x = pk2(v.x, v.y); wv.y = pk2(v.z, v.w);
                *(u32x2*)(p.O + qrow * D + h * 64 + 16 * dt + 4 * g) = wv;
            }
        }
    }
}
}

#define XB_TMO      128
#define XB_XCNT(j)  (256  + 64 * (j))
#define XB_XSUB(j)  (1280 + 64 * (j))
#define XB_XGEN(j)  (2304 + 64 * (j))
#define XB_TOP      3328
#define XB_TOPGEN   3392
#define XCD_BAR_WORDS 3456
#define XB_SPIN_CAP (1u << 18)
__device__ __forceinline__ unsigned xb_ld(unsigned* p)              { return __hip_atomic_load(p, __ATOMIC_RELAXED, __HIP_MEMORY_SCOPE_AGENT); }
__device__ __forceinline__ unsigned xb_add(unsigned* p, unsigned v) { return __hip_atomic_fetch_add(p, v, __ATOMIC_RELAXED, __HIP_MEMORY_SCOPE_AGENT); }
__device__ __forceinline__ unsigned xb_xcc_id() { return (unsigned)__builtin_amdgcn_s_getreg((3 << 11) | 20) & 0xFu; }
#define XB_SPIN(cond, bar) do { unsigned _sp = 0; while (cond) { __builtin_amdgcn_s_sleep(1); \
    if ((++_sp & 255u) == 0u) { if (xb_ld(&(bar)[XB_TMO])) break; if (_sp > XB_SPIN_CAP) { atomicAdd(&(bar)[XB_TMO], 1u); break; } } } } while (0)
struct XcdBarrier { unsigned* bar; unsigned x; volatile LAS unsigned* st; };
__device__ __forceinline__ XcdBarrier xcd_barrier_post(unsigned* bar, volatile LAS unsigned* st) {
    XcdBarrier b; b.bar = bar; b.x = xb_xcc_id(); b.st = st;
    if (threadIdx.x == 0) (void)xb_add(&bar[XB_XCNT(b.x)], 1u);
    return b;
}
__device__ __forceinline__ void xcd_barrier_complete(unsigned* bar, unsigned x, unsigned& nloc, unsigned& nx) {
    const unsigned G = gridDim.x * gridDim.y * gridDim.z;
    unsigned sum, cnt, mine, sp = 0u;
    for (;;) {
        sum = 0u; cnt = 0u; mine = 0u;
#pragma unroll
        for (unsigned j = 0; j < 16; ++j) { const unsigned c = xb_ld(&bar[XB_XCNT(j)]); sum += c; cnt += (c > 0u) ? 1u : 0u; mine = (j == x) ? c : mine; }
        if (sum == G) break;
        __builtin_amdgcn_s_sleep(1);
        if ((++sp & 255u) == 0u) { if (xb_ld(&bar[XB_TMO])) break; if (sp > XB_SPIN_CAP) { atomicAdd(&bar[XB_TMO], 1u); break; } }
    }
    nloc = mine > 0u ? mine : 1u; nx = cnt > 0u ? cnt : 1u;
}
__device__ __forceinline__ void xcd_barrier(const XcdBarrier& b) {
    asm volatile("s_waitcnt vmcnt(0)" ::: "memory");
    __syncthreads();
    if (threadIdx.x == 0) {
        unsigned* bar = b.bar;
        __builtin_amdgcn_s_waitcnt(0);
        unsigned nloc = b.st[0], nx = b.st[1];
        if (nloc == 0u) { xcd_barrier_complete(bar, b.x, nloc, nx); b.st[0] = nloc; b.st[1] = nx; }
        const unsigned old = xb_add(&bar[XB_XSUB(b.x)], 1u);
        const unsigned gen = old / nloc;
        if (old + 1u == (gen + 1u) * nloc) {
            __builtin_amdgcn_fence(__ATOMIC_RELEASE, "agent");
            asm volatile("s_waitcnt vmcnt(0)" ::: "memory");
            const unsigned og = xb_add(&bar[XB_TOP], 1u);
            const unsigned tg = og / nx;
            if (og + 1u == (tg + 1u) * nx) xb_add(&bar[XB_TOPGEN], 1u);
            else XB_SPIN(xb_ld(&bar[XB_TOPGEN]) == tg, bar);
            __builtin_amdgcn_fence(__ATOMIC_ACQUIRE, "agent");
            xb_add(&bar[XB_XGEN(b.x)], 1u);
            asm volatile("s_waitcnt vmcnt(0)" ::: "memory");
        } else {
            XB_SPIN(xb_ld(&bar[XB_XGEN(b.x)]) == gen, bar);
            __builtin_amdgcn_fence(__ATOMIC_ACQUIRE, "agent");
            asm volatile("s_waitcnt vmcnt(0)" ::: "memory");
        }
    }
    __syncthreads();
}

struct Args { const float* in[20]; float* out; unsigned char* ws; int ph_lo, ph_hi; };
constexpr int N_PHASES = 16;

__global__ void __launch_bounds__(NWAVES * 64, 2) mk_fwd(Args args) {
    extern __shared__ __attribute__((aligned(16))) unsigned char lds_raw[];
    LAS unsigned char* lds = (LAS unsigned char*)lds_raw;
    cg::grid_group grid = cg::this_grid();
    const int tid = threadIdx.x, lane = tid & 63, wave = __builtin_amdgcn_readfirstlane(tid >> 6);
    const int G = gridDim.x, cb = blockIdx.x;
    const int gw = cb * NWAVES + wave, NGW = G * NWAVES;
    unsigned char* ws = args.ws;
    const float* x_prompt = args.in[0]; const float* x_sample = args.in[1]; const float* state_in = args.in[2]; const float* cache_k = args.in[3]; const float* cache_v = args.in[4];
    const float* g_mix_pre = args.in[5]; const float* g_mix_post = args.in[6]; const float* g_ffn_pre = args.in[7]; const float* g_ffn_post = args.in[8];
    const float* w_in = args.in[9]; const float* lbraw = args.in[10]; const float* g_hnorm = args.in[11]; const float* w_hout = args.in[12];
    const float* g_kv = args.in[13]; const float* w_kv = args.in[14]; const float* w_q = args.in[15]; const float* sinks = args.in[16]; const float* w_ao = args.in[17];
    const float* w_gu = args.in[18]; const float* w_dn = args.in[19];
    bf16_t* Win_t = (bf16_t*)(ws + WS_WIN); bf16_t* Wout_t = (bf16_t*)(ws + WS_WOUT); bf16_t* Wkv_t = (bf16_t*)(ws + WS_WKV); bf16_t* Wq_t = (bf16_t*)(ws + WS_WQ); bf16_t* Wao_t = (bf16_t*)(ws + WS_WAO);
    bf16_t* Wgu_t[2] = {(bf16_t*)(ws + WS_WGU0), (bf16_t*)(ws + WS_WGU1)}; bf16_t* Wd_t[2] = {(bf16_t*)(ws + WS_WD0), (bf16_t*)(ws + WS_WD1)};
    f32x2* rope = (f32x2*)(ws + WS_ROPE);
    bf16_t* XN = (bf16_t*)(ws + WS_XN); bf16_t* O2 = (bf16_t*)(ws + WS_O2); bf16_t* Y = (bf16_t*)(ws + WS_Y);
    bf16_t* Qs = (bf16_t*)(ws + WS_QS); float* LOGF = (float*)(ws + WS_LOGF); bf16_t* Vb = (bf16_t*)(ws + WS_VB); bf16_t* SG = (bf16_t*)(ws + WS_SG);
    bf16_t* Hact = (bf16_t*)(ws + WS_HACT);
    bf16_t* XKV = (bf16_t*)(ws + WS_XKV); bf16_t* Qr = (bf16_t*)(ws + WS_QR); bf16_t* Kb = (bf16_t*)(ws + WS_KB); bf16_t* Vkv = (bf16_t*)(ws + WS_VKV);
    float* out = args.out; float* H = out + OUT_Y; bf16_t* Hb = (bf16_t*)(ws + WS_HB);
    float* slab = (float*)(ws + WS_SLAB); unsigned* cntw = (unsigned*)(ws + WS_CNT);
    const int lo = args.ph_lo, hi = args.ph_hi;
    LAS float* scr = (LAS float*)(lds + wave * 16384);
    constexpr int I_IN = 32 * 256, I_SQ = 32 * 64, I_KV = 32 * 16, I_GU = 32 * 352, I_DN = 88 * 64;
#define IN(k) (lo <= (k) && (k) < hi)
#define SEAM(k) do { if (IN(k) && IN((k) + 1)) { if (lo < 0) grid.sync(); else xcd_barrier(bar); } } while (0)
    volatile LAS unsigned* MISC = (volatile LAS unsigned*)(lds + 131072 + 320);
    if (tid < 32) MISC[tid] = 0u;
    __syncthreads();
    XcdBarrier bar; bar.bar = (unsigned*)ws; bar.x = 0; bar.st = nullptr;
    if (hi - lo > 1) bar = xcd_barrier_post((unsigned*)ws, MISC + 8);

    if (IN(0)) {
        cvt_stream<false>(w_in, D, 4 * D, Win_t, scr, gw, NGW, I_IN, lane);
        for (int e = cb * 512 + tid; e < (TP + TS) * 8; e += G * 512) {
            const int idx = e >> 3, f = e & 7; const double pos = idx < TP ? (double)idx : (double)(8192 + idx - TP);
            const double invf[8] = {1.0, 0.19392274474868576, 0.03760603093086393, 0.007292664737217109, 0.001414213562373095, 0.0002742481756762073, 5.318295896944988e-05, 1.031338537721246e-05};
            double iv = invf[0];
#pragma unroll
            for (int q = 1; q < 8; ++q) iv = f == q ? invf[q] : iv;
            const double ang = pos * (double)(float)iv;
            const double TWO_PI = 6.283185307179586476925286766559;
            const double r = ang - TWO_PI * __builtin_rint(ang / TWO_PI);
            const double r2 = r * r;
            double sn = 0.0, cs = 0.0;
#pragma unroll
            for (int k = 14; k >= 1; --k) { sn = (1.0 - sn) * r2 / (double)((2 * k) * (2 * k + 1)); cs = (1.0 - cs) * r2 / (double)((2 * k - 1) * (2 * k)); }
            rope[e] = (f32x2){(float)(1.0 - cs), (float)(r * (1.0 - sn))};
        }
        row_phase<false, true, false, true, false>(x_prompt, x_sample, nullptr, nullptr, nullptr, nullptr, nullptr, g_mix_pre, XN, nullptr, nullptr, gw, NGW, lane);
    }
    SEAM(0);
    if (IN(1)) {
        pg8::Gemm g{XN, Win_t, M, 4 * D, D}; pg8::StaticOrder S; S.init(M, 4 * D, G, cb, D);
        pg8::EpiIn E{Qs, LOGF, Vb, SG, lbraw};
        pg8::gemm_phase<pg8::EpiIn, pg8::StaticOrder, true, true>(lds, g, S, E);
        if (cb >= 64) {
            const int wv_ = (cb - 64) * NWAVES + wave;
            if (wv_ < 256) cvt_stream<false>(w_hout, D, D, Wout_t, scr, wv_, 256, I_SQ, lane);
            else if (wv_ < 512) cvt_stream<false>(w_q, D, D, Wq_t, scr, wv_ - 256, 256, I_SQ, lane);
            else if (wv_ < 768) cvt_stream<false>(w_ao, D, D, Wao_t, scr, wv_ - 512, 256, I_SQ, lane);
            else if (wv_ < 832) cvt_stream<false>(w_kv, D, 512, Wkv_t, scr, wv_ - 768, 64, I_KV, lane);
            else cvt_stream<false>(w_dn, DFF, D, Wd_t[0], scr, wv_ - 832, 704, I_DN, lane);
        }
    }
    SEAM(1);
    gla::P gp{Qs, LOGF, Vb, SG, g_hnorm, O2, ws + WS_GQT, ws + WS_GKH, ws + WS_GVT, ws + WS_GPS, ws + WS_GDEC};
    if (IN(2)) {
        gla::intra_items(lds, gp, cb, G, 2048);
    }
    SEAM(2);
    if (IN(3)) {
        const int nA = 64;
        if (cb < nA) gla::scan_seq(lds, gp, cb, out + OUT_SP + (size_t)cb * 16384, 32);
        else {
            gla::decode_items(lds, gp, state_in, out + OUT_SS, cb - nA, G - nA, BS * 16);
            __syncthreads();
            cvt_stream<true>(w_gu, D, 2 * DFF, Wgu_t[0], scr, 3754 + (cb - nA) * NWAVES + wave, (G - nA) * NWAVES, I_GU, lane);
        }
    }
    SEAM(3);
    if (IN(4)) {
        pg8::Gemm g{O2, Wout_t, M, D, D}; pg8::SplitOrder S; S.init(D, G, cb, D);
        pg8::EpiF32 E{Y, D, slab, cntw + 0 * 1024};
        pg8::gemm_phase<pg8::EpiF32, pg8::SplitOrder, true, true>(lds, g, S, E);
        if (cb >= 128) cvt_stream<true>(w_gu, D, 2 * DFF, Wgu_t[0], scr, (cb - 128) * NWAVES + wave, 128 * NWAVES, 3754, lane);
    }
    SEAM(4);
    if (IN(5)) {
        row_phase<true, true, false, true, true>(x_prompt, x_sample, nullptr, Y, g_mix_post, Hb, nullptr, g_ffn_pre, XN, nullptr, nullptr, gw, NGW, lane);
    }
    SEAM(5);
    if (IN(6)) {
        pg8::Gemm g{XN, Wgu_t[0], M, 2 * DFF, D}; pg8::StaticOrder S; S.init(M, 2 * DFF, G, cb, D);
        pg8::EpiSwiGLU E{Hact};
        pg8::gemm_phase<pg8::EpiSwiGLU, pg8::StaticOrder, true, true>(lds, g, S, E);
    }
    SEAM(6);
    if (IN(7)) {
        pg8::Gemm g{Hact, Wd_t[0], M, D, DFF}; pg8::SplitOrder S; S.init(D, G, cb, DFF);
        pg8::EpiF32 E{Y, D, slab, cntw + 1 * 1024};
        pg8::gemm_phase<pg8::EpiF32, pg8::SplitOrder, true, true>(lds, g, S, E);
    }
    SEAM(7);
    if (IN(8)) {
        row_phase<true, true, true, false, true>(nullptr, nullptr, Hb, Y, g_ffn_post, Hb, nullptr, g_mix_pre + D, XN, g_kv, XKV, gw, NGW, lane);
    }
    SEAM(8);
    if (IN(9)) {
        { pg8::Gemm g{XKV, Wkv_t, M, 512, D}; pg8::StaticOrder S; S.init(M, 512, G, cb, D);
          pg8::EpiRope<1> E{Kb, Vkv, rope, out + OUT_KWIN, out + OUT_VWIN, out + OUT_KNEW, out + OUT_VNEW};
          pg8::gemm_phase<pg8::EpiRope<1>, pg8::StaticOrder, true, true>(lds, g, S, E); }
        { pg8::Gemm g{XN, Wq_t, M, D, D}; pg8::StaticOrder S; S.init(M, D, G, (cb + G - (68 % G)) % G, D);
          pg8::EpiRope<0> E{Qr, nullptr, rope, nullptr, nullptr, nullptr, nullptr};
          pg8::gemm_phase<pg8::EpiRope<0>, pg8::StaticOrder, true, true>(lds, g, S, E); }
        if (cb >= 84) {
            const int wv_ = (cb - 84) * NWAVES + wave;
            if (wv_ < 917) cvt_stream<true>(w_gu + (size_t)D * 2 * DFF, D, 2 * DFF, Wgu_t[1], scr, wv_, 917, I_GU, lane);
            else cvt_stream<false>(w_dn + (size_t)DFF * D, DFF, D, Wd_t[1], scr, wv_ - 917, 459, I_DN, lane);
        }
    }
    SEAM(9);
    if (IN(10)) {
        att::P ap{Qr, Kb, Vkv, cache_k, cache_v, sinks, O2};
        for (int u = cb; u < 256 + 512; u += G) {
            if (u < 256) att::unit(lds, ap, true, u >> 6, (u >> 4) & 3, u & 15);
            else { const int v = u - 256; att::unit(lds, ap, false, v >> 2, v & 3, 0); }
        }
    }
    SEAM(10);
    if (IN(11)) {
        pg8::Gemm g{O2, Wao_t, M, D, D}; pg8::SplitOrder S; S.init(D, G, cb, D);
        pg8::EpiF32 E{Y, D, slab, cntw + 2 * 1024};
        pg8::gemm_phase<pg8::EpiF32, pg8::SplitOrder, true, true>(lds, g, S, E);
    }
    SEAM(11);
    if (IN(12)) {
        row_phase<true, true, false, false, true>(nullptr, nullptr, Hb, Y, g_mix_post + D, Hb, nullptr, g_ffn_pre + D, XN, nullptr, nullptr, gw, NGW, lane);
    }
    SEAM(12);
    if (IN(13)) {
        pg8::Gemm g{XN, Wgu_t[1], M, 2 * DFF, D}; pg8::StaticOrder S; S.init(M, 2 * DFF, G, cb, D);
        pg8::EpiSwiGLU E{Hact};
        pg8::gemm_phase<pg8::EpiSwiGLU, pg8::StaticOrder, true, true>(lds, g, S, E);
    }
    SEAM(13);
    if (IN(14)) {
        pg8::Gemm g{Hact, Wd_t[1], M, D, DFF}; pg8::SplitOrder S; S.init(D, G, cb, DFF);
        pg8::EpiF32 E{Y, D, slab, cntw + 3 * 1024};
        pg8::gemm_phase<pg8::EpiF32, pg8::SplitOrder, true, true>(lds, g, S, E);
    }
    SEAM(14);
    if (IN(15)) {
        row_phase<true, false, false, false, false>(nullptr, nullptr, Hb, Y, g_ffn_post + D, nullptr, H, nullptr, nullptr, nullptr, nullptr, gw, NGW, lane);
    }
#undef IN
#undef SEAM
}

extern "C" void kernel_launch(void* const* d_in, const int* in_sizes, int n_in, void* d_out, int out_size, void* d_ws, size_t ws_size, hipStream_t stream) {
    static int grid = 0;
    if (grid == 0) {
        if (n_in != 20 || (size_t)out_size != OUT_END || ws_size < WS_END) { fprintf(stderr, "kernel_launch: unexpected shapes: n_in %d out %d ws %zu (need %zu)\n", n_in, out_size, ws_size, (size_t)WS_END); grid = -1; return; }
        int dev = 0, cus = 0, per_cu = 0;
        hipGetDevice(&dev); hipDeviceGetAttribute(&cus, hipDeviceAttributeMultiprocessorCount, dev);
        if (hipFuncSetAttribute((const void*)mk_fwd, hipFuncAttributeMaxDynamicSharedMemorySize, LDS_BYTES) != hipSuccess) { fprintf(stderr, "kernel_launch: hipFuncSetAttribute failed\n"); grid = -1; return; }
        hipOccupancyMaxActiveBlocksPerMultiprocessor(&per_cu, (const void*)mk_fwd, NWAVES * 64, LDS_BYTES);
        (void)hipGetLastError();
        if (per_cu < 1) per_cu = 1;
        if (cus < 256) { fprintf(stderr, "kernel_launch: built for a 256-CU device (got %d)\n", cus); grid = -1; return; }
        grid = 256;
        fprintf(stderr, "kernel_launch: cus %d per_cu %d grid %d\n", cus, per_cu, grid);
    }
    if (grid < 0) return;
    if (hipMemsetAsync(d_ws, 0, 131072, stream) != hipSuccess) { fprintf(stderr, "kernel_launch: memset failed\n"); return; }
    Args a{};
    for (int i = 0; i < 20; ++i) a.in[i] = (const float*)d_in[i];
    a.out = (float*)d_out; a.ws = (unsigned char*)d_ws;
#if MK_ONE_LAUNCH
    void* kargs[] = {&a};
    a.ph_lo = 0; a.ph_hi = N_PHASES;
    hipError_t e = hipLaunchCooperativeKernel((const void*)mk_fwd, dim3(grid), dim3(NWAVES * 64), kargs, LDS_BYTES, stream);
    if (e != hipSuccess) fprintf(stderr, "kernel_launch: cooperative launch failed: %s\n", hipGetErrorString(e));
#else
    for (int ph = 0; ph < N_PHASES; ++ph) {
        a.ph_lo = ph; a.ph_hi = ph + 1;
        hipLaunchKernelGGL(mk_fwd, dim3(grid), dim3(NWAVES * 64), LDS_BYTES, stream, a);
    }
#endif
}
```
